# Optimizing an MI355X kernel written in HIP

```python
import numpy as np
import jax
import jax.numpy as jnp
from jax import lax


D_MODEL = 1024
BATCH = 8
SEQ = 2048
DEPTH = 2

HEAD_DIM = 64
A_HEADS = D_MODEL // (4 * HEAD_DIM)
IDX_HEADS = 4
IDX_DIM = 64
DSA_TOPK = 256
B_HEADS = D_MODEL // (2 * HEAD_DIM)
B_WIDTH = B_HEADS * HEAD_DIM
DECAY_LORA = 64
AAA_LORA = 64
GATE_LORA = 128
GN_EPS = 64e-5
C_HEADS = D_MODEL // (4 * HEAD_DIM)
CMP_LEN = 32
CMP_STRIDE = 16
CMP_HID = 256
SEL_LEN = 64
SEL_TOPN = 16
WIN = 512
Q_BLOCK = 128
ROPE_THETA = 10000.0
NORM_EPS = 1e-6
NEG = -1e30
MIX_WIDTH = A_HEADS * HEAD_DIM + B_WIDTH + C_HEADS * HEAD_DIM
A_COLS = (A_HEADS * HEAD_DIM, HEAD_DIM, HEAD_DIM, IDX_HEADS * IDX_DIM, IDX_DIM, IDX_HEADS)
B_COLS = (B_WIDTH, B_WIDTH, B_WIDTH, DECAY_LORA, AAA_LORA, GATE_LORA)
C_COLS = (C_HEADS * HEAD_DIM, 6 * HEAD_DIM, 3 * C_HEADS)
IN_COLS = sum(A_COLS) + sum(B_COLS) + sum(C_COLS)
FFN_HIDDEN = ((8 * D_MODEL // 3 + 255) // 256) * 256

kernel_name = 'hymba_dsa_rwkv7_nsa_block'


def rms_norm(x, g, eps=NORM_EPS):
    xf = x.astype(jnp.float32)
    y = xf * lax.rsqrt(jnp.mean(xf * xf, axis=-1, keepdims=True) + eps)
    return (y * g.astype(jnp.float32)).astype(x.dtype)


def rope(x, pos):
    half = x.shape[-1] // 2
    inv = ROPE_THETA ** (-jnp.arange(half, dtype=jnp.float32) / half)
    ang = pos.astype(jnp.float32)[..., None] * inv
    cos, sin = jnp.cos(ang), jnp.sin(ang)
    xf = x.astype(jnp.float32)
    x1, x2 = xf[..., :half], xf[..., half:]
    return jnp.concatenate([x1 * cos - x2 * sin, x2 * cos + x1 * sin], axis=-1).astype(x.dtype)


def split_cols(z, sizes):
    return jnp.split(z, np.cumsum(sizes)[:-1].tolist(), axis=-1)


def attend(q, k, v, valid):
    s = jnp.einsum('bqhd,bqkd->bqhk', q, k, preferred_element_type=jnp.float32) * HEAD_DIM ** -0.5
    s = jnp.where(valid[:, :, None, :], s, -jnp.inf)
    p = jax.nn.softmax(s, axis=-1).astype(v.dtype)
    return jnp.einsum('bqhk,bqkd->bqhd', p, v)


def dsa_mixer(q, k, v, iq, ik, iw, q_g, k_g):
    B, T = q.shape[:2]
    pos = jnp.arange(T)
    q = rope(rms_norm(q, q_g), pos[:, None])
    k = rope(rms_norm(k, k_g), pos)
    iq = rope(iq, pos[:, None]).astype(jnp.float32)
    ik = rope(ik, pos).astype(jnp.float32)
    iw = iw.astype(jnp.float32)
    topk = min(DSA_TOPK, T // 4)

    def block(i):
        t0 = i * Q_BLOCK
        tq = t0 + jnp.arange(Q_BLOCK)
        qb = lax.dynamic_slice_in_dim(q, t0, Q_BLOCK, axis=1)
        iqb = lax.dynamic_slice_in_dim(iq, t0, Q_BLOCK, axis=1)
        iwb = lax.dynamic_slice_in_dim(iw, t0, Q_BLOCK, axis=1)
        score = jnp.einsum('bqh,bqhs->bqs', iwb,
                           jax.nn.relu(jnp.einsum('bqhd,bsd->bqhs', iqb, ik)))
        score = jnp.where(pos[None, None, :] <= tq[None, :, None], score, -jnp.inf)
        _, idx = lax.top_k(score, topk)
        ks = jax.vmap(lambda kb, ib: kb[ib])(k, idx)
        vs = jax.vmap(lambda vb, ib: vb[ib])(v, idx)
        return attend(qb, ks, vs, idx <= tq[None, :, None])

    o = lax.map(block, jnp.arange(T // Q_BLOCK))
    return jnp.moveaxis(o, 0, 1).reshape(B, T, A_HEADS * HEAD_DIM)


def rwkv7_mixer(zb, mu, w0, w2, a0, a2, g2, k_k, k_a, r_k, ln_w, ln_b):
    B, T, _ = zb.shape
    f32 = jnp.float32
    z_prev = jnp.pad(zb, ((0, 0), (1, 0), (0, 0)))[:, :-1]
    z = zb + (z_prev - zb) * mu
    r, k, v, wd, ad, gd = split_cols(z, B_COLS)
    w_log = -jax.nn.softplus(-(w0 + jnp.tanh(wd) @ w2).astype(f32)) - 0.5
    decay = jnp.exp(-jnp.exp(w_log))
    a = jax.nn.sigmoid((a0 + ad @ a2).astype(f32))
    g = jax.nn.sigmoid(gd) @ g2
    hs = lambda t: t.reshape(B, T, B_HEADS, HEAD_DIM)
    kk = hs((k * k_k).astype(f32))
    kk = kk / jnp.maximum(jnp.linalg.norm(kk, axis=-1, keepdims=True), 1e-12)
    k = hs(k.astype(f32) * (1.0 + (a - 1.0) * k_a))
    r, v, a, decay = hs(r.astype(f32)), hs(v.astype(f32)), hs(a), hs(decay)

    def step(S, inp):
        r_t, w_t, k_t, v_t, kk_t, a_t = inp
        sa = jnp.einsum('bhij,bhj->bhi', S, kk_t)
        S = (S * w_t[:, :, None, :] - sa[..., None] * (kk_t * a_t)[:, :, None, :]
             + v_t[..., None] * k_t[:, :, None, :])
        return S, jnp.einsum('bhij,bhj->bhi', S, r_t)

    xs = tuple(jnp.moveaxis(t, 1, 0) for t in (r, decay, k, v, kk, a))
    S0 = jnp.zeros((B, B_HEADS, HEAD_DIM, HEAD_DIM), f32)
    _, y = lax.scan(step, S0, xs)
    y = jnp.moveaxis(y, 0, 1)
    mean = jnp.mean(y, axis=-1, keepdims=True)
    var = jnp.mean((y - mean) ** 2, axis=-1, keepdims=True)
    y = ((y - mean) * lax.rsqrt(var + GN_EPS)).reshape(B, T, B_WIDTH) * ln_w + ln_b
    bonus = jnp.sum(r * k * r_k, axis=-1, keepdims=True) * v
    y = (y + bonus.reshape(B, T, B_WIDTH)) * g
    return y.astype(zb.dtype)


def nsa_mixer(q, kc, vc, ks, vs, kw, vw, gates, q_g, k_g, pe, w1, w2):
    B, T = q.shape[:2]
    f32 = jnp.float32
    pos = jnp.arange(T)
    scale = HEAD_DIM ** -0.5
    q = rope(rms_norm(q, q_g), pos[:, None])
    n_cmp = (T - CMP_LEN) // CMP_STRIDE + 1
    starts = np.arange(n_cmp) * CMP_STRIDE
    end_pos = starts + CMP_LEN - 1
    blk_idx = starts[:, None] + np.arange(CMP_LEN)[None, :]

    def compress(x, j):
        blk = x[:, blk_idx] + pe[j]
        h = jax.nn.gelu(blk.reshape(B, n_cmp, CMP_LEN * HEAD_DIM) @ w1[j])
        return h @ w2[j]

    k_cmp = rope(rms_norm(compress(kc, 0), k_g), jnp.asarray(end_pos))
    v_cmp = compress(vc, 1)
    s = jnp.einsum('bthd,bnd->bhtn', q, k_cmp, preferred_element_type=f32) * scale
    cmp_valid = jnp.asarray(end_pos)[None, :] <= pos[:, None]
    p = jax.nn.softmax(jnp.where(cmp_valid, s, NEG), axis=-1) * cmp_valid
    o_cmp = jnp.einsum('bhtn,bnd->bthd', p.astype(vc.dtype), v_cmp)
    n_blk = T // SEL_LEN
    sel_start = np.arange(n_blk) * SEL_LEN
    overlap = ((starts[:, None] <= sel_start[None, :] + SEL_LEN - 1)
               & (end_pos[:, None] >= sel_start[None, :])).astype(np.float32)
    imp = jnp.einsum('bhtn,nj->btj', p, jnp.asarray(overlap))
    blk = jnp.arange(n_blk)
    cur = pos // SEL_LEN
    admissible = blk[None, :] * SEL_LEN <= pos[:, None]
    forced = (blk[None, :] == 0) | (blk[None, :] == cur[:, None]) | (blk[None, :] == cur[:, None] - 1)
    imp = jnp.where(admissible, jnp.where(forced, jnp.inf, imp), -jnp.inf)
    top_n = min(SEL_TOPN, n_blk)
    _, sel = lax.top_k(imp, top_n)
    ks = rope(rms_norm(ks, k_g), pos)
    kw = rope(rms_norm(kw, k_g), pos)
    ks_blk = ks.reshape(B, n_blk, SEL_LEN, HEAD_DIM)
    vs_blk = vs.reshape(B, n_blk, SEL_LEN, HEAD_DIM)
    kw_pad = jnp.pad(kw, ((0, 0), (WIN, 0), (0, 0)))
    vw_pad = jnp.pad(vw, ((0, 0), (WIN, 0), (0, 0)))
    in_blk = jnp.arange(SEL_LEN)

    def block(i):
        t0 = i * Q_BLOCK
        tq = t0 + jnp.arange(Q_BLOCK)
        qb = lax.dynamic_slice_in_dim(q, t0, Q_BLOCK, axis=1)
        selb = lax.dynamic_slice_in_dim(sel, t0, Q_BLOCK, axis=1)
        kg = jax.vmap(lambda kb, ib: kb[ib])(ks_blk, selb).reshape(B, Q_BLOCK, top_n * SEL_LEN, HEAD_DIM)
        vg = jax.vmap(lambda vb, ib: vb[ib])(vs_blk, selb).reshape(B, Q_BLOCK, top_n * SEL_LEN, HEAD_DIM)
        kpos = (selb[..., None] * SEL_LEN + in_blk).reshape(B, Q_BLOCK, top_n * SEL_LEN)
        o_slc = attend(qb, kg, vg, kpos <= tq[None, :, None])
        kwb = lax.dynamic_slice_in_dim(kw_pad, t0, WIN + Q_BLOCK, axis=1)
        vwb = lax.dynamic_slice_in_dim(vw_pad, t0, WIN + Q_BLOCK, axis=1)
        wpos = t0 - WIN + jnp.arange(WIN + Q_BLOCK)
        wvalid = ((wpos[None, :] <= tq[:, None]) & (wpos[None, :] > tq[:, None] - WIN)
                  & (wpos[None, :] >= 0))
        sw = jnp.einsum('bqhd,bkd->bqhk', qb, kwb, preferred_element_type=f32) * scale
        sw = jnp.where(wvalid[None, :, None, :], sw, -jnp.inf)
        o_win = jnp.einsum('bqhk,bkd->bqhd', jax.nn.softmax(sw, axis=-1).astype(vwb.dtype), vwb)
        return o_slc, o_win

    o_slc, o_win = lax.map(block, jnp.arange(T // Q_BLOCK))
    unblock = lambda o: jnp.moveaxis(o, 0, 1).reshape(B, T, C_HEADS, HEAD_DIM)
    g = jax.nn.sigmoid(gates.astype(f32)).reshape(B, T, C_HEADS, 3)
    o = g[..., 0:1] * o_cmp + g[..., 1:2] * unblock(o_slc) + g[..., 2:3] * unblock(o_win)
    return o.reshape(B, T, C_HEADS * HEAD_DIM).astype(q.dtype)


def setup_inputs(seed: int = 0) -> dict:
    key = jax.random.key(seed)
    ks = iter(jax.random.split(key, 32))
    nrm = lambda shape, s: jax.random.normal(next(ks), shape, jnp.float32) * s
    L, D = DEPTH, D_MODEL
    return {
        'x': nrm((BATCH, SEQ, D), 1.0),
        'c': nrm((BATCH, D), 1.0),
        'ada_w': nrm((L, D, 6 * D), 0.5 * D ** -0.5),
        'ada_b': nrm((L, 6 * D), 0.01),
        'norm1_g': 1.0 + nrm((L, D), 0.02),
        'w_in': nrm((L, D, IN_COLS), D ** -0.5),
        'dsa_q_g': 1.0 + nrm((L, HEAD_DIM), 0.02),
        'dsa_k_g': 1.0 + nrm((L, HEAD_DIM), 0.02),
        'rwkv_mu': jax.random.uniform(next(ks), (L, sum(B_COLS)), jnp.float32),
        'rwkv_w0': nrm((L, B_WIDTH), 0.5),
        'rwkv_w2': nrm((L, DECAY_LORA, B_WIDTH), DECAY_LORA ** -0.5),
        'rwkv_a0': nrm((L, B_WIDTH), 0.1),
        'rwkv_a2': nrm((L, AAA_LORA, B_WIDTH), AAA_LORA ** -0.5),
        'rwkv_g2': nrm((L, GATE_LORA, B_WIDTH), GATE_LORA ** -0.5),
        'rwkv_k_k': 0.85 + nrm((L, B_WIDTH), 0.05),
        'rwkv_k_a': 1.0 + nrm((L, B_WIDTH), 0.05),
        'rwkv_r_k': nrm((L, B_HEADS, HEAD_DIM), 0.1),
        'rwkv_ln_w': 1.0 + nrm((L, B_WIDTH), 0.02),
        'rwkv_ln_b': nrm((L, B_WIDTH), 0.01),
        'nsa_q_g': 1.0 + nrm((L, HEAD_DIM), 0.02),
        'nsa_k_g': 1.0 + nrm((L, HEAD_DIM), 0.02),
        'nsa_pe': nrm((L, 2, CMP_LEN, HEAD_DIM), 0.02),
        'nsa_w1': nrm((L, 2, CMP_LEN * HEAD_DIM, CMP_HID), (CMP_LEN * HEAD_DIM) ** -0.5),
        'nsa_w2': nrm((L, 2, CMP_HID, HEAD_DIM), CMP_HID ** -0.5),
        'w_out': nrm((L, MIX_WIDTH, D), MIX_WIDTH ** -0.5),
        'norm2_g': 1.0 + nrm((L, D), 0.02),
        'ffn_wi': nrm((L, D, 2 * FFN_HIDDEN), D ** -0.5),
        'ffn_wo': nrm((L, FFN_HIDDEN, D), FFN_HIDDEN ** -0.5),
    }


def reference(x, c, ada_w, ada_b, norm1_g, w_in, dsa_q_g, dsa_k_g, rwkv_mu, rwkv_w0, rwkv_w2,
              rwkv_a0, rwkv_a2, rwkv_g2, rwkv_k_k, rwkv_k_a, rwkv_r_k, rwkv_ln_w, rwkv_ln_b,
              nsa_q_g, nsa_k_g, nsa_pe, nsa_w1, nsa_w2, w_out, norm2_g, ffn_wi, ffn_wo):
    B, T, _ = x.shape
    for l in range(DEPTH):
        mod = jax.nn.silu(c) @ ada_w[l] + ada_b[l]
        sh1, sc1, g1, sh2, sc2, g2 = jnp.split(mod[:, None, :], 6, axis=-1)
        h = rms_norm(x, norm1_g[l]) * (1.0 + sc1) + sh1
        z = h @ w_in[l]
        za, zb, zc = split_cols(z, (sum(A_COLS), sum(B_COLS), sum(C_COLS)))
        qa, ka, va, iq, ik, iw = split_cols(za, A_COLS)
        o_a = dsa_mixer(qa.reshape(B, T, A_HEADS, HEAD_DIM), ka, va,
                        iq.reshape(B, T, IDX_HEADS, IDX_DIM), ik, iw, dsa_q_g[l], dsa_k_g[l])
        o_b = rwkv7_mixer(zb, rwkv_mu[l], rwkv_w0[l], rwkv_w2[l], rwkv_a0[l], rwkv_a2[l], rwkv_g2[l],
                          rwkv_k_k[l], rwkv_k_a[l], rwkv_r_k[l], rwkv_ln_w[l], rwkv_ln_b[l])
        qc, kvc, gc = split_cols(zc, C_COLS)
        kc, vc, ksl, vsl, kwn, vwn = jnp.split(kvc, 6, axis=-1)
        o_c = nsa_mixer(qc.reshape(B, T, C_HEADS, HEAD_DIM), kc, vc, ksl, vsl, kwn, vwn, gc,
                        nsa_q_g[l], nsa_k_g[l], nsa_pe[l], nsa_w1[l], nsa_w2[l])
        mixed = jnp.concatenate([o_a, o_b, o_c], axis=-1) @ w_out[l]
        x = x + g1 * mixed
        h = rms_norm(x, norm2_g[l]) * (1.0 + sc2) + sh2
        gate, up = jnp.split(h @ ffn_wi[l], 2, axis=-1)
        x = x + g2 * ((jax.nn.silu(gate) * up) @ ffn_wo[l])
    return x
```

```cpp
#include <hip/hip_runtime.h>
#include <hip/hip_cooperative_groups.h>
#include <cstdio>
#include <cstdint>
namespace cg = cooperative_groups;

typedef _Float16 h16;
typedef _Float16 half8 __attribute__((ext_vector_type(8)));
typedef _Float16 half4 __attribute__((ext_vector_type(4)));
typedef float f32x4 __attribute__((ext_vector_type(4)));
typedef float f32x16 __attribute__((ext_vector_type(16)));
#define LAS __attribute__((address_space(3)))
#define DI __device__ __forceinline__

constexpr int D = 1024, NB = 8, T = 2048, M = NB * T, FF = 2816, DEPTH = 2;
constexpr int ZC = 3328;
constexpr int C_QA = 0, C_KA = 256, C_VA = 320, C_IQ = 384, C_IK = 640, C_IW = 704;
constexpr int C_R = 768, C_K = 1280, C_V = 1792, C_WD = 2304;
constexpr int C_QC = 2560, C_KC = 2816, C_VC = 2880, C_KS = 2944, C_VS = 3008, C_KW = 3072, C_VW = 3136, C_GC = 3200;
constexpr int NTHREADS = 512;
constexpr int LDS_BYTES = 139264;

constexpr size_t MiB = 1u << 20;
constexpr size_t WS_CTL = 0;
constexpr size_t WS_PTRS = 60 * 1024;
constexpr size_t WS_MOD = 64 * 1024;
constexpr size_t WS_CBIAS = 512 * 1024;
constexpr size_t WS_KCMP = 1 * MiB;
constexpr size_t WS_VCMPT = 1 * MiB + 128 * 1024;
constexpr size_t WS_HID = 2 * MiB;
constexpr size_t WS_KA = 4 * MiB, WS_IK = 6 * MiB, WS_KS = 8 * MiB, WS_KW = 10 * MiB;
constexpr size_t WS_VAT = 12 * MiB, WS_VST = 14 * MiB, WS_VWT = 16 * MiB;
constexpr size_t WS_DMASK = 18 * MiB;
constexpr size_t WS_WIN = 22 * MiB;
constexpr size_t WS_WOUT = WS_WIN + 6656 * 1024;
constexpr size_t WS_WI = WS_WOUT + 2 * MiB;
constexpr size_t WS_WO = WS_WI + 11 * MiB;
constexpr size_t WS_W1 = WS_WO + 5632 * 1024;
constexpr size_t WS_WL = WS_W1 + 2 * MiB;
constexpr size_t WS_ACT = 50 * MiB;
constexpr size_t WS_L16 = WS_ACT, WS_KC = WS_ACT + 8 * MiB, WS_VC = WS_ACT + 12 * MiB;
constexpr size_t WS_DEC = 82 * MiB, WS_A = 98 * MiB, WS_G = 114 * MiB;
constexpr size_t WS_Z = 130 * MiB;
constexpr size_t WS_END = 234 * MiB;
static_assert(WS_WL + 768 * 1024 <= WS_ACT, "weights fit");

struct Params { const float* in[28]; float* out; unsigned char* ws; };
enum { I_X = 0, I_C, I_ADAW, I_ADAB, I_N1G, I_WIN, I_DQG, I_DKG, I_MU, I_W0, I_W2, I_A0, I_A2, I_G2, I_KK, I_KA, I_RK, I_LNW, I_LNB,
       I_NQG, I_NKG, I_PE, I_NW1, I_NW2, I_WOUT, I_N2G, I_FWI, I_FWO };

template <int CTRL> DI float dpp_f(float x) { return __builtin_bit_cast(float, __builtin_amdgcn_update_dpp(0, __builtin_bit_cast(int, x), CTRL, 0xF, 0xF, true)); }
DI float quad_sum(float x) { x += dpp_f<0xB1>(x); x += dpp_f<0x4E>(x); return x; }
DI float red8(float x) { x += dpp_f<0xB1>(x); x += dpp_f<0x4E>(x); x += dpp_f<0x141>(x); return x; }
DI float red16(float x) { x += __shfl_xor(x, 1); x += __shfl_xor(x, 2); x += __shfl_xor(x, 4); x += __shfl_xor(x, 8); return x; }
DI float wave_sum(float x) { for (int o = 1; o < 64; o <<= 1) x += __shfl_xor(x, o); return x; }
DI float sigmoidf_(float x) { return 1.f / (1.f + __expf(-x)); }
DI int crow(int i, int h) { return (i & 3) + 8 * (i >> 2) + 4 * h; }
#define WSYNC() asm volatile("s_waitcnt lgkmcnt(0)" ::: "memory")
#define MFMA32(a, b, c) __builtin_amdgcn_mfma_f32_32x32x16_f16((a), (b), (c), 0, 0, 0)

template <class Tp> DI Tp* launder_ptr(Tp* p) {
    unsigned lo = (unsigned)(uintptr_t)p, hi = (unsigned)((uintptr_t)p >> 32); asm volatile("" : "+v"(lo), "+v"(hi));
    lo = __builtin_amdgcn_readfirstlane(lo); hi = __builtin_amdgcn_readfirstlane(hi); return (Tp*)(((uintptr_t)hi << 32) | lo); }
__shared__ int s_item;
DI int next_item(unsigned* ctr) {
    __syncthreads();
    if (threadIdx.x == 0) s_item = (int)atomicAdd(ctr, 1u);
    __syncthreads();
    return s_item;
}

constexpr int BK = 64, HALF = 128, HT = HALF * BK;
DI void stage_rc(int b, int& R, int& C) { int st = b / 1024, sb = b % 1024, swz = sb ^ (((sb >> 9) & 1) << 5); R = (st >> 1) * 16 + swz / 64; C = (st & 1) * 32 + (swz % 64) / 2; }

template <class Epi>
DI void gemm_unit(const h16* __restrict__ A, int lda, const h16* __restrict__ Bt, int ldb, int K, int brow, int bcol, h16* shm, const Epi& epi) {
#define SA(b, h) (shm + ((b) * 2 + (h)) * HT)
#define SB(b, h) (shm + (4 + (b) * 2 + (h)) * HT)
#define STAGE_A(P, br, kt) do { const h16* _g = A + ((long)(br) * lda + (long)(kt) * BK); \
    __builtin_amdgcn_global_load_lds((const unsigned*)(_g + oa0), (LAS unsigned*)((char*)(P) + tidx * 16), 16, 0, 0); \
    __builtin_amdgcn_global_load_lds((const unsigned*)(_g + oa1), (LAS unsigned*)((char*)(P) + tidx * 16 + 8192), 16, 0, 0); } while (0)
#define STAGE_B(P, br, kt) do { const h16* _g = Bt + ((long)(br) * ldb + (long)(kt) * BK); \
    __builtin_amdgcn_global_load_lds((const unsigned*)(_g + ob0), (LAS unsigned*)((char*)(P) + tidx * 16), 16, 0, 0); \
    __builtin_amdgcn_global_load_lds((const unsigned*)(_g + ob1), (LAS unsigned*)((char*)(P) + tidx * 16 + 8192), 16, 0, 0); } while (0)
#define LDA(dst, b, h) _Pragma("unroll") for (int m = 0; m < 4; ++m) _Pragma("unroll") for (int k = 0; k < 2; ++k) dst[m][k] = *reinterpret_cast<const half8*>((char*)SA(b, h) + la + (m * 2 + k) * 1024)
#define LDB(dst, b, h) _Pragma("unroll") for (int n = 0; n < 2; ++n) _Pragma("unroll") for (int k = 0; k < 2; ++k) dst[n][k] = *reinterpret_cast<const half8*>((char*)SB(b, h) + lb + (n * 2 + k) * 1024)
#define MMA(ai, bj, At_, Bt_) do { __builtin_amdgcn_s_setprio(1); \
    _Pragma("unroll") for (int m = 0; m < 4; ++m) _Pragma("unroll") for (int n = 0; n < 2; ++n) _Pragma("unroll") for (int k = 0; k < 2; ++k) \
        acc[ai][bj][m][n] = __builtin_amdgcn_mfma_f32_16x16x32_f16(Bt_[n][k], At_[m][k], acc[ai][bj][m][n], 0, 0, 0); \
    __builtin_amdgcn_s_setprio(0); } while (0)
#define WAIT_V(n) asm volatile("s_waitcnt vmcnt(" #n ")" ::: "memory")
#define WAIT_L(n) asm volatile("s_waitcnt lgkmcnt(" #n ")" ::: "memory")
#define BAR __builtin_amdgcn_s_barrier()
#define SCHED __builtin_amdgcn_sched_barrier(0)
    int tidx = threadIdx.x; asm volatile("" : "+v"(tidx));
    const int wid = tidx >> 6, lane = tidx & 63, wr = wid >> 2, wc = wid & 3, fr = lane & 15, fq = lane >> 4;
    const int lpart = ((fr * 64 + fq * 16) ^ ((fr >> 3) << 5));
    const int la = wr * 8192 + lpart, lb = wc * 4096 + lpart;
    int oa0, oa1, ob0, ob1;
    { int _r, _c; stage_rc(tidx * 16, _r, _c); oa0 = _r * lda + _c; ob0 = _r * ldb + _c; stage_rc(tidx * 16 + 8192, _r, _c); oa1 = _r * lda + _c; ob1 = _r * ldb + _c; }
    f32x4 acc[2][2][4][2] = {};
    half8 At[4][2], B0[2][2], B1[2][2];
    const int nt = K / BK;
    STAGE_B(SB(0, 0), bcol, 0); STAGE_A(SA(0, 0), brow, 0);
    STAGE_B(SB(0, 1), bcol + HALF, 0); STAGE_A(SA(0, 1), brow + HALF, 0);
    if (wr == 1) BAR;
    WAIT_V(4); BAR;
    STAGE_B(SB(1, 0), bcol, 1); STAGE_A(SA(1, 0), brow, 1); STAGE_B(SB(1, 1), bcol + HALF, 1);
    WAIT_V(6); BAR;
    for (int t = 0; t < nt - 2; t += 2) {
        LDB(B0, 0, 0); SCHED; LDA(At, 0, 0); STAGE_A(SA(1, 1), brow + HALF, t + 1);
        WAIT_L(8); BAR; WAIT_L(0); MMA(0, 0, At, B0); BAR; SCHED;
        LDB(B1, 0, 1); STAGE_B(SB(0, 0), bcol, t + 2);
        BAR; WAIT_L(0); MMA(0, 1, At, B1); BAR;
        LDA(At, 0, 1); STAGE_A(SA(0, 0), brow, t + 2);
        BAR; WAIT_L(0); MMA(1, 0, At, B0); BAR; SCHED;
        STAGE_B(SB(0, 1), bcol + HALF, t + 2);
        WAIT_V(6); BAR; MMA(1, 1, At, B1); BAR;
        LDB(B0, 1, 0); SCHED; LDA(At, 1, 0); STAGE_A(SA(0, 1), brow + HALF, t + 2);
        WAIT_L(8); BAR; WAIT_L(0); MMA(0, 0, At, B0); BAR; SCHED;
        LDB(B1, 1, 1); STAGE_B(SB(1, 0), bcol, t + 3);
        BAR; WAIT_L(0); MMA(0, 1, At, B1); BAR;
        LDA(At, 1, 1); STAGE_A(SA(1, 0), brow, t + 3);
        BAR; WAIT_L(0); MMA(1, 0, At, B0); BAR; SCHED;
        STAGE_B(SB(1, 1), bcol + HALF, t + 3);
        WAIT_V(6); BAR; MMA(1, 1, At, B1); BAR;
    }
    { LDB(B0, 0, 0); LDA(At, 0, 0); STAGE_A(SA(1, 1), brow + HALF, nt - 1);
      BAR; WAIT_L(0); MMA(0, 0, At, B0); BAR;
      LDB(B1, 0, 1); BAR; WAIT_L(0); MMA(0, 1, At, B1); BAR;
      LDA(At, 0, 1); WAIT_V(4); BAR; WAIT_L(0); MMA(1, 0, At, B0); MMA(1, 1, At, B1); BAR; }
    { LDB(B0, 1, 0); LDA(At, 1, 0); WAIT_V(2); BAR; WAIT_L(0); MMA(0, 0, At, B0); BAR;
      LDB(B1, 1, 1); WAIT_V(0); BAR; WAIT_L(0); MMA(0, 1, At, B1); BAR;
      LDA(At, 1, 1); BAR; WAIT_L(0); MMA(1, 0, At, B0); MMA(1, 1, At, B1); BAR; }
    if (wr == 0) BAR;
    epi(acc, brow + wr * 64 + fr, bcol + wc * 32 + fq * 4);
    __syncthreads();
}
DI bool unit_order(int L, int nM, int nN, int& pm, int& pn) {
    const int nwg = nM * nN; if (L >= nwg) return false;
    int wgid = L; { const int q = nwg / 8, r = nwg % 8, xcd = wgid % 8, off = wgid / 8; wgid = (xcd < r ? xcd * (q + 1) : r * (q + 1) + (xcd - r) * q) + off; }
    const int nig = 8 * nN, gid = wgid / nig, fm = gid * 8, gsz = (nM - fm) < 8 ? (nM - fm) : 8;
    pm = fm + ((wgid % nig) % gsz); pn = (wgid % nig) / gsz; return true;
}
typedef f32x4 Acc[2][2][4][2];
#define EPI_LOOP _Pragma("unroll") for (int ai = 0; ai < 2; ++ai) _Pragma("unroll") for (int bj = 0; bj < 2; ++bj) _Pragma("unroll") for (int m = 0; m < 4; ++m) _Pragma("unroll") for (int n = 0; n < 2; ++n)
struct EpiZ { h16* z; int ld;
    DI void operator()(Acc& acc, int r0, int c0) const { EPI_LOOP { const int row = r0 + ai * 128 + m * 16, col = c0 + bj * 128 + n * 16;
        half4 v; _Pragma("unroll") for (int j = 0; j < 4; ++j) v[j] = (h16)acc[ai][bj][m][n][j]; *(half4*)(z + (size_t)row * ld + col) = v; } } };
struct EpiLora { h16 *dec, *a, *g; const float *w0, *a0;
    DI void operator()(Acc& acc, int r0, int c0) const { EPI_LOOP { const int row = r0 + ai * 128 + m * 16, col = c0 + bj * 128 + n * 16; half4 v;
        if (col < 512) { _Pragma("unroll") for (int j = 0; j < 4; ++j) { const float lw = w0[col + j] + acc[ai][bj][m][n][j]; v[j] = (h16)__expf(-0.60653066f * sigmoidf_(lw)); } *(half4*)(dec + (size_t)row * 512 + col) = v; }
        else if (col < 1024) { _Pragma("unroll") for (int j = 0; j < 4; ++j) v[j] = (h16)sigmoidf_(a0[col - 512 + j] + acc[ai][bj][m][n][j]); *(half4*)(a + (size_t)row * 512 + col - 512) = v; }
        else { _Pragma("unroll") for (int j = 0; j < 4; ++j) v[j] = (h16)acc[ai][bj][m][n][j]; *(half4*)(g + (size_t)row * 512 + col - 1024) = v; } } } };
struct EpiCmp { h16* hid; const float* bias;
    DI void operator()(Acc& acc, int r0, int c0) const { EPI_LOOP { const int row = r0 + ai * 128 + m * 16, col = c0 + bj * 128 + n * 16; half4 v;
        _Pragma("unroll") for (int j = 0; j < 4; ++j) { const float x = acc[ai][bj][m][n][j] + bias[col + j]; const float u = 0.7978845608f * (x + 0.044715f * x * x * x);
            const float th = 1.f - 2.f / (1.f + __expf(2.f * u)); v[j] = (h16)(0.5f * x * (1.f + th)); }
        *(half4*)(hid + (size_t)row * 256 + col) = v; } } };
struct EpiRes { const float* xin; float* xout; const float* gate;
    DI void operator()(Acc& acc, int r0, int c0) const { EPI_LOOP { const int row = r0 + ai * 128 + m * 16, col = c0 + bj * 128 + n * 16;
        const f32x4 xi = *(const f32x4*)(xin + (size_t)row * D + col); const f32x4 gg = *(const f32x4*)(gate + (size_t)(row >> 11) * 6144 + col);
        f32x4 o; _Pragma("unroll") for (int j = 0; j < 4; ++j) o[j] = xi[j] + gg[j] * acc[ai][bj][m][n][j]; *(f32x4*)(xout + (size_t)row * D + col) = o; } } };
struct EpiSwiglu { h16* hid;
    DI void operator()(Acc& acc, int r0, int c0) const { _Pragma("unroll") for (int ai = 0; ai < 2; ++ai) _Pragma("unroll") for (int m = 0; m < 4; ++m) _Pragma("unroll") for (int n = 0; n < 2; ++n) {
        const int row = r0 + ai * 128 + m * 16; const int tcol = c0 & 255, pn = c0 >> 8; const int col = pn * 128 + tcol + n * 16; half4 v;
        _Pragma("unroll") for (int j = 0; j < 4; ++j) { const float gt = acc[ai][0][m][n][j], up = acc[ai][1][m][n][j]; v[j] = (h16)(gt * sigmoidf_(gt) * up); }
        *(half4*)(hid + (size_t)row * FF + col) = v; } } };

struct Ctx {
    float* out; unsigned char* ws; char* lds; unsigned* ctl;
    int tid, lane, wave, gw, ngw;
    template <class Tp> DI Tp* W(size_t off) const { return (Tp*)(ws + off); }
    DI const float* inp(int i) const { return ((const float* const*)(ws + WS_PTRS))[i]; }
    DI const float* inl(int i, int l, size_t per_layer) const { return inp(i) + (size_t)l * per_layer; }
};

template <class CM>
DI void tr_item(const float* __restrict__ Wsrc, int K, int Nsrc, h16* WT, int k0, int n0, float* scr, int lane, CM cm) {
    const int sc = cm(n0 + (lane & 31));
#pragma unroll 8
    for (int i = 0; i < 32; ++i) { const int kk = 2 * i + (lane >> 5); scr[kk * 33 + (lane & 31)] = sc >= 0 ? Wsrc[(size_t)(k0 + kk) * Nsrc + sc] : 0.f; }
    WSYNC();
    const int c = lane & 7;
#pragma unroll
    for (int j = 0; j < 4; ++j) { const int n = (lane >> 3) + 8 * j; const float* s = scr + (8 * c) * 33 + n; half8 o;
        _Pragma("unroll") for (int q = 0; q < 8; ++q) o[q] = (h16)s[q * 33];
        *(half8*)(WT + (size_t)(n0 + n) * K + k0 + 8 * c) = o; }
    WSYNC();
}
DI void convert_weights(const Ctx& c, int l) {
    float* scr = (float*)(c.lds + c.wave * 8448);
    constexpr int I_IN = 16 * 104, I_OUT = 16 * 32, I_FI = 16 * 176, I_FO = 44 * 32, I_W1 = 32 * 8;
    constexpr int NIT = I_IN + I_OUT + I_FI + I_FO + 2 * I_W1;
    for (int it = c.gw; it < NIT; it += c.ngw) {
        int r = it;
        if (r < I_IN) { tr_item(c.inl(I_WIN, l, (size_t)D * 3152), D, 3152, c.W<h16>(WS_WIN), (r / 104) * 64, (r % 104) * 32, scr, c.lane,
                                [](int n) { return n < 708 ? n : (n < 768 ? -1 : (n < 3212 ? n - 60 : -1)); }); continue; } r -= I_IN;
        if (r < I_OUT) { tr_item(c.inl(I_WOUT, l, (size_t)D * D), D, D, c.W<h16>(WS_WOUT), (r / 32) * 64, (r % 32) * 32, scr, c.lane, [](int n) { return n; }); continue; } r -= I_OUT;
        if (r < I_FI) { tr_item(c.inl(I_FWI, l, (size_t)D * 2 * FF), D, 2 * FF, c.W<h16>(WS_WI), (r / 176) * 64, (r % 176) * 32, scr, c.lane,
                                [](int n) { const int pn = n >> 8, q = n & 255; return q < 128 ? pn * 128 + q : FF + pn * 128 + (q - 128); }); continue; } r -= I_FI;
        if (r < I_FO) { tr_item(c.inl(I_FWO, l, (size_t)FF * D), FF, D, c.W<h16>(WS_WO), (r / 32) * 64, (r % 32) * 32, scr, c.lane, [](int n) { return n; }); continue; } r -= I_FO;
        const int j = r / I_W1; r %= I_W1;
        tr_item(c.inl(I_NW1, l, (size_t)2 * 2048 * 256) + (size_t)j * 2048 * 256, 2048, 256, c.W<h16>(WS_W1) + (size_t)j * 256 * 2048, (r / 8) * 64, (r % 8) * 32, scr, c.lane, [](int n) { return n; });
    }
    const float* w2 = c.inl(I_W2, l, 64 * 512); const float* a2 = c.inl(I_A2, l, 64 * 512); const float* g2 = c.inl(I_G2, l, 128 * 512);
    h16* wl = c.W<h16>(WS_WL);
    for (int e = blockIdx.x * NTHREADS + c.tid; e < 1536 * 256; e += gridDim.x * NTHREADS) {
        const int n = e >> 8, k = e & 255; float v = 0.f;
        if (n < 512) { if (k < 64) v = w2[k * 512 + n]; }
        else if (n < 1024) { if (k >= 64 && k < 128) v = a2[(k - 64) * 512 + n - 512]; }
        else { if (k >= 128) v = g2[(k - 128) * 512 + n - 1024]; }
        wl[e] = (h16)v;
    }
}
template <int NV>
DI void gemv_item(const Ctx& c, const float* aL, int K, const float* __restrict__ Wsrc, int N, int n0, const float* bias, float* out, int out_stride, float* red) {
    const int nl = c.tid & 31, kc = c.tid >> 5, kper = K / 16;
    float acc[NV]; for (int v = 0; v < NV; ++v) acc[v] = 0.f;
    for (int k = kc * kper; k < (kc + 1) * kper; ++k) { const float w = Wsrc[(size_t)k * N + n0 + nl]; for (int v = 0; v < NV; ++v) acc[v] += aL[v * K + k] * w; }
    for (int v = 0; v < NV; ++v) red[(kc * NV + v) * 32 + nl] = acc[v];
    __syncthreads();
    if (c.tid < 32 * NV) { const int v = c.tid >> 5; float s = bias ? bias[n0 + nl] : 0.f; _Pragma("unroll") for (int q = 0; q < 16; ++q) s += red[(q * NV + v) * 32 + nl]; out[(size_t)v * out_stride + n0 + nl] = s; }
    __syncthreads();
}
DI void phase_mod(const Ctx& c) {
    float* sil = (float*)(c.lds + 70000); float* red = (float*)(c.lds + 70000 + 32768);
    for (int e = c.tid; e < 8 * 1024; e += NTHREADS) { const float x = c.inp(I_C)[e]; sil[e] = x * sigmoidf_(x); }
    __syncthreads();
    for (int it = blockIdx.x; it < 2 * 192; it += gridDim.x) { const int l = it / 192, n0 = (it % 192) * 32;
        gemv_item<8>(c, sil, 1024, c.inl(I_ADAW, l, (size_t)1024 * 6144), 6144, n0, c.inl(I_ADAB, l, 6144), c.W<float>(WS_MOD) + (size_t)l * 8 * 6144, 6144, red); }
}
DI void phase_cbias(const Ctx& c, int l) {
    float* pe = (float*)(c.lds + 70000); float* red = (float*)(c.lds + 70000 + 32768);
    __syncthreads();
    for (int e = c.tid; e < 2 * 2048; e += NTHREADS) pe[e] = c.inl(I_PE, l, 2 * 2048)[e];
    __syncthreads();
    for (int it = (int)gridDim.x - 1 - (int)blockIdx.x; it < 16; it += gridDim.x) { const int j = it >> 3, n0 = (it & 7) * 32;
        gemv_item<1>(c, pe + j * 2048, 2048, c.inl(I_NW1, l, (size_t)2 * 2048 * 256) + (size_t)j * 2048 * 256, 256, n0, nullptr, c.W<float>(WS_CBIAS) + j * 256, 256, red); }
}
DI void phase_norm(const Ctx& c, const float* x, const float* g, const float* mod_l, int sh_off, int sc_off) {
    h16* act = c.W<h16>(WS_ACT);
    for (int m = c.gw; m < M; m += c.ngw) {
        const f32x4* xr = (const f32x4*)(x + (size_t)m * D) + c.lane; f32x4 v[4]; float s = 0.f;
        _Pragma("unroll") for (int j = 0; j < 4; ++j) { v[j] = xr[64 * j]; s += v[j].x * v[j].x + v[j].y * v[j].y + v[j].z * v[j].z + v[j].w * v[j].w; }
        const float rstd = 1.f / sqrtf(wave_sum(s) * (1.f / D) + 1e-6f);
        const float* mb = mod_l + (size_t)(m >> 11) * 6144;
        _Pragma("unroll") for (int j = 0; j < 4; ++j) { const int col = 4 * c.lane + 256 * j; const f32x4 gg = *(const f32x4*)(g + col), sc = *(const f32x4*)(mb + sc_off + col), sh = *(const f32x4*)(mb + sh_off + col);
            half4 o; _Pragma("unroll") for (int q = 0; q < 4; ++q) o[q] = (h16)(v[j][q] * rstd * gg[q] * (1.f + sc[q]) + sh[q]);
            *(half4*)(act + (size_t)m * D + col) = o; }
    }
}
template <class Epi>
DI void phase_gemm(const Ctx& c, const h16* A, int lda, const h16* Bt, int ldb, int K, int nM, int nN, const Epi& epi) {
    for (int i = 0;; ++i) { int pm, pn; if (!unit_order(i * (int)gridDim.x + (int)blockIdx.x, nM, nN, pm, pn)) break;
        gemm_unit(A, lda, Bt, ldb, K, pm * 256, pn * 256, (h16*)c.lds, epi); }
}

DI void phase_prep(const Ctx& c, int l) {
    h16* Z = c.W<h16>(WS_Z);
    const float* dqg = c.inl(I_DQG, l, 64); const float* dkg = c.inl(I_DKG, l, 64); const float* nqg = c.inl(I_NQG, l, 64); const float* nkg = c.inl(I_NKG, l, 64);
    const float* mu = c.inl(I_MU, l, 1792);
    const int lane = c.lane; const bool hi = lane >= 32;
    const float inv = powf(10000.f, -(float)(lane & 31) * (1.f / 32.f));
    const float g_dq = dqg[lane], g_dk = dkg[lane], g_nq = nqg[lane], g_nk = nkg[lane];
    for (int m = c.gw; m < M; m += c.ngw) {
        const int b = m >> 11, t = m & 2047; h16* zr = Z + (size_t)m * ZC;
        const float ang = (float)t * inv; const float cs = cosf(ang), sn = sinf(ang);
        auto rope = [&](float x) { const float o = __shfl_xor(x, 32); return hi ? x * cs + o * sn : x * cs - o * sn; };
        auto normrope = [&](float x, float g) { const float ss = wave_sum(x * x); return rope(x * (1.f / sqrtf(ss * (1.f / 64.f) + 1e-6f)) * g); };
        _Pragma("unroll") for (int h = 0; h < 4; ++h) { h16* p = zr + C_QA + h * 64 + lane; *p = (h16)(normrope((float)*p, g_dq) * 0.125f); }
        c.W<h16>(WS_KA)[(size_t)m * 64 + lane] = (h16)normrope((float)zr[C_KA + lane], g_dk);
        c.W<h16>(WS_VAT)[((size_t)b * 64 + lane) * T + t] = zr[C_VA + lane];
        _Pragma("unroll") for (int h = 0; h < 4; ++h) { h16* p = zr + C_IQ + h * 64 + lane; *p = (h16)rope((float)*p); }
        c.W<h16>(WS_IK)[(size_t)m * 64 + lane] = (h16)rope((float)zr[C_IK + lane]);
        _Pragma("unroll") for (int h = 0; h < 4; ++h) { h16* p = zr + C_QC + h * 64 + lane; *p = (h16)(normrope((float)*p, g_nq) * 0.125f); }
        c.W<h16>(WS_KC)[(size_t)m * 64 + lane] = zr[C_KC + lane];
        c.W<h16>(WS_VC)[(size_t)m * 64 + lane] = zr[C_VC + lane];
        c.W<h16>(WS_KS)[(size_t)m * 64 + lane] = (h16)normrope((float)zr[C_KS + lane], g_nk);
        c.W<h16>(WS_VST)[((size_t)b * 64 + lane) * T + t] = zr[C_VS + lane];
        c.W<h16>(WS_KW)[(size_t)m * 64 + lane] = (h16)normrope((float)zr[C_KW + lane], g_nk);
        c.W<h16>(WS_VWT)[((size_t)b * 64 + lane) * T + t] = zr[C_VW + lane];
        { const int c4 = lane * 4; const half4 zc = *(const half4*)(zr + C_WD + c4); half4 zp = {0, 0, 0, 0}; if (t > 0) zp = *(const half4*)(zr - ZC + C_WD + c4);
          half4 o; _Pragma("unroll") for (int q = 0; q < 4; ++q) { const float a = (float)zc[q], v = a + ((float)zp[q] - a) * mu[1536 + c4 + q];
              o[q] = (h16)(c4 < 64 ? tanhf(v) : (c4 < 128 ? v : sigmoidf_(v))); }
          *(half4*)(c.W<h16>(WS_L16) + (size_t)m * 256 + c4) = o; }
    }
}

constexpr int SCS = 2056;
DI unsigned sortable(float v) { if (v == 0.f) v = 0.f; const unsigned u = __builtin_bit_cast(unsigned, v); return (u & 0x80000000u) ? ~u : (u | 0x80000000u); }
DI void dsa_select_item(const Ctx& c, int item) {
    const int b = item >> 7, t0 = (item & 127) * 16; const int lane = c.lane, w = c.wave;
    unsigned* dmask = c.W<unsigned>(WS_DMASK);
    if (t0 < 256) {
        for (int e = c.tid; e < 16 * 64; e += NTHREADS) { const int qi = e >> 6, wd = e & 63, t = t0 + qi; const int nb = t + 1 - 32 * wd;
            dmask[(size_t)(b * T + t) * 64 + wd] = nb <= 0 ? 0u : (nb >= 32 ? 0xFFFFFFFFu : ((1u << nb) - 1u)); }
        return;
    }
    float* sc = (float*)c.lds;
    const h16* Z = c.W<h16>(WS_Z); const h16* IK = c.W<h16>(WS_IK) + (size_t)b * T * 64;
    const int r = lane & 31, hf = lane >> 5, hd = r & 3;
    half8 qf[2][4]; float iw[2];
    _Pragma("unroll") for (int cb = 0; cb < 2; ++cb) { const int mq = b * T + t0 + 8 * cb + (r >> 2); const h16* zq = Z + (size_t)mq * ZC;
        _Pragma("unroll") for (int ks = 0; ks < 4; ++ks) qf[cb][ks] = *(const half8*)(zq + C_IQ + hd * 64 + 16 * ks + 8 * hf);
        iw[cb] = (float)zq[C_IW + hd]; }
    const int ntile = (t0 + 15) / 32 + 1;
    for (int kt = w; kt < ntile; kt += 8) {
        const h16* kr = IK + (size_t)(32 * kt + r) * 64 + 8 * hf;
        f32x16 s0 = {}, s1 = {};
        _Pragma("unroll") for (int ks = 0; ks < 4; ++ks) { const half8 kf = *(const half8*)(kr + 16 * ks); s0 = MFMA32(kf, qf[0][ks], s0); s1 = MFMA32(kf, qf[1][ks], s1); }
        _Pragma("unroll") for (int i = 0; i < 16; ++i) { const int key = 32 * kt + crow(i, hf);
            const float v0 = quad_sum(iw[0] * fmaxf(s0[i], 0.f)), v1 = quad_sum(iw[1] * fmaxf(s1[i], 0.f));
            if (hd == 0) { sc[(r >> 2) * SCS + key] = v0; sc[(8 + (r >> 2)) * SCS + key] = v1; } }
    }
    __syncthreads();
    _Pragma("unroll") for (int qq = 0; qq < 2; ++qq) {
        const int qi = 2 * w + qq, t = t0 + qi; unsigned u[32];
        _Pragma("unroll") for (int i = 0; i < 32; ++i) { const int key = 64 * i + lane; u[i] = key <= t ? sortable(sc[qi * SCS + key]) : 0u; }
        unsigned thr = 0u; bool exact = false;
        for (int bit = 31; bit >= 0; --bit) { const unsigned cand = thr | (1u << bit); int cnt = 0;
            _Pragma("unroll") for (int i = 0; i < 32; ++i) cnt += (u[i] >= cand) ? 1 : 0;
            for (int o = 1; o < 64; o <<= 1) cnt += __shfl_xor(cnt, o);
            if (cnt >= 256) { thr = cand; if (cnt == 256) { exact = true; break; } } }
        int need = 0;
        if (!exact) { int cg_ = 0; _Pragma("unroll") for (int i = 0; i < 32; ++i) cg_ += (u[i] > thr) ? 1 : 0; for (int o = 1; o < 64; o <<= 1) cg_ += __shfl_xor(cg_, o); need = 256 - cg_; }
        unsigned long long mine = 0ull; int run = 0;
        _Pragma("unroll") for (int i = 0; i < 32; ++i) { bool sel;
            if (exact) sel = u[i] >= thr;
            else { const bool eq = (u[i] == thr); const unsigned long long be = __ballot(eq); const int pre = run + __popcll(be & ((1ull << lane) - 1ull)); sel = (u[i] > thr) || (eq && pre < need); run += __popcll(be); }
            const unsigned long long bs = __ballot(sel); if (lane == i) mine = bs; }
        if (lane < 32) *(unsigned long long*)(dmask + (size_t)(b * T + t) * 64 + 2 * lane) = mine;
    }
}

struct Flash { f32x16 o0, o1; float mx, l; DI void init() { _Pragma("unroll") for (int i = 0; i < 16; ++i) { o0[i] = 0.f; o1[i] = 0.f; } mx = -1e30f; l = 0.f; } };
template <class VF>
DI void flash_tile(Flash& f, const half8 (&qf)[4], const h16* Kb, const h16* Vt, int ldv, int key0, int lane, VF valid) {
    const int r = lane & 31, hf = lane >> 5;
    const h16* kr = Kb + (size_t)(key0 + r) * 64 + 8 * hf;
    f32x16 s = {};
    _Pragma("unroll") for (int ks = 0; ks < 4; ++ks) { const half8 kf = *(const half8*)(kr + 16 * ks); s = MFMA32(kf, qf[ks], s); }
    float tmax = -1e30f;
    _Pragma("unroll") for (int i = 0; i < 16; ++i) { s[i] = valid(i) ? s[i] : -1e30f; tmax = fmaxf(tmax, s[i]); }
    tmax = fmaxf(tmax, __shfl_xor(tmax, 32));
    const float mnew = fmaxf(f.mx, tmax), alpha = __expf(f.mx - mnew);
    float psum = 0.f;
    _Pragma("unroll") for (int i = 0; i < 16; ++i) { const float p = s[i] > -1e29f ? __expf(s[i] - mnew) : 0.f; s[i] = p; psum += p; }
    f.l = f.l * alpha + psum; f.mx = mnew;
    _Pragma("unroll") for (int i = 0; i < 16; ++i) { f.o0[i] *= alpha; f.o1[i] *= alpha; }
    _Pragma("unroll") for (int st = 0; st < 2; ++st) { half8 pf; _Pragma("unroll") for (int j = 0; j < 8; ++j) pf[j] = (h16)s[8 * st + j];
        const h16* vp0 = Vt + (size_t)r * ldv + key0 + 16 * st + 4 * hf; const h16* vp1 = vp0 + (size_t)32 * ldv;
        const half4 a0 = *(const half4*)vp0, b0 = *(const half4*)(vp0 + 8), a1 = *(const half4*)vp1, b1 = *(const half4*)(vp1 + 8);
        const half8 v0 = __builtin_shufflevector(a0, b0, 0, 1, 2, 3, 4, 5, 6, 7), v1 = __builtin_shufflevector(a1, b1, 0, 1, 2, 3, 4, 5, 6, 7);
        f.o0 = MFMA32(v0, pf, f.o0); f.o1 = MFMA32(v1, pf, f.o1); }
}
DI void store_o(h16* dst  , const f32x16& o0, const f32x16& o1, int hf) {
    _Pragma("unroll") for (int g = 0; g < 4; ++g) { half4 a, b; _Pragma("unroll") for (int j = 0; j < 4; ++j) { a[j] = (h16)o0[4 * g + j]; b[j] = (h16)o1[4 * g + j]; }
        *(half4*)(dst + 8 * g + 4 * hf) = a; *(half4*)(dst + 32 + 8 * g + 4 * hf) = b; }
}
DI void dsa_attn_wave(const Ctx& c, int b, int t0) {
    const int lane = c.lane, r = lane & 31, hf = lane >> 5, hd = r & 3, t = t0 + (r >> 2), m = b * T + t;
    const h16* zq = c.W<h16>(WS_Z) + (size_t)m * ZC + C_QA + hd * 64 + 8 * hf;
    half8 qf[4]; _Pragma("unroll") for (int ks = 0; ks < 4; ++ks) qf[ks] = *(const half8*)(zq + 16 * ks);
    const h16* Kb = c.W<h16>(WS_KA) + (size_t)b * T * 64; const h16* Vt = c.W<h16>(WS_VAT) + (size_t)b * 64 * T;
    const unsigned* mrow = c.W<unsigned>(WS_DMASK) + (size_t)m * 64;
    Flash f; f.init();
    const int ntile = (t0 + 7) / 32 + 1;
    for (int kt = 0; kt < ntile; ++kt) { const unsigned word = mrow[kt]; if (__ballot(word != 0u) == 0ull) continue;
        flash_tile(f, qf, Kb, Vt, T, 32 * kt, lane, [&](int i) { return ((word >> crow(i, hf)) & 1u) != 0u; }); }
    const float lt = f.l + __shfl_xor(f.l, 32), inv = 1.f / lt;
    _Pragma("unroll") for (int i = 0; i < 16; ++i) { f.o0[i] *= inv; f.o1[i] *= inv; }
    store_o(c.W<h16>(WS_ACT) + (size_t)m * D + hd * 64, f.o0, f.o1, hf);
}
DI void nsa_attn_wave(const Ctx& c, int b, int t0) {
    const int lane = c.lane, w = c.wave, r = lane & 31, hf = lane >> 5, hd = r & 3, qi = r >> 2, t = t0 + qi, m = b * T + t;
    const h16* zrow = c.W<h16>(WS_Z) + (size_t)m * ZC;
    half8 qf[4]; _Pragma("unroll") for (int ks = 0; ks < 4; ++ks) qf[ks] = *(const half8*)(zrow + C_QC + hd * 64 + 8 * hf + 16 * ks);
    const float g0 = sigmoidf_((float)zrow[C_GC + hd * 3 + 0]), g1 = sigmoidf_((float)zrow[C_GC + hd * 3 + 1]), g2 = sigmoidf_((float)zrow[C_GC + hd * 3 + 2]);
    float* GS = (float*)(c.lds + w * 4096); float* LA = GS + 256; float* IMPF = GS + 512; unsigned* SELM = (unsigned*)(GS + 768);
    f32x16 a0, a1;
    {
        const h16* Kc = c.W<h16>(WS_KCMP) + (size_t)b * 128 * 64; const h16* Vc = c.W<h16>(WS_VCMPT) + (size_t)b * 64 * 128;
        const int nmax = t >= 31 ? ((t - 31) >> 4) : -1;
        f32x16 s[4]; float mxv = -1e30f;
        _Pragma("unroll") for (int tl = 0; tl < 4; ++tl) { const h16* kr = Kc + (size_t)(32 * tl + r) * 64 + 8 * hf; f32x16 a = {};
            _Pragma("unroll") for (int ks = 0; ks < 4; ++ks) { const half8 kf = *(const half8*)(kr + 16 * ks); a = MFMA32(kf, qf[ks], a); }
            _Pragma("unroll") for (int i = 0; i < 16; ++i) { const int n = 32 * tl + crow(i, hf); a[i] = n <= nmax ? a[i] : -1e30f; mxv = fmaxf(mxv, a[i]); }
            s[tl] = a; }
        mxv = fmaxf(mxv, __shfl_xor(mxv, 32));
        float sum = 0.f;
        _Pragma("unroll") for (int tl = 0; tl < 4; ++tl) _Pragma("unroll") for (int i = 0; i < 16; ++i) { const float p = s[tl][i] > -1e29f ? __expf(s[tl][i] - mxv) : 0.f; s[tl][i] = p; sum += p; }
        sum += __shfl_xor(sum, 32);
        const float inv = sum > 0.f ? 1.f / sum : 0.f;
        f32x16 o0 = {}, o1 = {};
        _Pragma("unroll") for (int tl = 0; tl < 4; ++tl) { _Pragma("unroll") for (int i = 0; i < 16; ++i) s[tl][i] *= inv;
            _Pragma("unroll") for (int st = 0; st < 2; ++st) { half8 pf; _Pragma("unroll") for (int j = 0; j < 8; ++j) pf[j] = (h16)s[tl][8 * st + j];
                const h16* vp0 = Vc + (size_t)r * 128 + 32 * tl + 16 * st + 4 * hf; const h16* vp1 = vp0 + 32 * 128;
                const half4 x0 = *(const half4*)vp0, y0 = *(const half4*)(vp0 + 8), x1 = *(const half4*)vp1, y1 = *(const half4*)(vp1 + 8);
                o0 = MFMA32(__builtin_shufflevector(x0, y0, 0, 1, 2, 3, 4, 5, 6, 7), pf, o0); o1 = MFMA32(__builtin_shufflevector(x1, y1, 0, 1, 2, 3, 4, 5, 6, 7), pf, o1); } }
        _Pragma("unroll") for (int i = 0; i < 16; ++i) { a0[i] = g0 * o0[i]; a1[i] = g0 * o1[i]; }
        _Pragma("unroll") for (int tl = 0; tl < 4; ++tl) _Pragma("unroll") for (int g = 0; g < 4; ++g) { const int G = 8 * tl + 2 * g + hf;
            const float gs = quad_sum((s[tl][4 * g] + s[tl][4 * g + 1]) + (s[tl][4 * g + 2] + s[tl][4 * g + 3])); const float la = quad_sum(s[tl][4 * g + 3]);
            if (hd == 0) { GS[qi * 32 + G] = gs; LA[qi * 32 + G] = la; } }
        WSYNC();
        _Pragma("unroll") for (int it = 0; it < 4; ++it) { const int q = (lane >> 5) + 2 * it, j = lane & 31, tq = t0 + q, cur = tq >> 6;
            const float imp = GS[q * 32 + j] + (j > 0 ? LA[q * 32 + j - 1] : 0.f);
            const bool adm = (j * 64 <= tq), forced = (j == 0) || (j == cur) || (j == cur - 1);
            IMPF[q * 32 + j] = adm ? (forced ? __builtin_inff() : imp) : -__builtin_inff(); }
        WSYNC();
        _Pragma("unroll") for (int it = 0; it < 4; ++it) { const int q = (lane >> 5) + 2 * it, j = lane & 31; const float mv = IMPF[q * 32 + j]; int rank = 0;
            _Pragma("unroll") for (int jj = 0; jj < 32; ++jj) { const float ov = IMPF[q * 32 + jj]; rank += (ov > mv || (ov == mv && jj < j)) ? 1 : 0; }
            const unsigned long long bs = __ballot(rank < 16);
            if (lane == 0) { SELM[2 * it] = (unsigned)bs; SELM[2 * it + 1] = (unsigned)(bs >> 32); } }
        WSYNC();
    }
    const unsigned selmask = SELM[qi];
    WSYNC();
    {
        const h16* Kb = c.W<h16>(WS_KS) + (size_t)b * T * 64; const h16* Vt = c.W<h16>(WS_VST) + (size_t)b * 64 * T;
        Flash f; f.init();
        const int ntile = (t0 + 7) / 32 + 1;
        for (int kt = 0; kt < ntile; ++kt) { const bool bit = ((selmask >> (kt >> 1)) & 1u) != 0u; if (__ballot(bit) == 0ull) continue;
            const int key0 = 32 * kt; flash_tile(f, qf, Kb, Vt, T, key0, lane, [&](int i) { return bit && (key0 + crow(i, hf) <= t); }); }
        const float lt = f.l + __shfl_xor(f.l, 32), sc = g1 / lt;
        _Pragma("unroll") for (int i = 0; i < 16; ++i) { a0[i] += sc * f.o0[i]; a1[i] += sc * f.o1[i]; }
    }
    {
        const h16* Kb = c.W<h16>(WS_KW) + (size_t)b * T * 64; const h16* Vt = c.W<h16>(WS_VWT) + (size_t)b * 64 * T;
        Flash f; f.init();
        const int lo = (t0 - 511 > 0 ? t0 - 511 : 0) >> 5, hiT = (t0 + 7) >> 5;
        for (int kt = lo; kt <= hiT; ++kt) { const int key0 = 32 * kt;
            flash_tile(f, qf, Kb, Vt, T, key0, lane, [&](int i) { const int key = key0 + crow(i, hf); return key <= t && key > t - 512; }); }
        const float lt = f.l + __shfl_xor(f.l, 32), sc = g2 / lt;
        _Pragma("unroll") for (int i = 0; i < 16; ++i) { a0[i] += sc * f.o0[i]; a1[i] += sc * f.o1[i]; }
    }
    store_o(c.W<h16>(WS_ACT) + (size_t)m * D + 768 + hd * 64, a0, a1, hf);
}

DI void rwkv_item(const Ctx& c, int l, int item) {
    const int b = item >> 3, h = item & 7; const int tid = c.tid, lane = c.lane, w = c.wave;
    float* kkL = (float*)c.lds; float* wL = kkL + 2048; float* kpL = wL + 2048; float* bbL = kpL + 2048; float* rrL = bbL + 2048; float* vvL = rrL + 2048; float* yL = vvL + 2048;
    const h16* Z = c.W<h16>(WS_Z); const h16* DEC = c.W<h16>(WS_DEC); const h16* AA = c.W<h16>(WS_A); const h16* GG = c.W<h16>(WS_G); h16* MIX = c.W<h16>(WS_ACT);
    const float* mu = c.inl(I_MU, l, 1792); const float* k_k = c.inl(I_KK, l, 512); const float* k_a = c.inl(I_KA, l, 512); const float* r_k = c.inl(I_RK, l, 512);
    const float* ln_w = c.inl(I_LNW, l, 512); const float* ln_b = c.inl(I_LNB, l, 512);
    const int s_ = tid >> 4, ch = (tid & 15) * 4, col = h * 64 + ch;
    float mur[4], muk[4], muv[4], kkc[4], kac[4], rkc[4], lw[4], lb[4];
    _Pragma("unroll") for (int q = 0; q < 4; ++q) { mur[q] = mu[col + q]; muk[q] = mu[512 + col + q]; muv[q] = mu[1024 + col + q]; kkc[q] = k_k[col + q]; kac[q] = k_a[col + q]; rkc[q] = r_k[col + q]; lw[q] = ln_w[col + q]; lb[q] = ln_b[col + q]; }
    const int rl = lane >> 3, cc = lane & 7, irow = 8 * w + rl, j0 = 8 * cc;
    float S[8]; _Pragma("unroll") for (int q = 0; q < 8; ++q) S[q] = 0.f;
    for (int chunk = 0; chunk < 64; ++chunk) {
        const int tt0 = chunk * 32; const int m = b * T + tt0 + s_;
        __syncthreads();
        {
            const h16* zr = Z + (size_t)m * ZC; const bool hasp = (tt0 + s_) > 0;
            const half4 r4 = *(const half4*)(zr + C_R + col), k4 = *(const half4*)(zr + C_K + col), v4 = *(const half4*)(zr + C_V + col);
            half4 rp = {0, 0, 0, 0}, kp_ = {0, 0, 0, 0}, vp = {0, 0, 0, 0};
            if (hasp) { rp = *(const half4*)(zr - ZC + C_R + col); kp_ = *(const half4*)(zr - ZC + C_K + col); vp = *(const half4*)(zr - ZC + C_V + col); }
            const half4 d4 = *(const half4*)(DEC + (size_t)m * 512 + col), a4 = *(const half4*)(AA + (size_t)m * 512 + col);
            float rr[4], kx[4], vv[4], kr[4]; float ss = 0.f;
            _Pragma("unroll") for (int q = 0; q < 4; ++q) { const float r0 = (float)r4[q], k0 = (float)k4[q], v0 = (float)v4[q];
                rr[q] = r0 + ((float)rp[q] - r0) * mur[q]; kx[q] = k0 + ((float)kp_[q] - k0) * muk[q]; vv[q] = v0 + ((float)vp[q] - v0) * muv[q];
                kr[q] = kx[q] * kkc[q]; ss += kr[q] * kr[q]; }
            ss = red16(ss); const float inrm = 1.f / fmaxf(sqrtf(ss), 1e-12f);
            f32x4 o_kk, o_w, o_kp, o_bb, o_r, o_v;
            _Pragma("unroll") for (int q = 0; q < 4; ++q) { const float a = (float)a4[q]; const float kk = kr[q] * inrm;
                o_kk[q] = kk; o_w[q] = (float)d4[q]; o_kp[q] = kx[q] * (1.f + (a - 1.f) * kac[q]); o_bb[q] = kk * a; o_r[q] = rr[q]; o_v[q] = vv[q]; }
            *(f32x4*)(kkL + s_ * 64 + ch) = o_kk; *(f32x4*)(wL + s_ * 64 + ch) = o_w; *(f32x4*)(kpL + s_ * 64 + ch) = o_kp;
            *(f32x4*)(bbL + s_ * 64 + ch) = o_bb; *(f32x4*)(rrL + s_ * 64 + ch) = o_r; *(f32x4*)(vvL + s_ * 64 + ch) = o_v;
        }
        __syncthreads();
#pragma unroll 4
        for (int s = 0; s < 32; ++s) {
            const f32x4 ka = *(const f32x4*)(kkL + s * 64 + j0), kb = *(const f32x4*)(kkL + s * 64 + j0 + 4);
            const f32x4 wa = *(const f32x4*)(wL + s * 64 + j0), wb = *(const f32x4*)(wL + s * 64 + j0 + 4);
            const f32x4 pa = *(const f32x4*)(kpL + s * 64 + j0), pb = *(const f32x4*)(kpL + s * 64 + j0 + 4);
            const f32x4 ba = *(const f32x4*)(bbL + s * 64 + j0), bb = *(const f32x4*)(bbL + s * 64 + j0 + 4);
            const f32x4 ra = *(const f32x4*)(rrL + s * 64 + j0), rb = *(const f32x4*)(rrL + s * 64 + j0 + 4);
            const float vv = vvL[s * 64 + irow];
            float sa = 0.f, sb = 0.f;
            _Pragma("unroll") for (int q = 0; q < 4; ++q) { sa += S[q] * ka[q]; sb += S[4 + q] * kb[q]; }
            sa = red8(sa + sb);
            float ya = 0.f, yb = 0.f;
            _Pragma("unroll") for (int q = 0; q < 4; ++q) { S[q] = S[q] * wa[q] + (vv * pa[q] - sa * ba[q]); S[4 + q] = S[4 + q] * wb[q] + (vv * pb[q] - sa * bb[q]); ya += S[q] * ra[q]; yb += S[4 + q] * rb[q]; }
            const float y = red8(ya + yb);
            if (cc == 0) yL[s * 64 + irow] = y;
        }
        __syncthreads();
        {
            const f32x4 y4 = *(const f32x4*)(yL + s_ * 64 + ch); const f32x4 r4 = *(const f32x4*)(rrL + s_ * 64 + ch), p4 = *(const f32x4*)(kpL + s_ * 64 + ch), v4 = *(const f32x4*)(vvL + s_ * 64 + ch);
            const float mean = red16((y4[0] + y4[1]) + (y4[2] + y4[3])) * (1.f / 64.f);
            float vs = 0.f, bs = 0.f; _Pragma("unroll") for (int q = 0; q < 4; ++q) { const float d = y4[q] - mean; vs += d * d; bs += r4[q] * p4[q] * rkc[q]; }
            const float rstd = 1.f / sqrtf(red16(vs) * (1.f / 64.f) + 64e-5f); bs = red16(bs);
            const half4 g4 = *(const half4*)(GG + (size_t)m * 512 + col); half4 o;
            _Pragma("unroll") for (int q = 0; q < 4; ++q) o[q] = (h16)((((y4[q] - mean) * rstd * lw[q] + lb[q]) + bs * v4[q]) * (float)g4[q]);
            *(half4*)(MIX + (size_t)m * D + 256 + col) = o;
        }
    }
}

DI void phase_cmp2(const Ctx& c, int l) {
    const h16* HID = c.W<h16>(WS_HID); const float* w2 = c.inl(I_NW2, l, 2 * 256 * 64); const float* nkg = c.inl(I_NKG, l, 64);
    const int lane = c.lane; const bool hi = lane >= 32; const float inv = powf(10000.f, -(float)(lane & 31) * (1.f / 32.f));
    for (int it = c.gw; it < 2 * 1024; it += c.ngw) { const int j = it >> 10, rrow = it & 1023, b = rrow >> 7, n = rrow & 127;
        float acc = 0.f;
        if (n < 127) { const h16* hr = HID + ((size_t)j * 1024 + rrow) * 256; const float* wj = w2 + (size_t)j * 256 * 64;
            for (int k = 0; k < 256; k += 8) { const half8 hv = *(const half8*)(hr + k); _Pragma("unroll") for (int q = 0; q < 8; ++q) acc += (float)hv[q] * wj[(k + q) * 64 + lane]; } }
        if (j == 0) { const float ss = wave_sum(acc * acc); float y = acc * (1.f / sqrtf(ss * (1.f / 64.f) + 1e-6f)) * nkg[lane];
            const float ang = (float)(16 * n + 31) * inv; const float cs = cosf(ang), sn = sinf(ang); const float o = __shfl_xor(y, 32); y = hi ? y * cs + o * sn : y * cs - o * sn;
            c.W<h16>(WS_KCMP)[((size_t)b * 128 + n) * 64 + lane] = (h16)(n < 127 ? y : 0.f); }
        else c.W<h16>(WS_VCMPT)[((size_t)b * 64 + lane) * 128 + n] = (h16)acc; }
}

__global__ void __launch_bounds__(NTHREADS) fwd_kernel(Params p) {
    extern __shared__ __attribute__((aligned(16))) char lds[];
    cg::grid_group grid = cg::this_grid();
    Ctx c; c.out = p.out; c.ws = p.ws; c.lds = lds; c.ctl = (unsigned*)(p.ws + WS_CTL);
    if (threadIdx.x < 28) ((const float**)(p.ws + WS_PTRS))[threadIdx.x] = p.in[threadIdx.x];
    __threadfence(); __syncthreads();
    c.tid = threadIdx.x; c.lane = c.tid & 63; c.wave = __builtin_amdgcn_readfirstlane(c.tid >> 6); c.gw = blockIdx.x * 8 + c.wave; c.ngw = gridDim.x * 8;
    h16* ACT = c.W<h16>(WS_ACT); h16* Z = c.W<h16>(WS_Z);

#define PH() do { c.ws = launder_ptr(c.ws); c.out = launder_ptr(c.out); asm volatile("" : "+v"(c.tid)); c.lane = c.tid & 63; c.wave = __builtin_amdgcn_readfirstlane(c.tid >> 6); c.gw = blockIdx.x * 8 + c.wave; } while (0)
    phase_mod(c);
#pragma unroll 1
    for (int l = 0; l < DEPTH; ++l) {
        const float* mod_l = c.W<float>(WS_MOD) + (size_t)l * 8 * 6144;
        const float* xin = l == 0 ? c.inp(I_X) : c.out;
        PH(); convert_weights(c, l);
        PH(); phase_cbias(c, l);
        if (l == 0) grid.sync();
        PH();
        phase_norm(c, xin, c.inl(I_N1G, l, D), mod_l, 0, 1024);
        grid.sync(); PH();
        phase_gemm(c, ACT, D, c.W<h16>(WS_WIN), D, D, 64, 13, EpiZ{Z, ZC});
        grid.sync(); PH();
        phase_prep(c, l);
        grid.sync(); PH();
        {
            unsigned* ctr = c.ctl + 16 * (2 * l);
            for (;;) { const int it = next_item(ctr); if (it >= 8 + 384 + 1024) break; PH();
                if (it < 8) { const int j = it >> 2, pm = it & 3;
                    gemm_unit(c.W<h16>(j ? WS_VC : WS_KC), 1024, c.W<h16>(WS_W1) + (size_t)j * 256 * 2048, 2048, 2048, pm * 256, 0, (h16*)lds, EpiCmp{c.W<h16>(WS_HID) + (size_t)j * 1024 * 256, c.W<float>(WS_CBIAS) + j * 256}); }
                else if (it < 392) { const int u = it - 8, pm = u / 6, pn = u % 6;
                    gemm_unit(c.W<h16>(WS_L16), 256, c.W<h16>(WS_WL), 256, 256, pm * 256, pn * 256, (h16*)lds, EpiLora{c.W<h16>(WS_DEC), c.W<h16>(WS_A), c.W<h16>(WS_G), c.inl(I_W0, l, 512), c.inl(I_A0, l, 512)}); }
                else dsa_select_item(c, 1023 - (it - 392)); }
        }
        grid.sync(); PH();
        phase_cmp2(c, l);
        grid.sync(); PH();
        {
            unsigned* ctr = c.ctl + 16 * (2 * l + 1);
            for (;;) { const int it = next_item(ctr); if (it >= 64 + 512) break; PH();
                if (it < 64) rwkv_item(c, l, it);
                else { const int a = it - 64; const int kind = a >> 8, idx = 255 - (a & 255); const int b = idx & 7, qb = idx >> 3; const int t0 = qb * 64 + c.wave * 8;
                    if (kind == 0) nsa_attn_wave(c, b, t0); else dsa_attn_wave(c, b, t0); } }
        }
        grid.sync(); PH();
        phase_gemm(c, ACT, D, c.W<h16>(WS_WOUT), D, D, 64, 4, EpiRes{xin, c.out, mod_l + 2048});
        grid.sync(); PH();
        phase_norm(c, c.out, c.inl(I_N2G, l, D), mod_l, 3072, 4096);
        grid.sync(); PH();
        phase_gemm(c, ACT, D, c.W<h16>(WS_WI), D, D, 64, 22, EpiSwiglu{Z});
        grid.sync(); PH();
        phase_gemm(c, Z, FF, c.W<h16>(WS_WO), FF, FF, 64, 4, EpiRes{c.out, c.out, mod_l + 5120});
        grid.sync(); PH();
    }
}

extern "C" void kernel_launch(void* const* d_in, const int* in_sizes, int n_in, void* d_out, int out_size, void* d_ws, size_t ws_size, hipStream_t stream) {
    static int grid_blocks = 0;
    if (grid_blocks == 0) {
        if (n_in != 28 || ws_size < WS_END) { fprintf(stderr, "kernel_launch: unexpected n_in %d / ws %zu\n", n_in, ws_size); grid_blocks = -1; return; }
        int dev = 0, cus = 0, per_cu = 0;
        hipGetDevice(&dev); hipDeviceGetAttribute(&cus, hipDeviceAttributeMultiprocessorCount, dev);
        hipFuncSetAttribute((const void*)fwd_kernel, hipFuncAttributeMaxDynamicSharedMemorySize, LDS_BYTES);
        hipOccupancyMaxActiveBlocksPerMultiprocessor(&per_cu, (const void*)fwd_kernel, NTHREADS, LDS_BYTES);
        if (per_cu < 1) { fprintf(stderr, "kernel_launch: occupancy query says %d blocks/CU\n", per_cu); per_cu = 1; }
        grid_blocks = cus * 1;
    }
    if (grid_blocks < 0) return;
    hipMemsetAsync((char*)d_ws + WS_CTL, 0, 64 * 1024, stream);
    Params p{};
    for (int i = 0; i < 28; ++i) p.in[i] = (const float*)d_in[i];
    p.out = (float*)d_out; p.ws = (unsigned char*)d_ws;
    void* args[] = {&p};
    hipError_t e = hipLaunchCooperativeKernel((const void*)fwd_kernel, dim3(grid_blocks), dim3(NTHREADS), args, LDS_BYTES, stream);
    if (e != hipSuccess) fprintf(stderr, "cooperative launch failed: %s (grid %d)\n", hipGetErrorString(e), grid_blocks);
}
```

```cpp
#include <hip/hip_runtime.h>
#include <hip/hip_cooperative_groups.h>
#include <cstdio>
#include <cstdint>
namespace cg = cooperative_groups;

typedef _Float16 h16;
typedef _Float16 half8 __attribute__((ext_vector_type(8)));
typedef _Float16 half4 __attribute__((ext_vector_type(4)));
typedef float f32x4 __attribute__((ext_vector_type(4)));
typedef float f32x16 __attribute__((ext_vector_type(16)));
#define LAS __attribute__((address_space(3)))
#define DI __device__ __forceinline__

constexpr int D = 1024, NB = 8, T = 2048, M = NB * T, FF = 2816, DEPTH = 2;
constexpr int ZC = 3328;
constexpr int C_QA = 0, C_KA = 256, C_VA = 320, C_IQ = 384, C_IK = 640, C_IW = 704;
constexpr int C_R = 768, C_K = 1280, C_V = 1792, C_WD = 2304;
constexpr int C_QC = 2560, C_KC = 2816, C_VC = 2880, C_KS = 2944, C_VS = 3008, C_KW = 3072, C_VW = 3136, C_GC = 3200;
constexpr int NTHREADS = 512;
constexpr int LDS_BYTES = 139264;

constexpr size_t MiB = 1u << 20;
constexpr size_t WS_CTL = 0;
constexpr size_t WS_PTRS = 60 * 1024;
constexpr size_t WS_MOD = 64 * 1024;
constexpr size_t WS_CBIAS = 512 * 1024;
constexpr size_t WS_KCMP = 1 * MiB;
constexpr size_t WS_VCMPT = 1 * MiB + 128 * 1024;
constexpr size_t WS_HID = 2 * MiB;
constexpr size_t WS_KA = 4 * MiB, WS_IK = 6 * MiB, WS_KS = 8 * MiB, WS_KW = 10 * MiB;
constexpr size_t WS_VAT = 12 * MiB, WS_VST = 14 * MiB, WS_VWT = 16 * MiB;
constexpr size_t WS_DMASK = 18 * MiB;
constexpr size_t WS_WIN = 22 * MiB;
constexpr size_t WS_WOUT = WS_WIN + 6656 * 1024;
constexpr size_t WS_WI = WS_WOUT + 2 * MiB;
constexpr size_t WS_WO = WS_WI + 11 * MiB;
constexpr size_t WS_W1 = WS_WO + 5632 * 1024;
constexpr size_t WS_WL = WS_W1 + 2 * MiB;
constexpr size_t WS_ACT = 50 * MiB;
constexpr size_t WS_L16 = WS_ACT, WS_KC = WS_ACT + 8 * MiB, WS_VC = WS_ACT + 12 * MiB;
constexpr size_t WS_DEC = 82 * MiB, WS_A = 98 * MiB, WS_G = 114 * MiB;
constexpr size_t WS_Z = 130 * MiB;
constexpr size_t WS_END = 234 * MiB;
static_assert(WS_WL + 768 * 1024 <= WS_ACT, "weights fit");

struct Params { const float* in[28]; float* out; unsigned char* ws; };
enum { I_X = 0, I_C, I_ADAW, I_ADAB, I_N1G, I_WIN, I_DQG, I_DKG, I_MU, I_W0, I_W2, I_A0, I_A2, I_G2, I_KK, I_KA, I_RK, I_LNW, I_LNB,
       I_NQG, I_NKG, I_PE, I_NW1, I_NW2, I_WOUT, I_N2G, I_FWI, I_FWO };

template <int CTRL> DI float dpp_f(float x) { return __builtin_bit_cast(float, __builtin_amdgcn_update_dpp(0, __builtin_bit_cast(int, x), CTRL, 0xF, 0xF, true)); }
DI float quad_sum(float x) { x += dpp_f<0xB1>(x); x += dpp_f<0x4E>(x); return x; }
DI float red8(float x) { x += dpp_f<0xB1>(x); x += dpp_f<0x4E>(x); x += dpp_f<0x141>(x); return x; }
DI float red16(float x) { x += __shfl_xor(x, 1); x += __shfl_xor(x, 2); x += __shfl_xor(x, 4); x += __shfl_xor(x, 8); return x; }
DI float wave_sum(float x) { for (int o = 1; o < 64; o <<= 1) x += __shfl_xor(x, o); return x; }
DI float rcpf_(float x) { return __builtin_amdgcn_rcpf(x); }
DI float rsqf_(float x) { return __builtin_amdgcn_rsqf(x); }
DI float sigmoidf_(float x) { return rcpf_(1.f + __expf(-x)); }
DI int crow(int i, int h) { return (i & 3) + 8 * (i >> 2) + 4 * h; }
#define WSYNC() asm volatile("s_waitcnt lgkmcnt(0)" ::: "memory")
#define MFMA32(a, b, c) __builtin_amdgcn_mfma_f32_32x32x16_f16((a), (b), (c), 0, 0, 0)

template <class Tp> DI Tp* launder_ptr(Tp* p) {
    unsigned lo = (unsigned)(uintptr_t)p, hi = (unsigned)((uintptr_t)p >> 32); asm volatile("" : "+v"(lo), "+v"(hi));
    lo = __builtin_amdgcn_readfirstlane(lo); hi = __builtin_amdgcn_readfirstlane(hi); return (Tp*)(((uintptr_t)hi << 32) | lo); }
DI int lane_id() { return (int)__builtin_amdgcn_mbcnt_hi(~0u, __builtin_amdgcn_mbcnt_lo(~0u, 0u)); }
__shared__ int s_item;
DI int next_item(unsigned* ctr, int tid) {
    __syncthreads();
    if (tid == 0) s_item = (int)atomicAdd(ctr, 1u);
    __syncthreads();
    return s_item;
}

constexpr int BK = 64, HALF = 128, HT = HALF * BK;
DI void stage_rc(int b, int& R, int& C) { int st = b / 1024, sb = b % 1024, swz = sb ^ (((sb >> 9) & 1) << 5); R = (st >> 1) * 16 + swz / 64; C = (st & 1) * 32 + (swz % 64) / 2; }

template <class Epi>
DI void gemm_unit(int tid_in, const h16* __restrict__ A, int lda, const h16* __restrict__ Bt, int ldb, int K, int brow, int bcol, h16* shm, const Epi& epi) {
#define SA(b, h) (shm + ((b) * 2 + (h)) * HT)
#define SB(b, h) (shm + (4 + (b) * 2 + (h)) * HT)
#define STAGE_A(P, br, kt) do { const char* _g = (const char*)(A + ((long)(br) * lda + (long)(kt) * BK)); \
    __builtin_amdgcn_global_load_lds((const unsigned*)(_g + oa0), (LAS unsigned*)((char*)(P) + tidx * 16), 16, 0, 0); \
    __builtin_amdgcn_global_load_lds((const unsigned*)(_g + (size_t)lda * 128 + oa0), (LAS unsigned*)((char*)(P) + tidx * 16 + 8192), 16, 0, 0); } while (0)
#define STAGE_B(P, br, kt) do { const char* _g = (const char*)(Bt + ((long)(br) * ldb + (long)(kt) * BK)); \
    __builtin_amdgcn_global_load_lds((const unsigned*)(_g + ob0), (LAS unsigned*)((char*)(P) + tidx * 16), 16, 0, 0); \
    __builtin_amdgcn_global_load_lds((const unsigned*)(_g + (size_t)ldb * 128 + ob0), (LAS unsigned*)((char*)(P) + tidx * 16 + 8192), 16, 0, 0); } while (0)
#define LDA(dst, b, h) _Pragma("unroll") for (int m = 0; m < 4; ++m) _Pragma("unroll") for (int k = 0; k < 2; ++k) dst[m][k] = *reinterpret_cast<const half8*>((char*)SA(b, h) + la + (m * 2 + k) * 1024)
#define LDB(dst, b, h) _Pragma("unroll") for (int n = 0; n < 2; ++n) _Pragma("unroll") for (int k = 0; k < 2; ++k) dst[n][k] = *reinterpret_cast<const half8*>((char*)SB(b, h) + lb + (n * 2 + k) * 1024)
#define MMA(ai, bj, At_, Bt_) do { __builtin_amdgcn_s_setprio(1); \
    _Pragma("unroll") for (int m = 0; m < 4; ++m) _Pragma("unroll") for (int n = 0; n < 2; ++n) _Pragma("unroll") for (int k = 0; k < 2; ++k) \
        acc[ai][bj][m][n] = __builtin_amdgcn_mfma_f32_16x16x32_f16(Bt_[n][k], At_[m][k], acc[ai][bj][m][n], 0, 0, 0); \
    __builtin_amdgcn_s_setprio(0); } while (0)
#define WAIT_V(n) asm volatile("s_waitcnt vmcnt(" #n ")" ::: "memory")
#define WAIT_L(n) asm volatile("s_waitcnt lgkmcnt(" #n ")" ::: "memory")
#define BAR __builtin_amdgcn_s_barrier()
#define SCHED __builtin_amdgcn_sched_barrier(0)
    int tidx = tid_in; asm volatile("" : "+v"(tidx));
    const int wid = tidx >> 6, lane = tidx & 63, wr = wid >> 2, wc = wid & 3, fr = lane & 15, fq = lane >> 4;
    const int lpart = ((fr * 64 + fq * 16) ^ ((fr >> 3) << 5));
    const int la = wr * 8192 + lpart, lb = wc * 4096 + lpart;
    unsigned oa0, ob0;
    { int _r, _c; stage_rc(tidx * 16, _r, _c); oa0 = (unsigned)(_r * lda + _c) * 2u; ob0 = (unsigned)(_r * ldb + _c) * 2u; }
    f32x4 acc[2][2][4][2] = {};
    half8 At[4][2], B0[2][2], B1[2][2];
    const int nt = K / BK;
    STAGE_B(SB(0, 0), bcol, 0); STAGE_A(SA(0, 0), brow, 0);
    STAGE_B(SB(0, 1), bcol + HALF, 0); STAGE_A(SA(0, 1), brow + HALF, 0);
    if (wr == 1) BAR;
    WAIT_V(4); BAR;
    STAGE_B(SB(1, 0), bcol, 1); STAGE_A(SA(1, 0), brow, 1); STAGE_B(SB(1, 1), bcol + HALF, 1);
    WAIT_V(6); BAR;
    for (int t = 0; t < nt - 2; t += 2) {
        LDB(B0, 0, 0); SCHED; LDA(At, 0, 0); STAGE_A(SA(1, 1), brow + HALF, t + 1);
        WAIT_L(8); BAR; WAIT_L(0); MMA(0, 0, At, B0); BAR; SCHED;
        LDB(B1, 0, 1); STAGE_B(SB(0, 0), bcol, t + 2);
        BAR; WAIT_L(0); MMA(0, 1, At, B1); BAR;
        LDA(At, 0, 1); STAGE_A(SA(0, 0), brow, t + 2);
        BAR; WAIT_L(0); MMA(1, 0, At, B0); BAR; SCHED;
        STAGE_B(SB(0, 1), bcol + HALF, t + 2);
        WAIT_V(6); BAR; MMA(1, 1, At, B1); BAR;
        LDB(B0, 1, 0); SCHED; LDA(At, 1, 0); STAGE_A(SA(0, 1), brow + HALF, t + 2);
        WAIT_L(8); BAR; WAIT_L(0); MMA(0, 0, At, B0); BAR; SCHED;
        LDB(B1, 1, 1); STAGE_B(SB(1, 0), bcol, t + 3);
        BAR; WAIT_L(0); MMA(0, 1, At, B1); BAR;
        LDA(At, 1, 1); STAGE_A(SA(1, 0), brow, t + 3);
        BAR; WAIT_L(0); MMA(1, 0, At, B0); BAR; SCHED;
        STAGE_B(SB(1, 1), bcol + HALF, t + 3);
        WAIT_V(6); BAR; MMA(1, 1, At, B1); BAR;
    }
    { LDB(B0, 0, 0); LDA(At, 0, 0); STAGE_A(SA(1, 1), brow + HALF, nt - 1);
      BAR; WAIT_L(0); MMA(0, 0, At, B0); BAR;
      LDB(B1, 0, 1); BAR; WAIT_L(0); MMA(0, 1, At, B1); BAR;
      LDA(At, 0, 1); WAIT_V(4); BAR; WAIT_L(0); MMA(1, 0, At, B0); MMA(1, 1, At, B1); BAR; }
    { LDB(B0, 1, 0); LDA(At, 1, 0); WAIT_V(2); BAR; WAIT_L(0); MMA(0, 0, At, B0); BAR;
      LDB(B1, 1, 1); WAIT_V(0); BAR; WAIT_L(0); MMA(0, 1, At, B1); BAR;
      LDA(At, 1, 1); BAR; WAIT_L(0); MMA(1, 0, At, B0); MMA(1, 1, At, B1); BAR; }
    if (wr == 0) BAR;
    epi(acc, brow + wr * 64 + fr, bcol + wc * 32 + fq * 4);
    __syncthreads();
}
DI bool unit_order(int L, int nM, int nN, int& pm, int& pn) {
    const int nwg = nM * nN; if (L >= nwg) return false;
    int wgid = L; { const int q = nwg / 8, r = nwg % 8, xcd = wgid % 8, off = wgid / 8; wgid = (xcd < r ? xcd * (q + 1) : r * (q + 1) + (xcd - r) * q) + off; }
    const int nig = 8 * nN, gid = wgid / nig, fm = gid * 8, gsz = (nM - fm) < 8 ? (nM - fm) : 8;
    pm = fm + ((wgid % nig) % gsz); pn = (wgid % nig) / gsz; return true;
}
typedef f32x4 Acc[2][2][4][2];
#define EPI_LOOP _Pragma("unroll") for (int ai = 0; ai < 2; ++ai) _Pragma("unroll") for (int bj = 0; bj < 2; ++bj) _Pragma("unroll") for (int m = 0; m < 4; ++m) _Pragma("unroll") for (int n = 0; n < 2; ++n)
struct EpiZ { h16* z; int ld;
    DI void operator()(Acc& acc, int r0, int c0) const { EPI_LOOP { const int row = r0 + ai * 128 + m * 16, col = c0 + bj * 128 + n * 16;
        half4 v; _Pragma("unroll") for (int j = 0; j < 4; ++j) v[j] = (h16)acc[ai][bj][m][n][j]; *(half4*)(z + (size_t)row * ld + col) = v; } } };
struct EpiLora { h16 *dec, *a, *g; const float *w0, *a0;
    DI void operator()(Acc& acc, int r0, int c0) const { EPI_LOOP { const int row = r0 + ai * 128 + m * 16, col = c0 + bj * 128 + n * 16; half4 v;
        if (col < 512) { _Pragma("unroll") for (int j = 0; j < 4; ++j) { const float lw = w0[col + j] + acc[ai][bj][m][n][j]; v[j] = (h16)__expf(-0.60653066f * sigmoidf_(lw)); } *(half4*)(dec + (size_t)row * 512 + col) = v; }
        else if (col < 1024) { _Pragma("unroll") for (int j = 0; j < 4; ++j) v[j] = (h16)sigmoidf_(a0[col - 512 + j] + acc[ai][bj][m][n][j]); *(half4*)(a + (size_t)row * 512 + col - 512) = v; }
        else { _Pragma("unroll") for (int j = 0; j < 4; ++j) v[j] = (h16)acc[ai][bj][m][n][j]; *(half4*)(g + (size_t)row * 512 + col - 1024) = v; } } } };
struct EpiCmp { h16* hid; const float* bias;
    DI void operator()(Acc& acc, int r0, int c0) const { EPI_LOOP { const int row = r0 + ai * 128 + m * 16, col = c0 + bj * 128 + n * 16; half4 v;
        _Pragma("unroll") for (int j = 0; j < 4; ++j) { const float x = acc[ai][bj][m][n][j] + bias[col + j]; const float u = 0.7978845608f * (x + 0.044715f * x * x * x);
            const float th = 1.f - 2.f * rcpf_(1.f + __expf(2.f * u)); v[j] = (h16)(0.5f * x * (1.f + th)); }
        *(half4*)(hid + (size_t)row * 256 + col) = v; } } };
struct EpiRes { const float* xin; float* xout; const float* gate;
    DI void operator()(Acc& acc, int r0, int c0) const { EPI_LOOP { const int row = r0 + ai * 128 + m * 16, col = c0 + bj * 128 + n * 16;
        const f32x4 xi = *(const f32x4*)(xin + (size_t)row * D + col); const f32x4 gg = *(const f32x4*)(gate + (size_t)(row >> 11) * 6144 + col);
        f32x4 o; _Pragma("unroll") for (int j = 0; j < 4; ++j) o[j] = xi[j] + gg[j] * acc[ai][bj][m][n][j]; *(f32x4*)(xout + (size_t)row * D + col) = o; } } };
struct EpiSwiglu { h16* hid;
    DI void operator()(Acc& acc, int r0, int c0) const { _Pragma("unroll") for (int ai = 0; ai < 2; ++ai) _Pragma("unroll") for (int m = 0; m < 4; ++m) _Pragma("unroll") for (int n = 0; n < 2; ++n) {
        const int row = r0 + ai * 128 + m * 16; const int tcol = c0 & 255, pn = c0 >> 8; const int col = pn * 128 + tcol + n * 16; half4 v;
        _Pragma("unroll") for (int j = 0; j < 4; ++j) { const float gt = acc[ai][0][m][n][j], up = acc[ai][1][m][n][j]; v[j] = (h16)(gt * sigmoidf_(gt) * up); }
        *(half4*)(hid + (size_t)row * FF + col) = v; } } };

struct Ctx {
    float* out; unsigned char* ws; char* lds; unsigned* ctl;
    int tid, lane, wave, gw, ngw;
    template <class Tp> DI Tp* W(size_t off) const { return (Tp*)(ws + off); }
    DI const float* inp(int i) const { const unsigned* t = (const unsigned*)(ws + WS_PTRS) + 2 * i;
        const unsigned lo = __builtin_amdgcn_readfirstlane(t[0]), hi = __builtin_amdgcn_readfirstlane(t[1]); return (const float*)(((uintptr_t)hi << 32) | lo); }
    DI const float* inl(int i, int l, size_t per_layer) const { return inp(i) + (size_t)l * per_layer; }
};

template <class CM>
DI void tr_item(const float* __restrict__ Wsrc, int K, int Nsrc, h16* WT, int k0, int n0, float* scr, int lane, CM cm) {
    const int sc = cm(n0 + (lane & 31));
#pragma unroll 8
    for (int i = 0; i < 32; ++i) { const int kk = 2 * i + (lane >> 5); scr[kk * 33 + (lane & 31)] = sc >= 0 ? Wsrc[(size_t)(k0 + kk) * Nsrc + sc] : 0.f; }
    WSYNC();
    const int c = lane & 7;
#pragma unroll
    for (int j = 0; j < 4; ++j) { const int n = (lane >> 3) + 8 * j; const float* s = scr + (8 * c) * 33 + n; half8 o;
        _Pragma("unroll") for (int q = 0; q < 8; ++q) o[q] = (h16)s[q * 33];
        *(half8*)(WT + (size_t)(n0 + n) * K + k0 + 8 * c) = o; }
    WSYNC();
}
DI void convert_weights(const Ctx& c, int l) {
    float* scr = (float*)(c.lds + c.wave * 8448);
    constexpr int I_IN = 16 * 104, I_OUT = 16 * 32, I_FI = 16 * 176, I_FO = 44 * 32, I_W1 = 32 * 8;
    constexpr int NIT = I_IN + I_OUT + I_FI + I_FO + 2 * I_W1;
    for (int it = c.gw; it < NIT; it += c.ngw) {
        int r = it;
        if (r < I_IN) { tr_item(c.inl(I_WIN, l, (size_t)D * 3152), D, 3152, c.W<h16>(WS_WIN), (r / 104) * 64, (r % 104) * 32, scr, c.lane,
                                [](int n) { return n < 708 ? n : (n < 768 ? -1 : (n < 3212 ? n - 60 : -1)); }); continue; } r -= I_IN;
        if (r < I_OUT) { tr_item(c.inl(I_WOUT, l, (size_t)D * D), D, D, c.W<h16>(WS_WOUT), (r / 32) * 64, (r % 32) * 32, scr, c.lane, [](int n) { return n; }); continue; } r -= I_OUT;
        if (r < I_FI) { tr_item(c.inl(I_FWI, l, (size_t)D * 2 * FF), D, 2 * FF, c.W<h16>(WS_WI), (r / 176) * 64, (r % 176) * 32, scr, c.lane,
                                [](int n) { const int pn = n >> 8, q = n & 255; return q < 128 ? pn * 128 + q : FF + pn * 128 + (q - 128); }); continue; } r -= I_FI;
        if (r < I_FO) { tr_item(c.inl(I_FWO, l, (size_t)FF * D), FF, D, c.W<h16>(WS_WO), (r / 32) * 64, (r % 32) * 32, scr, c.lane, [](int n) { return n; }); continue; } r -= I_FO;
        const int j = r / I_W1; r %= I_W1;
        tr_item(c.inl(I_NW1, l, (size_t)2 * 2048 * 256) + (size_t)j * 2048 * 256, 2048, 256, c.W<h16>(WS_W1) + (size_t)j * 256 * 2048, (r / 8) * 64, (r % 8) * 32, scr, c.lane, [](int n) { return n; });
    }
    const float* w2 = c.inl(I_W2, l, 64 * 512); const float* a2 = c.inl(I_A2, l, 64 * 512); const float* g2 = c.inl(I_G2, l, 128 * 512);
    h16* wl = c.W<h16>(WS_WL);
    for (int e = blockIdx.x * NTHREADS + c.tid; e < 1536 * 256; e += gridDim.x * NTHREADS) {
        const int n = e >> 8, k = e & 255; float v = 0.f;
        if (n < 512) { if (k < 64) v = w2[k * 512 + n]; }
        else if (n < 1024) { if (k >= 64 && k < 128) v = a2[(k - 64) * 512 + n - 512]; }
        else { if (k >= 128) v = g2[(k - 128) * 512 + n - 1024]; }
        wl[e] = (h16)v;
    }
}
template <int NV>
DI void gemv_item(const Ctx& c, const float* aL, int K, const float* __restrict__ Wsrc, int N, int n0, const float* bias, float* out, int out_stride, float* red) {
    const int nl = c.tid & 31, kc = c.tid >> 5, kper = K / 16;
    float acc[NV]; for (int v = 0; v < NV; ++v) acc[v] = 0.f;
    for (int k = kc * kper; k < (kc + 1) * kper; ++k) { const float w = Wsrc[(size_t)k * N + n0 + nl]; for (int v = 0; v < NV; ++v) acc[v] += aL[v * K + k] * w; }
    for (int v = 0; v < NV; ++v) red[(kc * NV + v) * 32 + nl] = acc[v];
    __syncthreads();
    if (c.tid < 32 * NV) { const int v = c.tid >> 5; float s = bias ? bias[n0 + nl] : 0.f; _Pragma("unroll") for (int q = 0; q < 16; ++q) s += red[(q * NV + v) * 32 + nl]; out[(size_t)v * out_stride + n0 + nl] = s; }
    __syncthreads();
}
DI void phase_mod(const Ctx& c) {
    float* sil = (float*)(c.lds + 70000); float* red = (float*)(c.lds + 70000 + 32768);
    for (int e = c.tid; e < 8 * 1024; e += NTHREADS) { const float x = c.inp(I_C)[e]; sil[e] = x * sigmoidf_(x); }
    __syncthreads();
    for (int it = blockIdx.x; it < 2 * 192; it += gridDim.x) { const int l = it / 192, n0 = (it % 192) * 32;
        gemv_item<8>(c, sil, 1024, c.inl(I_ADAW, l, (size_t)1024 * 6144), 6144, n0, c.inl(I_ADAB, l, 6144), c.W<float>(WS_MOD) + (size_t)l * 8 * 6144, 6144, red); }
}
DI void phase_cbias(const Ctx& c, int l) {
    float* pe = (float*)(c.lds + 70000); float* red = (float*)(c.lds + 70000 + 32768);
    __syncthreads();
    for (int e = c.tid; e < 2 * 2048; e += NTHREADS) pe[e] = c.inl(I_PE, l, 2 * 2048)[e];
    __syncthreads();
    for (int it = (int)gridDim.x - 1 - (int)blockIdx.x; it < 16; it += gridDim.x) { const int j = it >> 3, n0 = (it & 7) * 32;
        gemv_item<1>(c, pe + j * 2048, 2048, c.inl(I_NW1, l, (size_t)2 * 2048 * 256) + (size_t)j * 2048 * 256, 256, n0, nullptr, c.W<float>(WS_CBIAS) + j * 256, 256, red); }
}
DI void phase_norm(const Ctx& c, const float* x, const float* g, const float* mod_l, int sh_off, int sc_off) {
    h16* act = c.W<h16>(WS_ACT);
    for (int m = c.gw; m < M; m += c.ngw) {
        const f32x4* xr = (const f32x4*)(x + (size_t)m * D) + c.lane; f32x4 v[4]; float s = 0.f;
        _Pragma("unroll") for (int j = 0; j < 4; ++j) { v[j] = xr[64 * j]; s += v[j].x * v[j].x + v[j].y * v[j].y + v[j].z * v[j].z + v[j].w * v[j].w; }
        const float rstd = rsqf_(wave_sum(s) * (1.f / D) + 1e-6f);
        const float* mb = mod_l + (size_t)(m >> 11) * 6144;
        _Pragma("unroll") for (int j = 0; j < 4; ++j) { const int col = 4 * c.lane + 256 * j; const f32x4 gg = *(const f32x4*)(g + col), sc = *(const f32x4*)(mb + sc_off + col), sh = *(const f32x4*)(mb + sh_off + col);
            half4 o; _Pragma("unroll") for (int q = 0; q < 4; ++q) o[q] = (h16)(v[j][q] * rstd * gg[q] * (1.f + sc[q]) + sh[q]);
            *(half4*)(act + (size_t)m * D + col) = o; }
    }
}
template <class Epi>
DI void phase_gemm(const Ctx& c, const h16* A, int lda, const h16* Bt, int ldb, int K, int nM, int nN, const Epi& epi) {
    for (int i = 0;; ++i) { int pm, pn; if (!unit_order(i * (int)gridDim.x + (int)blockIdx.x, nM, nN, pm, pn)) break;
        gemm_unit(c.tid, A, lda, Bt, ldb, K, pm * 256, pn * 256, (h16*)c.lds, epi); }
}

DI void phase_prep(const Ctx& c, int l) {
    h16* Z = c.W<h16>(WS_Z);
    const float* dqg = c.inl(I_DQG, l, 64); const float* dkg = c.inl(I_DKG, l, 64); const float* nqg = c.inl(I_NQG, l, 64); const float* nkg = c.inl(I_NKG, l, 64);
    const float* mu = c.inl(I_MU, l, 1792);
    const int lane = c.lane; const bool hi = lane >= 32;
    const float inv = powf(10000.f, -(float)(lane & 31) * (1.f / 32.f));
    const float g_dq = dqg[lane], g_dk = dkg[lane], g_nq = nqg[lane], g_nk = nkg[lane];
    for (int m = c.gw; m < M; m += c.ngw) {
        const int b = m >> 11, t = m & 2047; h16* zr = Z + (size_t)m * ZC;
        const float ang = (float)t * inv; const float cs = cosf(ang), sn = sinf(ang);
        auto rope = [&](float x) { const float o = __shfl_xor(x, 32); return hi ? x * cs + o * sn : x * cs - o * sn; };
        auto normrope = [&](float x, float g) { const float ss = wave_sum(x * x); return rope(x * rsqf_(ss * (1.f / 64.f) + 1e-6f) * g); };
        _Pragma("unroll") for (int h = 0; h < 4; ++h) { h16* p = zr + C_QA + h * 64 + lane; *p = (h16)(normrope((float)*p, g_dq) * 0.125f); }
        c.W<h16>(WS_KA)[(size_t)m * 64 + lane] = (h16)normrope((float)zr[C_KA + lane], g_dk);
        c.W<h16>(WS_VAT)[((size_t)b * 64 + lane) * T + t] = zr[C_VA + lane];
        _Pragma("unroll") for (int h = 0; h < 4; ++h) { h16* p = zr + C_IQ + h * 64 + lane; *p = (h16)rope((float)*p); }
        c.W<h16>(WS_IK)[(size_t)m * 64 + lane] = (h16)rope((float)zr[C_IK + lane]);
        _Pragma("unroll") for (int h = 0; h < 4; ++h) { h16* p = zr + C_QC + h * 64 + lane; *p = (h16)(normrope((float)*p, g_nq) * 0.125f); }
        c.W<h16>(WS_KC)[(size_t)m * 64 + lane] = zr[C_KC + lane];
        c.W<h16>(WS_VC)[(size_t)m * 64 + lane] = zr[C_VC + lane];
        c.W<h16>(WS_KS)[(size_t)m * 64 + lane] = (h16)normrope((float)zr[C_KS + lane], g_nk);
        c.W<h16>(WS_VST)[((size_t)b * 64 + lane) * T + t] = zr[C_VS + lane];
        c.W<h16>(WS_KW)[(size_t)m * 64 + lane] = (h16)normrope((float)zr[C_KW + lane], g_nk);
        c.W<h16>(WS_VWT)[((size_t)b * 64 + lane) * T + t] = zr[C_VW + lane];
        { const int c4 = lane * 4; const half4 zc = *(const half4*)(zr + C_WD + c4); half4 zp = {0, 0, 0, 0}; if (t > 0) zp = *(const half4*)(zr - ZC + C_WD + c4);
          half4 o; _Pragma("unroll") for (int q = 0; q < 4; ++q) { const float a = (float)zc[q], v = a + ((float)zp[q] - a) * mu[1536 + c4 + q];
              o[q] = (h16)(c4 < 64 ? tanhf(v) : (c4 < 128 ? v : sigmoidf_(v))); }
          *(half4*)(c.W<h16>(WS_L16) + (size_t)m * 256 + c4) = o; }
    }
}

constexpr int SCS = 2056;
DI unsigned sortable(float v) { if (v == 0.f) v = 0.f; const unsigned u = __builtin_bit_cast(unsigned, v); return (u & 0x80000000u) ? ~u : (u | 0x80000000u); }
DI void dsa_select_item(const Ctx& c, int item) {
    const int b = item >> 7, t0 = (item & 127) * 16; const int lane = c.lane, w = c.wave;
    unsigned* dmask = c.W<unsigned>(WS_DMASK);
    if (t0 < 256) {
        for (int e = c.tid; e < 16 * 64; e += NTHREADS) { const int qi = e >> 6, wd = e & 63, t = t0 + qi; const int nb = t + 1 - 32 * wd;
            dmask[(size_t)(b * T + t) * 64 + wd] = nb <= 0 ? 0u : (nb >= 32 ? 0xFFFFFFFFu : ((1u << nb) - 1u)); }
        return;
    }
    float* sc = (float*)c.lds;
    const h16* Z = c.W<h16>(WS_Z); const h16* IK = c.W<h16>(WS_IK) + (size_t)b * T * 64;
    const int r = lane & 31, hf = lane >> 5, hd = r & 3;
    half8 qf[2][4]; float iw[2];
    _Pragma("unroll") for (int cb = 0; cb < 2; ++cb) { const int mq = b * T + t0 + 8 * cb + (r >> 2); const h16* zq = Z + (size_t)mq * ZC;
        _Pragma("unroll") for (int ks = 0; ks < 4; ++ks) qf[cb][ks] = *(const half8*)(zq + C_IQ + hd * 64 + 16 * ks + 8 * hf);
        iw[cb] = (float)zq[C_IW + hd]; }
    const int ntile = (t0 + 15) / 32 + 1;
    for (int kt = w; kt < ntile; kt += 8) {
        const h16* kr = IK + (size_t)(32 * kt + r) * 64 + 8 * hf;
        f32x16 s0 = {}, s1 = {};
        _Pragma("unroll") for (int ks = 0; ks < 4; ++ks) { const half8 kf = *(const half8*)(kr + 16 * ks); s0 = MFMA32(kf, qf[0][ks], s0); s1 = MFMA32(kf, qf[1][ks], s1); }
        _Pragma("unroll") for (int i = 0; i < 16; ++i) { const int key = 32 * kt + crow(i, hf);
            const float v0 = quad_sum(iw[0] * fmaxf(s0[i], 0.f)), v1 = quad_sum(iw[1] * fmaxf(s1[i], 0.f));
            if (hd == 0) { sc[(r >> 2) * SCS + key] = v0; sc[(8 + (r >> 2)) * SCS + key] = v1; } }
    }
    __syncthreads();
    _Pragma("unroll") for (int qq = 0; qq < 2; ++qq) {
        const int qi = 2 * w + qq, t = t0 + qi; unsigned u[32];
        _Pragma("unroll") for (int i = 0; i < 32; ++i) { const int key = 64 * i + lane; u[i] = key <= t ? sortable(sc[qi * SCS + key]) : 0u; }
        unsigned thr = 0u; bool exact = false;
        for (int bit = 31; bit >= 0; --bit) { const unsigned cand = thr | (1u << bit); int cnt = 0;
            _Pragma("unroll") for (int i = 0; i < 32; ++i) cnt += __popcll(__ballot(u[i] >= cand));
            if (cnt >= 256) { thr = cand; if (cnt == 256) { exact = true; break; } } }
        int need = 0;
        if (!exact) { int cg_ = 0; _Pragma("unroll") for (int i = 0; i < 32; ++i) cg_ += __popcll(__ballot(u[i] > thr)); need = 256 - cg_; }
        unsigned long long mine = 0ull; int run = 0;
        _Pragma("unroll") for (int i = 0; i < 32; ++i) { bool sel;
            if (exact) sel = u[i] >= thr;
            else { const bool eq = (u[i] == thr); const unsigned long long be = __ballot(eq); const int pre = run + __popcll(be & ((1ull << lane) - 1ull)); sel = (u[i] > thr) || (eq && pre < need); run += __popcll(be); }
            const unsigned long long bs = __ballot(sel); if (lane == i) mine = bs; }
        if (lane < 32) *(unsigned long long*)(dmask + (size_t)(b * T + t) * 64 + 2 * lane) = mine;
    }
}

struct Flash { f32x16 o0, o1; float mx, l; DI void init() { _Pragma("unroll") for (int i = 0; i < 16; ++i) { o0[i] = 0.f; o1[i] = 0.f; } mx = -1e30f; l = 0.f; } };
template <class VF>
DI void flash_tile(Flash& f, const half8 (&qf)[4], const h16* Kb, const h16* Vt, int ldv, int key0, int lane, VF valid) {
    const int r = lane & 31, hf = lane >> 5;
    const h16* kr = Kb + (size_t)(key0 + r) * 64 + 8 * hf;
    f32x16 s = {};
    _Pragma("unroll") for (int ks = 0; ks < 4; ++ks) { const half8 kf = *(const half8*)(kr + 16 * ks); s = MFMA32(kf, qf[ks], s); }
    float tmax = -1e30f;
    _Pragma("unroll") for (int i = 0; i < 16; ++i) { s[i] = valid(i) ? s[i] : -1e30f; tmax = fmaxf(tmax, s[i]); }
    tmax = fmaxf(tmax, __shfl_xor(tmax, 32));
    const float mnew = fmaxf(f.mx, tmax), alpha = __expf(f.mx - mnew);
    float psum = 0.f;
    _Pragma("unroll") for (int i = 0; i < 16; ++i) { const float p = s[i] > -1e29f ? __expf(s[i] - mnew) : 0.f; s[i] = p; psum += p; }
    f.l = f.l * alpha + psum; f.mx = mnew;
    _Pragma("unroll") for (int i = 0; i < 16; ++i) { f.o0[i] *= alpha; f.o1[i] *= alpha; }
    _Pragma("unroll") for (int st = 0; st < 2; ++st) { half8 pf; _Pragma("unroll") for (int j = 0; j < 8; ++j) pf[j] = (h16)s[8 * st + j];
        const h16* vp0 = Vt + (size_t)r * ldv + key0 + 16 * st + 4 * hf; const h16* vp1 = vp0 + (size_t)32 * ldv;
        const half4 a0 = *(const half4*)vp0, b0 = *(const half4*)(vp0 + 8), a1 = *(const half4*)vp1, b1 = *(const half4*)(vp1 + 8);
        const half8 v0 = __builtin_shufflevector(a0, b0, 0, 1, 2, 3, 4, 5, 6, 7), v1 = __builtin_shufflevector(a1, b1, 0, 1, 2, 3, 4, 5, 6, 7);
        f.o0 = MFMA32(v0, pf, f.o0); f.o1 = MFMA32(v1, pf, f.o1); }
}
DI void store_o(h16* dst  , const f32x16& o0, const f32x16& o1, int hf) {
    _Pragma("unroll") for (int g = 0; g < 4; ++g) { half4 a, b; _Pragma("unroll") for (int j = 0; j < 4; ++j) { a[j] = (h16)o0[4 * g + j]; b[j] = (h16)o1[4 * g + j]; }
        *(half4*)(dst + 8 * g + 4 * hf) = a; *(half4*)(dst + 32 + 8 * g + 4 * hf) = b; }
}
DI void dsa_attn_wave(const Ctx& c, int b, int t0) {
    const int lane = c.lane, r = lane & 31, hf = lane >> 5, hd = r & 3, t = t0 + (r >> 2), m = b * T + t;
    const h16* zq = c.W<h16>(WS_Z) + (size_t)m * ZC + C_QA + hd * 64 + 8 * hf;
    half8 qf[4]; _Pragma("unroll") for (int ks = 0; ks < 4; ++ks) qf[ks] = *(const half8*)(zq + 16 * ks);
    const h16* Kb = c.W<h16>(WS_KA) + (size_t)b * T * 64; const h16* Vt = c.W<h16>(WS_VAT) + (size_t)b * 64 * T;
    const unsigned* mrow = c.W<unsigned>(WS_DMASK) + (size_t)m * 64;
    Flash f; f.init();
    const int ntile = (t0 + 7) / 32 + 1;
    for (int kt = 0; kt < ntile; ++kt) { const unsigned word = mrow[kt]; if (__ballot(word != 0u) == 0ull) continue;
        flash_tile(f, qf, Kb, Vt, T, 32 * kt, lane, [&](int i) { return ((word >> crow(i, hf)) & 1u) != 0u; }); }
    const float lt = f.l + __shfl_xor(f.l, 32), inv = rcpf_(lt);
    _Pragma("unroll") for (int i = 0; i < 16; ++i) { f.o0[i] *= inv; f.o1[i] *= inv; }
    store_o(c.W<h16>(WS_ACT) + (size_t)m * D + hd * 64, f.o0, f.o1, hf);
}
DI void nsa_attn_wave(const Ctx& c, int b, int t0) {
    const int lane = c.lane, w = c.wave, r = lane & 31, hf = lane >> 5, hd = r & 3, qi = r >> 2, t = t0 + qi, m = b * T + t;
    const h16* zrow = c.W<h16>(WS_Z) + (size_t)m * ZC;
    half8 qf[4]; _Pragma("unroll") for (int ks = 0; ks < 4; ++ks) qf[ks] = *(const half8*)(zrow + C_QC + hd * 64 + 8 * hf + 16 * ks);
    const float g0 = sigmoidf_((float)zrow[C_GC + hd * 3 + 0]), g1 = sigmoidf_((float)zrow[C_GC + hd * 3 + 1]), g2 = sigmoidf_((float)zrow[C_GC + hd * 3 + 2]);
    float* GS = (float*)(c.lds + w * 4096); float* LA = GS + 256; float* IMPF = GS + 512; unsigned* SELM = (unsigned*)(GS + 768);
    f32x16 a0, a1;
    {
        const h16* Kc = c.W<h16>(WS_KCMP) + (size_t)b * 128 * 64; const h16* Vc = c.W<h16>(WS_VCMPT) + (size_t)b * 64 * 128;
        const int nmax = t >= 31 ? ((t - 31) >> 4) : -1;
        f32x16 s[4]; float mxv = -1e30f;
        _Pragma("unroll") for (int tl = 0; tl < 4; ++tl) { const h16* kr = Kc + (size_t)(32 * tl + r) * 64 + 8 * hf; f32x16 a = {};
            _Pragma("unroll") for (int ks = 0; ks < 4; ++ks) { const half8 kf = *(const half8*)(kr + 16 * ks); a = MFMA32(kf, qf[ks], a); }
            _Pragma("unroll") for (int i = 0; i < 16; ++i) { const int n = 32 * tl + crow(i, hf); a[i] = n <= nmax ? a[i] : -1e30f; mxv = fmaxf(mxv, a[i]); }
            s[tl] = a; }
        mxv = fmaxf(mxv, __shfl_xor(mxv, 32));
        float sum = 0.f;
        _Pragma("unroll") for (int tl = 0; tl < 4; ++tl) _Pragma("unroll") for (int i = 0; i < 16; ++i) { const float p = s[tl][i] > -1e29f ? __expf(s[tl][i] - mxv) : 0.f; s[tl][i] = p; sum += p; }
        sum += __shfl_xor(sum, 32);
        const float inv = sum > 0.f ? rcpf_(sum) : 0.f;
        f32x16 o0 = {}, o1 = {};
        _Pragma("unroll") for (int tl = 0; tl < 4; ++tl) { _Pragma("unroll") for (int i = 0; i < 16; ++i) s[tl][i] *= inv;
            _Pragma("unroll") for (int st = 0; st < 2; ++st) { half8 pf; _Pragma("unroll") for (int j = 0; j < 8; ++j) pf[j] = (h16)s[tl][8 * st + j];
                const h16* vp0 = Vc + (size_t)r * 128 + 32 * tl + 16 * st + 4 * hf; const h16* vp1 = vp0 + 32 * 128;
                const half4 x0 = *(const half4*)vp0, y0 = *(const half4*)(vp0 + 8), x1 = *(const half4*)vp1, y1 = *(const half4*)(vp1 + 8);
                o0 = MFMA32(__builtin_shufflevector(x0, y0, 0, 1, 2, 3, 4, 5, 6, 7), pf, o0); o1 = MFMA32(__builtin_shufflevector(x1, y1, 0, 1, 2, 3, 4, 5, 6, 7), pf, o1); } }
        _Pragma("unroll") for (int i = 0; i < 16; ++i) { a0[i] = g0 * o0[i]; a1[i] = g0 * o1[i]; }
        _Pragma("unroll") for (int tl = 0; tl < 4; ++tl) _Pragma("unroll") for (int g = 0; g < 4; ++g) { const int G = 8 * tl + 2 * g + hf;
            const float gs = quad_sum((s[tl][4 * g] + s[tl][4 * g + 1]) + (s[tl][4 * g + 2] + s[tl][4 * g + 3])); const float la = quad_sum(s[tl][4 * g + 3]);
            if (hd == 0) { GS[qi * 32 + G] = gs; LA[qi * 32 + G] = la; } }
        WSYNC();
        _Pragma("unroll") for (int it = 0; it < 4; ++it) { const int q = (lane >> 5) + 2 * it, j = lane & 31, tq = t0 + q, cur = tq >> 6;
            const float imp = GS[q * 32 + j] + (j > 0 ? LA[q * 32 + j - 1] : 0.f);
            const bool adm = (j * 64 <= tq), forced = (j == 0) || (j == cur) || (j == cur - 1);
            IMPF[q * 32 + j] = adm ? (forced ? __builtin_inff() : imp) : -__builtin_inff(); }
        WSYNC();
        _Pragma("unroll") for (int it = 0; it < 4; ++it) { const int q = (lane >> 5) + 2 * it, j = lane & 31; const float mv = IMPF[q * 32 + j]; int rank = 0;
            _Pragma("unroll") for (int jj = 0; jj < 32; ++jj) { const float ov = IMPF[q * 32 + jj]; rank += (ov > mv || (ov == mv && jj < j)) ? 1 : 0; }
            const unsigned long long bs = __ballot(rank < 16);
            if (lane == 0) { SELM[2 * it] = (unsigned)bs; SELM[2 * it + 1] = (unsigned)(bs >> 32); } }
        WSYNC();
    }
    const unsigned selmask = SELM[qi];
    WSYNC();
    {
        const h16* Kb = c.W<h16>(WS_KS) + (size_t)b * T * 64; const h16* Vt = c.W<h16>(WS_VST) + (size_t)b * 64 * T;
        Flash f; f.init();
        const int ntile = (t0 + 7) / 32 + 1;
        for (int kt = 0; kt < ntile; ++kt) { const bool bit = ((selmask >> (kt >> 1)) & 1u) != 0u; if (__ballot(bit) == 0ull) continue;
            const int key0 = 32 * kt; flash_tile(f, qf, Kb, Vt, T, key0, lane, [&](int i) { return bit && (key0 + crow(i, hf) <= t); }); }
        const float lt = f.l + __shfl_xor(f.l, 32), sc = g1 * rcpf_(lt);
        _Pragma("unroll") for (int i = 0; i < 16; ++i) { a0[i] += sc * f.o0[i]; a1[i] += sc * f.o1[i]; }
    }
    {
        const h16* Kb = c.W<h16>(WS_KW) + (size_t)b * T * 64; const h16* Vt = c.W<h16>(WS_VWT) + (size_t)b * 64 * T;
        Flash f; f.init();
        const int lo = (t0 - 511 > 0 ? t0 - 511 : 0) >> 5, hiT = (t0 + 7) >> 5;
        for (int kt = lo; kt <= hiT; ++kt) { const int key0 = 32 * kt;
            flash_tile(f, qf, Kb, Vt, T, key0, lane, [&](int i) { const int key = key0 + crow(i, hf); return key <= t && key > t - 512; }); }
        const float lt = f.l + __shfl_xor(f.l, 32), sc = g2 * rcpf_(lt);
        _Pragma("unroll") for (int i = 0; i < 16; ++i) { a0[i] += sc * f.o0[i]; a1[i] += sc * f.o1[i]; }
    }
    store_o(c.W<h16>(WS_ACT) + (size_t)m * D + 768 + hd * 64, a0, a1, hf);
}

DI void rwkv_item(const Ctx& c, int l, int item) {
    const int b = item >> 3, h = item & 7; const int tid = c.tid, lane = c.lane, w = c.wave;
    float* kkL = (float*)c.lds; float* wL = kkL + 2048; float* kpL = wL + 2048; float* bbL = kpL + 2048; float* rrL = bbL + 2048; float* vvL = rrL + 2048; float* yL = vvL + 2048;
    const h16* Z = c.W<h16>(WS_Z); const h16* DEC = c.W<h16>(WS_DEC); const h16* AA = c.W<h16>(WS_A); const h16* GG = c.W<h16>(WS_G); h16* MIX = c.W<h16>(WS_ACT);
    const float* mu = c.inl(I_MU, l, 1792); const float* k_k = c.inl(I_KK, l, 512); const float* k_a = c.inl(I_KA, l, 512); const float* r_k = c.inl(I_RK, l, 512);
    const float* ln_w = c.inl(I_LNW, l, 512); const float* ln_b = c.inl(I_LNB, l, 512);
    const int s_ = tid >> 4, ch = (tid & 15) * 4, col = h * 64 + ch;
    float mur[4], muk[4], muv[4], kkc[4], kac[4], rkc[4], lw[4], lb[4];
    _Pragma("unroll") for (int q = 0; q < 4; ++q) { mur[q] = mu[col + q]; muk[q] = mu[512 + col + q]; muv[q] = mu[1024 + col + q]; kkc[q] = k_k[col + q]; kac[q] = k_a[col + q]; rkc[q] = r_k[col + q]; lw[q] = ln_w[col + q]; lb[q] = ln_b[col + q]; }
    const int rl = lane >> 3, cc = lane & 7, irow = 8 * w + rl, j0 = 8 * cc;
    float S[8]; _Pragma("unroll") for (int q = 0; q < 8; ++q) S[q] = 0.f;
    for (int chunk = 0; chunk < 64; ++chunk) {
        const int tt0 = chunk * 32; const int m = b * T + tt0 + s_;
        __syncthreads();
        {
            const h16* zr = Z + (size_t)m * ZC; const bool hasp = (tt0 + s_) > 0;
            const half4 r4 = *(const half4*)(zr + C_R + col), k4 = *(const half4*)(zr + C_K + col), v4 = *(const half4*)(zr + C_V + col);
            half4 rp = {0, 0, 0, 0}, kp_ = {0, 0, 0, 0}, vp = {0, 0, 0, 0};
            if (hasp) { rp = *(const half4*)(zr - ZC + C_R + col); kp_ = *(const half4*)(zr - ZC + C_K + col); vp = *(const half4*)(zr - ZC + C_V + col); }
            const half4 d4 = *(const half4*)(DEC + (size_t)m * 512 + col), a4 = *(const half4*)(AA + (size_t)m * 512 + col);
            float rr[4], kx[4], vv[4], kr[4]; float ss = 0.f;
            _Pragma("unroll") for (int q = 0; q < 4; ++q) { const float r0 = (float)r4[q], k0 = (float)k4[q], v0 = (float)v4[q];
                rr[q] = r0 + ((float)rp[q] - r0) * mur[q]; kx[q] = k0 + ((float)kp_[q] - k0) * muk[q]; vv[q] = v0 + ((float)vp[q] - v0) * muv[q];
                kr[q] = kx[q] * kkc[q]; ss += kr[q] * kr[q]; }
            ss = red16(ss); const float inrm = rcpf_(fmaxf(__builtin_amdgcn_sqrtf(ss), 1e-12f));
            f32x4 o_kk, o_w, o_kp, o_bb, o_r, o_v;
            _Pragma("unroll") for (int q = 0; q < 4; ++q) { const float a = (float)a4[q]; const float kk = kr[q] * inrm;
                o_kk[q] = kk; o_w[q] = (float)d4[q]; o_kp[q] = kx[q] * (1.f + (a - 1.f) * kac[q]); o_bb[q] = kk * a; o_r[q] = rr[q]; o_v[q] = vv[q]; }
            *(f32x4*)(kkL + s_ * 64 + ch) = o_kk; *(f32x4*)(wL + s_ * 64 + ch) = o_w; *(f32x4*)(kpL + s_ * 64 + ch) = o_kp;
            *(f32x4*)(bbL + s_ * 64 + ch) = o_bb; *(f32x4*)(rrL + s_ * 64 + ch) = o_r; *(f32x4*)(vvL + s_ * 64 + ch) = o_v;
        }
        __syncthreads();
#pragma unroll 4
        for (int s = 0; s < 32; ++s) {
            const f32x4 ka = *(const f32x4*)(kkL + s * 64 + j0), kb = *(const f32x4*)(kkL + s * 64 + j0 + 4);
            const f32x4 wa = *(const f32x4*)(wL + s * 64 + j0), wb = *(const f32x4*)(wL + s * 64 + j0 + 4);
            const f32x4 pa = *(const f32x4*)(kpL + s * 64 + j0), pb = *(const f32x4*)(kpL + s * 64 + j0 + 4);
            const f32x4 ba = *(const f32x4*)(bbL + s * 64 + j0), bb = *(const f32x4*)(bbL + s * 64 + j0 + 4);
            const f32x4 ra = *(const f32x4*)(rrL + s * 64 + j0), rb = *(const f32x4*)(rrL + s * 64 + j0 + 4);
            const float vv = vvL[s * 64 + irow];
            float sa = 0.f, sb = 0.f;
            _Pragma("unroll") for (int q = 0; q < 4; ++q) { sa += S[q] * ka[q]; sb += S[4 + q] * kb[q]; }
            sa = red8(sa + sb);
            float ya = 0.f, yb = 0.f;
            _Pragma("unroll") for (int q = 0; q < 4; ++q) { S[q] = S[q] * wa[q] + (vv * pa[q] - sa * ba[q]); S[4 + q] = S[4 + q] * wb[q] + (vv * pb[q] - sa * bb[q]); ya += S[q] * ra[q]; yb += S[4 + q] * rb[q]; }
            const float y = red8(ya + yb);
            if (cc == 0) yL[s * 64 + irow] = y;
        }
        __syncthreads();
        {
            const f32x4 y4 = *(const f32x4*)(yL + s_ * 64 + ch); const f32x4 r4 = *(const f32x4*)(rrL + s_ * 64 + ch), p4 = *(const f32x4*)(kpL + s_ * 64 + ch), v4 = *(const f32x4*)(vvL + s_ * 64 + ch);
            const float mean = red16((y4[0] + y4[1]) + (y4[2] + y4[3])) * (1.f / 64.f);
            float vs = 0.f, bs = 0.f; _Pragma("unroll") for (int q = 0; q < 4; ++q) { const float d = y4[q] - mean; vs += d * d; bs += r4[q] * p4[q] * rkc[q]; }
            const float rstd = rsqf_(red16(vs) * (1.f / 64.f) + 64e-5f); bs = red16(bs);
            const half4 g4 = *(const half4*)(GG + (size_t)m * 512 + col); half4 o;
            _Pragma("unroll") for (int q = 0; q < 4; ++q) o[q] = (h16)((((y4[q] - mean) * rstd * lw[q] + lb[q]) + bs * v4[q]) * (float)g4[q]);
            *(half4*)(MIX + (size_t)m * D + 256 + col) = o;
        }
    }
}

DI void phase_cmp2(const Ctx& c, int l) {
    const h16* HID = c.W<h16>(WS_HID); const float* w2 = c.inl(I_NW2, l, 2 * 256 * 64); const float* nkg = c.inl(I_NKG, l, 64);
    const int lane = c.lane; const bool hi = lane >= 32; const float inv = powf(10000.f, -(float)(lane & 31) * (1.f / 32.f));
    for (int it = c.gw; it < 2 * 1024; it += c.ngw) { const int j = it >> 10, rrow = it & 1023, b = rrow >> 7, n = rrow & 127;
        float acc = 0.f;
        if (n < 127) { const h16* hr = HID + ((size_t)j * 1024 + rrow) * 256; const float* wj = w2 + (size_t)j * 256 * 64;
            for (int k = 0; k < 256; k += 8) { const half8 hv = *(const half8*)(hr + k); _Pragma("unroll") for (int q = 0; q < 8; ++q) acc += (float)hv[q] * wj[(k + q) * 64 + lane]; } }
        if (j == 0) { const float ss = wave_sum(acc * acc); float y = acc * rsqf_(ss * (1.f / 64.f) + 1e-6f) * nkg[lane];
            const float ang = (float)(16 * n + 31) * inv; const float cs = cosf(ang), sn = sinf(ang); const float o = __shfl_xor(y, 32); y = hi ? y * cs + o * sn : y * cs - o * sn;
            c.W<h16>(WS_KCMP)[((size_t)b * 128 + n) * 64 + lane] = (h16)(n < 127 ? y : 0.f); }
        else c.W<h16>(WS_VCMPT)[((size_t)b * 64 + lane) * 128 + n] = (h16)acc; }
}

__global__ void __launch_bounds__(NTHREADS) fwd_kernel(Params p) {
    extern __shared__ __attribute__((aligned(16))) char lds[];
    cg::grid_group grid = cg::this_grid();
    Ctx c; c.out = p.out; c.ws = p.ws; c.lds = lds; c.ctl = (unsigned*)(p.ws + WS_CTL);
    c.wave = __builtin_amdgcn_readfirstlane(threadIdx.x >> 6); c.lane = lane_id(); c.tid = c.wave * 64 + c.lane; c.gw = blockIdx.x * 8 + c.wave; c.ngw = gridDim.x * 8;
    if (c.tid < 28) ((const float**)(p.ws + WS_PTRS))[c.tid] = p.in[c.tid];
    __threadfence(); __syncthreads();
    h16* ACT = c.W<h16>(WS_ACT); h16* Z = c.W<h16>(WS_Z);

#define PH() do { c.ws = launder_ptr(c.ws); c.out = launder_ptr(c.out); c.lane = lane_id(); asm volatile("" : "+v"(c.lane)); c.tid = c.wave * 64 + c.lane; c.gw = blockIdx.x * 8 + c.wave; } while (0)
    phase_mod(c);
#pragma unroll 1
    for (int l = 0; l < DEPTH; ++l) {
        const float* mod_l = c.W<float>(WS_MOD) + (size_t)l * 8 * 6144;
        PH(); convert_weights(c, l);
        PH(); phase_cbias(c, l);
        if (l == 0) grid.sync();
        PH();
        phase_norm(c, l == 0 ? c.inp(I_X) : c.out, c.inl(I_N1G, l, D), mod_l, 0, 1024);
        grid.sync(); PH();
        phase_gemm(c, ACT, D, c.W<h16>(WS_WIN), D, D, 64, 13, EpiZ{Z, ZC});
        grid.sync(); PH();
        phase_prep(c, l);
        grid.sync(); PH();
        {
            unsigned* ctr = c.ctl + 16 * (2 * l);
            for (;;) { const int it = next_item(ctr, c.tid); if (it >= 8 + 384 + 1024) break; PH();
                if (it < 8) { const int j = it >> 2, pm = it & 3;
                    gemm_unit(c.tid, c.W<h16>(j ? WS_VC : WS_KC), 1024, c.W<h16>(WS_W1) + (size_t)j * 256 * 2048, 2048, 2048, pm * 256, 0, (h16*)lds, EpiCmp{c.W<h16>(WS_HID) + (size_t)j * 1024 * 256, c.W<float>(WS_CBIAS) + j * 256}); }
                else if (it < 392) { const int u = it - 8, pm = u / 6, pn = u % 6;
                    gemm_unit(c.tid, c.W<h16>(WS_L16), 256, c.W<h16>(WS_WL), 256, 256, pm * 256, pn * 256, (h16*)lds, EpiLora{c.W<h16>(WS_DEC), c.W<h16>(WS_A), c.W<h16>(WS_G), c.inl(I_W0, l, 512), c.inl(I_A0, l, 512)}); }
                else dsa_select_item(c, 1023 - (it - 392)); }
        }
        grid.sync(); PH();
        phase_cmp2(c, l);
        grid.sync(); PH();
        {
            unsigned* ctr = c.ctl + 16 * (2 * l + 1);
            for (;;) { const int it = next_item(ctr, c.tid); if (it >= 64 + 512) break; PH();
                if (it < 64) rwkv_item(c, l, it);
                else { const int a = it - 64; const int kind = a >> 8, idx = 255 - (a & 255); const int b = idx & 7, qb = idx >> 3; const int t0 = qb * 64 + c.wave * 8;
                    if (kind == 0) nsa_attn_wave(c, b, t0); else dsa_attn_wave(c, b, t0); } }
        }
        grid.sync(); PH();
        phase_gemm(c, ACT, D, c.W<h16>(WS_WOUT), D, D, 64, 4, EpiRes{l == 0 ? c.inp(I_X) : c.out, c.out, mod_l + 2048});
        grid.sync(); PH();
        phase_norm(c, c.out, c.inl(I_N2G, l, D), mod_l, 3072, 4096);
        grid.sync(); PH();
        phase_gemm(c, ACT, D, c.W<h16>(WS_WI), D, D, 64, 22, EpiSwiglu{Z});
        grid.sync(); PH();
        phase_gemm(c, Z, FF, c.W<h16>(WS_WO), FF, FF, 64, 4, EpiRes{c.out, c.out, mod_l + 5120});
        grid.sync(); PH();
    }
}

extern "C" void kernel_launch(void* const* d_in, const int* in_sizes, int n_in, void* d_out, int out_size, void* d_ws, size_t ws_size, hipStream_t stream) {
    static int grid_blocks = 0;
    if (grid_blocks == 0) {
        if (n_in != 28 || ws_size < WS_END) { fprintf(stderr, "kernel_launch: unexpected n_in %d / ws %zu\n", n_in, ws_size); grid_blocks = -1; return; }
        int dev = 0, cus = 0, per_cu = 0;
        hipGetDevice(&dev); hipDeviceGetAttribute(&cus, hipDeviceAttributeMultiprocessorCount, dev);
        hipFuncSetAttribute((const void*)fwd_kernel, hipFuncAttributeMaxDynamicSharedMemorySize, LDS_BYTES);
        hipOccupancyMaxActiveBlocksPerMultiprocessor(&per_cu, (const void*)fwd_kernel, NTHREADS, LDS_BYTES);
        if (per_cu < 1) { fprintf(stderr, "kernel_launch: occupancy query says %d blocks/CU\n", per_cu); per_cu = 1; }
        grid_blocks = cus * 1;
    }
    if (grid_blocks < 0) return;
    hipMemsetAsync((char*)d_ws + WS_CTL, 0, 64 * 1024, stream);
    Params p{};
    for (int i = 0; i < 28; ++i) p.in[i] = (const float*)d_in[i];
    p.out = (float*)d_out; p.ws = (unsigned char*)d_ws;
    void* args[] = {&p};
    hipError_t e = hipLaunchCooperativeKernel((const void*)fwd_kernel, dim3(grid_blocks), dim3(NTHREADS), args, LDS_BYTES, stream);
    if (e != hipSuccess) fprintf(stderr, "cooperative launch failed: %s (grid %d)\n", hipGetErrorString(e), grid_blocks);
}
```

```cpp
#include <hip/hip_runtime.h>
#include <hip/hip_cooperative_groups.h>
#include <cstdio>
#include <cstdint>
namespace cg = cooperative_groups;

typedef _Float16 h16;
typedef _Float16 half8 __attribute__((ext_vector_type(8)));
typedef _Float16 half4 __attribute__((ext_vector_type(4)));
typedef float f32x4 __attribute__((ext_vector_type(4)));
typedef float f32x16 __attribute__((ext_vector_type(16)));
#define LAS __attribute__((address_space(3)))
#define DI __device__ __forceinline__

constexpr int D = 1024, NB = 8, T = 2048, M = NB * T, FF = 2816, DEPTH = 2;
constexpr int ZC = 3328;
constexpr int C_QA = 0, C_KA = 256, C_VA = 320, C_IQ = 384, C_IK = 640, C_IW = 704;
constexpr int C_R = 768, C_K = 1280, C_V = 1792, C_WD = 2304;
constexpr int C_QC = 2560, C_KC = 2816, C_VC = 2880, C_KS = 2944, C_VS = 3008, C_KW = 3072, C_VW = 3136, C_GC = 3200;
constexpr int NTHREADS = 512;
constexpr int LDS_BYTES = 139264;

constexpr size_t MiB = 1u << 20;
constexpr size_t WS_CTL = 0;
constexpr size_t WS_PTRS = 60 * 1024;
constexpr size_t WS_MOD = 64 * 1024;
constexpr size_t WS_CBIAS = 512 * 1024;
constexpr size_t WS_KCMP = 1 * MiB;
constexpr size_t WS_VCMPT = 1 * MiB + 128 * 1024;
constexpr size_t WS_HID = 2 * MiB;
constexpr size_t WS_KA = 4 * MiB, WS_IK = 6 * MiB, WS_KS = 8 * MiB, WS_KW = 10 * MiB;
constexpr size_t WS_VAT = 12 * MiB, WS_VST = 14 * MiB, WS_VWT = 16 * MiB;
constexpr size_t WS_DMASK = 18 * MiB;
constexpr size_t WS_WIN = 22 * MiB;
constexpr size_t WS_WOUT = WS_WIN + 6656 * 1024;
constexpr size_t WS_WI = WS_WOUT + 2 * MiB;
constexpr size_t WS_WO = WS_WI + 11 * MiB;
constexpr size_t WS_W1 = WS_WO + 5632 * 1024;
constexpr size_t WS_WL = WS_W1 + 2 * MiB;
constexpr size_t WS_ACT = 50 * MiB;
constexpr size_t WS_L16 = WS_ACT, WS_KC = WS_ACT + 8 * MiB, WS_VC = WS_ACT + 12 * MiB;
constexpr size_t WS_DEC = 82 * MiB, WS_A = 98 * MiB, WS_G = 114 * MiB;
constexpr size_t WS_Z = 130 * MiB;
constexpr size_t WS_END = 234 * MiB;
static_assert(WS_WL + 768 * 1024 <= WS_ACT, "weights fit");

struct Params { const float* in[28]; float* out; unsigned char* ws; };
enum { I_X = 0, I_C, I_ADAW, I_ADAB, I_N1G, I_WIN, I_DQG, I_DKG, I_MU, I_W0, I_W2, I_A0, I_A2, I_G2, I_KK, I_KA, I_RK, I_LNW, I_LNB,
       I_NQG, I_NKG, I_PE, I_NW1, I_NW2, I_WOUT, I_N2G, I_FWI, I_FWO };

template <int CTRL> DI float dpp_f(float x) { return __builtin_bit_cast(float, __builtin_amdgcn_update_dpp(0, __builtin_bit_cast(int, x), CTRL, 0xF, 0xF, true)); }
DI float quad_sum(float x) { x += dpp_f<0xB1>(x); x += dpp_f<0x4E>(x); return x; }
DI float red8(float x) { x += dpp_f<0xB1>(x); x += dpp_f<0x4E>(x); x += dpp_f<0x141>(x); return x; }
DI float red16(float x) { x += __shfl_xor(x, 1); x += __shfl_xor(x, 2); x += __shfl_xor(x, 4); x += __shfl_xor(x, 8); return x; }
DI float wave_sum(float x) { for (int o = 1; o < 64; o <<= 1) x += __shfl_xor(x, o); return x; }
DI float rcpf_(float x) { return __builtin_amdgcn_rcpf(x); }
DI float rsqf_(float x) { return __builtin_amdgcn_rsqf(x); }
DI float sigmoidf_(float x) { return rcpf_(1.f + __expf(-x)); }
DI int crow(int i, int h) { return (i & 3) + 8 * (i >> 2) + 4 * h; }
#define WSYNC() asm volatile("s_waitcnt lgkmcnt(0)" ::: "memory")
#define MFMA32(a, b, c) __builtin_amdgcn_mfma_f32_32x32x16_f16((a), (b), (c), 0, 0, 0)

template <class Tp> DI Tp* launder_ptr(Tp* p) {
    unsigned lo = (unsigned)(uintptr_t)p, hi = (unsigned)((uintptr_t)p >> 32); asm volatile("" : "+v"(lo), "+v"(hi));
    lo = __builtin_amdgcn_readfirstlane(lo); hi = __builtin_amdgcn_readfirstlane(hi); return (Tp*)(((uintptr_t)hi << 32) | lo); }
DI int lane_id() { return (int)__builtin_amdgcn_mbcnt_hi(~0u, __builtin_amdgcn_mbcnt_lo(~0u, 0u)); }
__shared__ int s_item;
DI int next_item(unsigned* ctr, int tid) {
    __syncthreads();
    if (tid == 0) s_item = (int)atomicAdd(ctr, 1u);
    __syncthreads();
    return s_item;
}


#define XB_TMO      128
#define XB_XCNT(j)  (256  + 64 * (j))
#define XB_XSUB(j)  (1280 + 64 * (j))
#define XB_XGEN(j)  (2304 + 64 * (j))
#define XB_TOP      3328
#define XB_TOPGEN   3392
#define XB_SPIN_CAP (1u << 22)
DI unsigned xb_ld(unsigned* p) { return __hip_atomic_load(p, __ATOMIC_RELAXED, __HIP_MEMORY_SCOPE_AGENT); }
DI unsigned xb_add(unsigned* p, unsigned v) { return __hip_atomic_fetch_add(p, v, __ATOMIC_RELAXED, __HIP_MEMORY_SCOPE_AGENT); }
DI unsigned xb_xcc_id() { return (unsigned)__builtin_amdgcn_s_getreg((3 << 11) | 20) & 0xFu; }
#define XB_SPIN(cond, bar) do { unsigned _sp = 0; while (cond) { __builtin_amdgcn_s_sleep(1); \
    if ((++_sp & 255u) == 0u) { if (xb_ld(&(bar)[XB_TMO])) break; if (_sp > XB_SPIN_CAP) { atomicAdd(&(bar)[XB_TMO], 1u); break; } } } } while (0)
__shared__ unsigned s_xb[2];
DI void xcd_barrier_complete(unsigned* bar, unsigned x, unsigned& nloc, unsigned& nx) {
    const unsigned G = gridDim.x; unsigned sum, cnt, mine, sp = 0u;
    for (;;) { sum = 0u; cnt = 0u; mine = 0u;
        _Pragma("unroll") for (unsigned j = 0; j < 16; ++j) { const unsigned c = xb_ld(&bar[XB_XCNT(j)]); sum += c; cnt += (c > 0u) ? 1u : 0u; mine = (j == x) ? c : mine; }
        if (sum == G) break;
        __builtin_amdgcn_s_sleep(1);
        if ((++sp & 255u) == 0u) { if (xb_ld(&bar[XB_TMO])) break; if (sp > XB_SPIN_CAP) { atomicAdd(&bar[XB_TMO], 1u); break; } } }
    nloc = mine > 0u ? mine : 1u; nx = cnt > 0u ? cnt : 1u;
}
DI void xcd_barrier(unsigned* bar, int tid) {
    asm volatile("s_waitcnt vmcnt(0)" ::: "memory");
    __syncthreads();
    if (tid == 0) {
        __builtin_amdgcn_s_waitcnt(0);
        const unsigned x = xb_xcc_id();
        unsigned nloc = s_xb[0], nx = s_xb[1];
        if (nloc == 0u) { xcd_barrier_complete(bar, x, nloc, nx); s_xb[0] = nloc; s_xb[1] = nx; }
        const unsigned old = xb_add(&bar[XB_XSUB(x)], 1u);
        const unsigned gen = old / nloc;
        if (old + 1u == (gen + 1u) * nloc) {
            __builtin_amdgcn_fence(__ATOMIC_RELEASE, "agent");
            asm volatile("s_waitcnt vmcnt(0)" ::: "memory");
            const unsigned og = xb_add(&bar[XB_TOP], 1u);
            const unsigned tg = og / nx;
            if (og + 1u == (tg + 1u) * nx) xb_add(&bar[XB_TOPGEN], 1u);
            else XB_SPIN(xb_ld(&bar[XB_TOPGEN]) == tg, bar);
            __builtin_amdgcn_fence(__ATOMIC_ACQUIRE, "agent");
            xb_add(&bar[XB_XGEN(x)], 1u);
            asm volatile("s_waitcnt vmcnt(0)" ::: "memory");
        } else {
            XB_SPIN(xb_ld(&bar[XB_XGEN(x)]) == gen, bar);
            __builtin_amdgcn_fence(__ATOMIC_ACQUIRE, "agent");
            asm volatile("s_waitcnt vmcnt(0)" ::: "memory");
        }
    }
    __syncthreads();
}

constexpr int BK = 64, HALF = 128, HT = HALF * BK;
DI void stage_rc(int b, int& R, int& C) { int st = b / 1024, sb = b % 1024, swz = sb ^ (((sb >> 9) & 1) << 5); R = (st >> 1) * 16 + swz / 64; C = (st & 1) * 32 + (swz % 64) / 2; }

template <class Epi>
DI void gemm_unit(int tid_in, const h16* __restrict__ A, int lda, const h16* __restrict__ Bt, int ldb, int K, int brow, int bcol, h16* shm, const Epi& epi) {
#define SA(b, h) (shm + ((b) * 2 + (h)) * HT)
#define SB(b, h) (shm + (4 + (b) * 2 + (h)) * HT)
#define STAGE_A(P, br, kt) do { const char* _g = (const char*)(A + ((long)(br) * lda + (long)(kt) * BK)); \
    __builtin_amdgcn_global_load_lds((const unsigned*)(_g + oa0), (LAS unsigned*)((char*)(P) + tidx * 16), 16, 0, 0); \
    __builtin_amdgcn_global_load_lds((const unsigned*)(_g + (size_t)lda * 128 + oa0), (LAS unsigned*)((char*)(P) + tidx * 16 + 8192), 16, 0, 0); } while (0)
#define STAGE_B(P, br, kt) do { const char* _g = (const char*)(Bt + ((long)(br) * ldb + (long)(kt) * BK)); \
    __builtin_amdgcn_global_load_lds((const unsigned*)(_g + ob0), (LAS unsigned*)((char*)(P) + tidx * 16), 16, 0, 0); \
    __builtin_amdgcn_global_load_lds((const unsigned*)(_g + (size_t)ldb * 128 + ob0), (LAS unsigned*)((char*)(P) + tidx * 16 + 8192), 16, 0, 0); } while (0)
#define LDA(dst, b, h) _Pragma("unroll") for (int m = 0; m < 4; ++m) _Pragma("unroll") for (int k = 0; k < 2; ++k) dst[m][k] = *reinterpret_cast<const half8*>((char*)SA(b, h) + la + (m * 2 + k) * 1024)
#define LDB(dst, b, h) _Pragma("unroll") for (int n = 0; n < 2; ++n) _Pragma("unroll") for (int k = 0; k < 2; ++k) dst[n][k] = *reinterpret_cast<const half8*>((char*)SB(b, h) + lb + (n * 2 + k) * 1024)
#define MMA(ai, bj, At_, Bt_) do { __builtin_amdgcn_s_setprio(1); \
    _Pragma("unroll") for (int m = 0; m < 4; ++m) _Pragma("unroll") for (int n = 0; n < 2; ++n) _Pragma("unroll") for (int k = 0; k < 2; ++k) \
        acc[ai][bj][m][n] = __builtin_amdgcn_mfma_f32_16x16x32_f16(Bt_[n][k], At_[m][k], acc[ai][bj][m][n], 0, 0, 0); \
    __builtin_amdgcn_s_setprio(0); } while (0)
#define WAIT_V(n) asm volatile("s_waitcnt vmcnt(" #n ")" ::: "memory")
#define WAIT_L(n) asm volatile("s_waitcnt lgkmcnt(" #n ")" ::: "memory")
#define BAR __builtin_amdgcn_s_barrier()
#define SCHED __builtin_amdgcn_sched_barrier(0)
    int tidx = tid_in; asm volatile("" : "+v"(tidx));
    const int wid = tidx >> 6, lane = tidx & 63, wr = wid >> 2, wc = wid & 3, fr = lane & 15, fq = lane >> 4;
    const int lpart = ((fr * 64 + fq * 16) ^ ((fr >> 3) << 5));
    const int la = wr * 8192 + lpart, lb = wc * 4096 + lpart;
    unsigned oa0, ob0;
    { int _r, _c; stage_rc(tidx * 16, _r, _c); oa0 = (unsigned)(_r * lda + _c) * 2u; ob0 = (unsigned)(_r * ldb + _c) * 2u; }
    f32x4 acc[2][2][4][2] = {};
    half8 At[4][2], B0[2][2], B1[2][2];
    const int nt = K / BK;
    STAGE_B(SB(0, 0), bcol, 0); STAGE_A(SA(0, 0), brow, 0);
    STAGE_B(SB(0, 1), bcol + HALF, 0); STAGE_A(SA(0, 1), brow + HALF, 0);
    if (wr == 1) BAR;
    WAIT_V(4); BAR;
    STAGE_B(SB(1, 0), bcol, 1); STAGE_A(SA(1, 0), brow, 1); STAGE_B(SB(1, 1), bcol + HALF, 1);
    WAIT_V(6); BAR;
    for (int t = 0; t < nt - 2; t += 2) {
        LDB(B0, 0, 0); SCHED; LDA(At, 0, 0); STAGE_A(SA(1, 1), brow + HALF, t + 1);
        WAIT_L(8); BAR; WAIT_L(0); MMA(0, 0, At, B0); BAR; SCHED;
        LDB(B1, 0, 1); STAGE_B(SB(0, 0), bcol, t + 2);
        BAR; WAIT_L(0); MMA(0, 1, At, B1); BAR;
        LDA(At, 0, 1); STAGE_A(SA(0, 0), brow, t + 2);
        BAR; WAIT_L(0); MMA(1, 0, At, B0); BAR; SCHED;
        STAGE_B(SB(0, 1), bcol + HALF, t + 2);
        WAIT_V(6); BAR; MMA(1, 1, At, B1); BAR;
        LDB(B0, 1, 0); SCHED; LDA(At, 1, 0); STAGE_A(SA(0, 1), brow + HALF, t + 2);
        WAIT_L(8); BAR; WAIT_L(0); MMA(0, 0, At, B0); BAR; SCHED;
        LDB(B1, 1, 1); STAGE_B(SB(1, 0), bcol, t + 3);
        BAR; WAIT_L(0); MMA(0, 1, At, B1); BAR;
        LDA(At, 1, 1); STAGE_A(SA(1, 0), brow, t + 3);
        BAR; WAIT_L(0); MMA(1, 0, At, B0); BAR; SCHED;
        STAGE_B(SB(1, 1), bcol + HALF, t + 3);
        WAIT_V(6); BAR; MMA(1, 1, At, B1); BAR;
    }
    { LDB(B0, 0, 0); LDA(At, 0, 0); STAGE_A(SA(1, 1), brow + HALF, nt - 1);
      BAR; WAIT_L(0); MMA(0, 0, At, B0); BAR;
      LDB(B1, 0, 1); BAR; WAIT_L(0); MMA(0, 1, At, B1); BAR;
      LDA(At, 0, 1); WAIT_V(4); BAR; WAIT_L(0); MMA(1, 0, At, B0); MMA(1, 1, At, B1); BAR; }
    { LDB(B0, 1, 0); LDA(At, 1, 0); WAIT_V(2); BAR; WAIT_L(0); MMA(0, 0, At, B0); BAR;
      LDB(B1, 1, 1); WAIT_V(0); BAR; WAIT_L(0); MMA(0, 1, At, B1); BAR;
      LDA(At, 1, 1); BAR; WAIT_L(0); MMA(1, 0, At, B0); MMA(1, 1, At, B1); BAR; }
    if (wr == 0) BAR;
    epi(acc, brow + wr * 64 + fr, bcol + wc * 32 + fq * 4);
    __syncthreads();
}
DI bool unit_order(int L, int nM, int nN, int& pm, int& pn) {
    const int nwg = nM * nN; if (L >= nwg) return false;
    int wgid = L; { const int q = nwg / 8, r = nwg % 8, xcd = wgid % 8, off = wgid / 8; wgid = (xcd < r ? xcd * (q + 1) : r * (q + 1) + (xcd - r) * q) + off; }
    const int nig = 8 * nN, gid = wgid / nig, fm = gid * 8, gsz = (nM - fm) < 8 ? (nM - fm) : 8;
    pm = fm + ((wgid % nig) % gsz); pn = (wgid % nig) / gsz; return true;
}
typedef f32x4 Acc[2][2][4][2];
#define EPI_LOOP _Pragma("unroll") for (int ai = 0; ai < 2; ++ai) _Pragma("unroll") for (int bj = 0; bj < 2; ++bj) _Pragma("unroll") for (int m = 0; m < 4; ++m) _Pragma("unroll") for (int n = 0; n < 2; ++n)
struct EpiZ { h16* z; int ld;
    DI void operator()(Acc& acc, int r0, int c0) const { EPI_LOOP { const int row = r0 + ai * 128 + m * 16, col = c0 + bj * 128 + n * 16;
        half4 v; _Pragma("unroll") for (int j = 0; j < 4; ++j) v[j] = (h16)acc[ai][bj][m][n][j]; *(half4*)(z + (size_t)row * ld + col) = v; } } };
struct EpiLora { h16 *dec, *a, *g; const float *w0, *a0;
    DI void operator()(Acc& acc, int r0, int c0) const { EPI_LOOP { const int row = r0 + ai * 128 + m * 16, col = c0 + bj * 128 + n * 16; half4 v;
        if (col < 512) { _Pragma("unroll") for (int j = 0; j < 4; ++j) { const float lw = w0[col + j] + acc[ai][bj][m][n][j]; v[j] = (h16)__expf(-0.60653066f * sigmoidf_(lw)); } *(half4*)(dec + (size_t)row * 512 + col) = v; }
        else if (col < 1024) { _Pragma("unroll") for (int j = 0; j < 4; ++j) v[j] = (h16)sigmoidf_(a0[col - 512 + j] + acc[ai][bj][m][n][j]); *(half4*)(a + (size_t)row * 512 + col - 512) = v; }
        else { _Pragma("unroll") for (int j = 0; j < 4; ++j) v[j] = (h16)acc[ai][bj][m][n][j]; *(half4*)(g + (size_t)row * 512 + col - 1024) = v; } } } };
struct EpiCmp { h16* hid; const float* bias;
    DI void operator()(Acc& acc, int r0, int c0) const { EPI_LOOP { const int row = r0 + ai * 128 + m * 16, col = c0 + bj * 128 + n * 16; half4 v;
        _Pragma("unroll") for (int j = 0; j < 4; ++j) { const float x = acc[ai][bj][m][n][j] + bias[col + j]; const float u = 0.7978845608f * (x + 0.044715f * x * x * x);
            const float th = 1.f - 2.f * rcpf_(1.f + __expf(2.f * u)); v[j] = (h16)(0.5f * x * (1.f + th)); }
        *(half4*)(hid + (size_t)row * 256 + col) = v; } } };
struct EpiRes { const float* xin; float* xout; const float* gate;
    DI void operator()(Acc& acc, int r0, int c0) const { EPI_LOOP { const int row = r0 + ai * 128 + m * 16, col = c0 + bj * 128 + n * 16;
        const f32x4 xi = *(const f32x4*)(xin + (size_t)row * D + col); const f32x4 gg = *(const f32x4*)(gate + (size_t)(row >> 11) * 6144 + col);
        f32x4 o; _Pragma("unroll") for (int j = 0; j < 4; ++j) o[j] = xi[j] + gg[j] * acc[ai][bj][m][n][j]; *(f32x4*)(xout + (size_t)row * D + col) = o; } } };
struct EpiSwiglu { h16* hid;
    DI void operator()(Acc& acc, int r0, int c0) const { _Pragma("unroll") for (int ai = 0; ai < 2; ++ai) _Pragma("unroll") for (int m = 0; m < 4; ++m) _Pragma("unroll") for (int n = 0; n < 2; ++n) {
        const int row = r0 + ai * 128 + m * 16; const int tcol = c0 & 255, pn = c0 >> 8; const int col = pn * 128 + tcol + n * 16; half4 v;
        _Pragma("unroll") for (int j = 0; j < 4; ++j) { const float gt = acc[ai][0][m][n][j], up = acc[ai][1][m][n][j]; v[j] = (h16)(gt * sigmoidf_(gt) * up); }
        *(half4*)(hid + (size_t)row * FF + col) = v; } } };

struct Ctx {
    float* out; unsigned char* ws; char* lds; unsigned* ctl;
    int tid, lane, wave, gw, ngw;
    template <class Tp> DI Tp* W(size_t off) const { return (Tp*)(ws + off); }
    DI const float* inp(int i) const { const unsigned* t = (const unsigned*)(ws + WS_PTRS) + 2 * i;
        const unsigned lo = __builtin_amdgcn_readfirstlane(t[0]), hi = __builtin_amdgcn_readfirstlane(t[1]); return (const float*)(((uintptr_t)hi << 32) | lo); }
    DI const float* inl(int i, int l, size_t per_layer) const { return inp(i) + (size_t)l * per_layer; }
};

template <class CM>
DI void tr_item(const float* __restrict__ Wsrc, int K, int Nsrc, h16* WT, int k0, int n0, float* scr, int lane, CM cm) {
    const int sc = cm(n0 + (lane & 31));
#pragma unroll 8
    for (int i = 0; i < 32; ++i) { const int kk = 2 * i + (lane >> 5); scr[kk * 33 + (lane & 31)] = sc >= 0 ? Wsrc[(size_t)(k0 + kk) * Nsrc + sc] : 0.f; }
    WSYNC();
    const int c = lane & 7;
#pragma unroll
    for (int j = 0; j < 4; ++j) { const int n = (lane >> 3) + 8 * j; const float* s = scr + (8 * c) * 33 + n; half8 o;
        _Pragma("unroll") for (int q = 0; q < 8; ++q) o[q] = (h16)s[q * 33];
        *(half8*)(WT + (size_t)(n0 + n) * K + k0 + 8 * c) = o; }
    WSYNC();
}
DI void convert_weights(const Ctx& c, int l) {
    float* scr = (float*)(c.lds + c.wave * 8448);
    constexpr int I_IN = 16 * 104, I_OUT = 16 * 32, I_FI = 16 * 176, I_FO = 44 * 32, I_W1 = 32 * 8;
    constexpr int NIT = I_IN + I_OUT + I_FI + I_FO + 2 * I_W1;
    for (int it = c.gw; it < NIT; it += c.ngw) {
        int r = it;
        if (r < I_IN) { tr_item(c.inl(I_WIN, l, (size_t)D * 3152), D, 3152, c.W<h16>(WS_WIN), (r / 104) * 64, (r % 104) * 32, scr, c.lane,
                                [](int n) { return n < 708 ? n : (n < 768 ? -1 : (n < 3212 ? n - 60 : -1)); }); continue; } r -= I_IN;
        if (r < I_OUT) { tr_item(c.inl(I_WOUT, l, (size_t)D * D), D, D, c.W<h16>(WS_WOUT), (r / 32) * 64, (r % 32) * 32, scr, c.lane, [](int n) { return n; }); continue; } r -= I_OUT;
        if (r < I_FI) { tr_item(c.inl(I_FWI, l, (size_t)D * 2 * FF), D, 2 * FF, c.W<h16>(WS_WI), (r / 176) * 64, (r % 176) * 32, scr, c.lane,
                                [](int n) { const int pn = n >> 8, q = n & 255; return q < 128 ? pn * 128 + q : FF + pn * 128 + (q - 128); }); continue; } r -= I_FI;
        if (r < I_FO) { tr_item(c.inl(I_FWO, l, (size_t)FF * D), FF, D, c.W<h16>(WS_WO), (r / 32) * 64, (r % 32) * 32, scr, c.lane, [](int n) { return n; }); continue; } r -= I_FO;
        const int j = r / I_W1; r %= I_W1;
        tr_item(c.inl(I_NW1, l, (size_t)2 * 2048 * 256) + (size_t)j * 2048 * 256, 2048, 256, c.W<h16>(WS_W1) + (size_t)j * 256 * 2048, (r / 8) * 64, (r % 8) * 32, scr, c.lane, [](int n) { return n; });
    }
    const float* w2 = c.inl(I_W2, l, 64 * 512); const float* a2 = c.inl(I_A2, l, 64 * 512); const float* g2 = c.inl(I_G2, l, 128 * 512);
    h16* wl = c.W<h16>(WS_WL);
    for (int e = blockIdx.x * NTHREADS + c.tid; e < 1536 * 256; e += gridDim.x * NTHREADS) {
        const int n = e >> 8, k = e & 255; float v = 0.f;
        if (n < 512) { if (k < 64) v = w2[k * 512 + n]; }
        else if (n < 1024) { if (k >= 64 && k < 128) v = a2[(k - 64) * 512 + n - 512]; }
        else { if (k >= 128) v = g2[(k - 128) * 512 + n - 1024]; }
        wl[e] = (h16)v;
    }
}
template <int NV>
DI void gemv_item(const Ctx& c, const float* aL, int K, const float* __restrict__ Wsrc, int N, int n0, const float* bias, float* out, int out_stride, float* red) {
    const int nl = c.tid & 31, kc = c.tid >> 5, kper = K / 16;
    float acc[NV]; for (int v = 0; v < NV; ++v) acc[v] = 0.f;
    for (int k = kc * kper; k < (kc + 1) * kper; ++k) { const float w = Wsrc[(size_t)k * N + n0 + nl]; for (int v = 0; v < NV; ++v) acc[v] += aL[v * K + k] * w; }
    for (int v = 0; v < NV; ++v) red[(kc * NV + v) * 32 + nl] = acc[v];
    __syncthreads();
    if (c.tid < 32 * NV) { const int v = c.tid >> 5; float s = bias ? bias[n0 + nl] : 0.f; _Pragma("unroll") for (int q = 0; q < 16; ++q) s += red[(q * NV + v) * 32 + nl]; out[(size_t)v * out_stride + n0 + nl] = s; }
    __syncthreads();
}
DI void phase_mod(const Ctx& c) {
    float* sil = (float*)(c.lds + 70000); float* red = (float*)(c.lds + 70000 + 32768);
    for (int e = c.tid; e < 8 * 1024; e += NTHREADS) { const float x = c.inp(I_C)[e]; sil[e] = x * sigmoidf_(x); }
    __syncthreads();
    for (int it = blockIdx.x; it < 2 * 192; it += gridDim.x) { const int l = it / 192, n0 = (it % 192) * 32;
        gemv_item<8>(c, sil, 1024, c.inl(I_ADAW, l, (size_t)1024 * 6144), 6144, n0, c.inl(I_ADAB, l, 6144), c.W<float>(WS_MOD) + (size_t)l * 8 * 6144, 6144, red); }
}
DI void phase_cbias(const Ctx& c, int l) {
    float* pe = (float*)(c.lds + 70000); float* red = (float*)(c.lds + 70000 + 32768);
    __syncthreads();
    for (int e = c.tid; e < 2 * 2048; e += NTHREADS) pe[e] = c.inl(I_PE, l, 2 * 2048)[e];
    __syncthreads();
    for (int it = (int)gridDim.x - 1 - (int)blockIdx.x; it < 16; it += gridDim.x) { const int j = it >> 3, n0 = (it & 7) * 32;
        gemv_item<1>(c, pe + j * 2048, 2048, c.inl(I_NW1, l, (size_t)2 * 2048 * 256) + (size_t)j * 2048 * 256, 256, n0, nullptr, c.W<float>(WS_CBIAS) + j * 256, 256, red); }
}
DI void phase_norm(const Ctx& c, const float* x, const float* g, const float* mod_l, int sh_off, int sc_off) {
    h16* act = c.W<h16>(WS_ACT);
    for (int m = c.gw; m < M; m += c.ngw) {
        const f32x4* xr = (const f32x4*)(x + (size_t)m * D) + c.lane; f32x4 v[4]; float s = 0.f;
        _Pragma("unroll") for (int j = 0; j < 4; ++j) { v[j] = xr[64 * j]; s += v[j].x * v[j].x + v[j].y * v[j].y + v[j].z * v[j].z + v[j].w * v[j].w; }
        const float rstd = rsqf_(wave_sum(s) * (1.f / D) + 1e-6f);
        const float* mb = mod_l + (size_t)(m >> 11) * 6144;
        _Pragma("unroll") for (int j = 0; j < 4; ++j) { const int col = 4 * c.lane + 256 * j; const f32x4 gg = *(const f32x4*)(g + col), sc = *(const f32x4*)(mb + sc_off + col), sh = *(const f32x4*)(mb + sh_off + col);
            half4 o; _Pragma("unroll") for (int q = 0; q < 4; ++q) o[q] = (h16)(v[j][q] * rstd * gg[q] * (1.f + sc[q]) + sh[q]);
            *(half4*)(act + (size_t)m * D + col) = o; }
    }
}
template <class Epi>
DI void phase_gemm(const Ctx& c, const h16* A, int lda, const h16* Bt, int ldb, int K, int nM, int nN, const Epi& epi) {
    for (int i = 0;; ++i) { int pm, pn; if (!unit_order(i * (int)gridDim.x + (int)blockIdx.x, nM, nN, pm, pn)) break;
        gemm_unit(c.tid, A, lda, Bt, ldb, K, pm * 256, pn * 256, (h16*)c.lds, epi); }
}

DI void phase_prep(const Ctx& c, int l) {
    h16* Z = c.W<h16>(WS_Z);
    const float* dqg = c.inl(I_DQG, l, 64); const float* dkg = c.inl(I_DKG, l, 64); const float* nqg = c.inl(I_NQG, l, 64); const float* nkg = c.inl(I_NKG, l, 64);
    const float* mu = c.inl(I_MU, l, 1792);
    const int lane = c.lane; const bool hi = lane >= 32;
    const float inv = powf(10000.f, -(float)(lane & 31) * (1.f / 32.f));
    const float g_dq = dqg[lane], g_dk = dkg[lane], g_nq = nqg[lane], g_nk = nkg[lane];
    for (int m = c.gw; m < M; m += c.ngw) {
        const int b = m >> 11, t = m & 2047; h16* zr = Z + (size_t)m * ZC;
        const float ang = (float)t * inv; const float cs = cosf(ang), sn = sinf(ang);
        auto rope = [&](float x) { const float o = __shfl_xor(x, 32); return hi ? x * cs + o * sn : x * cs - o * sn; };
        auto normrope = [&](float x, float g) { const float ss = wave_sum(x * x); return rope(x * rsqf_(ss * (1.f / 64.f) + 1e-6f) * g); };
        _Pragma("unroll") for (int h = 0; h < 4; ++h) { h16* p = zr + C_QA + h * 64 + lane; *p = (h16)(normrope((float)*p, g_dq) * 0.125f); }
        c.W<h16>(WS_KA)[(size_t)m * 64 + lane] = (h16)normrope((float)zr[C_KA + lane], g_dk);
        c.W<h16>(WS_VAT)[((size_t)b * 64 + lane) * T + t] = zr[C_VA + lane];
        _Pragma("unroll") for (int h = 0; h < 4; ++h) { h16* p = zr + C_IQ + h * 64 + lane; *p = (h16)rope((float)*p); }
        c.W<h16>(WS_IK)[(size_t)m * 64 + lane] = (h16)rope((float)zr[C_IK + lane]);
        _Pragma("unroll") for (int h = 0; h < 4; ++h) { h16* p = zr + C_QC + h * 64 + lane; *p = (h16)(normrope((float)*p, g_nq) * 0.125f); }
        c.W<h16>(WS_KC)[(size_t)m * 64 + lane] = zr[C_KC + lane];
        c.W<h16>(WS_VC)[(size_t)m * 64 + lane] = zr[C_VC + lane];
        c.W<h16>(WS_KS)[(size_t)m * 64 + lane] = (h16)normrope((float)zr[C_KS + lane], g_nk);
        c.W<h16>(WS_VST)[((size_t)b * 64 + lane) * T + t] = zr[C_VS + lane];
        c.W<h16>(WS_KW)[(size_t)m * 64 + lane] = (h16)normrope((float)zr[C_KW + lane], g_nk);
        c.W<h16>(WS_VWT)[((size_t)b * 64 + lane) * T + t] = zr[C_VW + lane];
        { const int c4 = lane * 4; const half4 zc = *(const half4*)(zr + C_WD + c4); half4 zp = {0, 0, 0, 0}; if (t > 0) zp = *(const half4*)(zr - ZC + C_WD + c4);
          half4 o; _Pragma("unroll") for (int q = 0; q < 4; ++q) { const float a = (float)zc[q], v = a + ((float)zp[q] - a) * mu[1536 + c4 + q];
              o[q] = (h16)(c4 < 64 ? tanhf(v) : (c4 < 128 ? v : sigmoidf_(v))); }
          *(half4*)(c.W<h16>(WS_L16) + (size_t)m * 256 + c4) = o; }
    }
}

constexpr int SCS = 2056;
DI unsigned sortable(float v) { if (v == 0.f) v = 0.f; const unsigned u = __builtin_bit_cast(unsigned, v); return (u & 0x80000000u) ? ~u : (u | 0x80000000u); }
DI void dsa_select_item(const Ctx& c, int item) {
    const int b = item >> 7, t0 = (item & 127) * 16; const int lane = c.lane, w = c.wave;
    unsigned* dmask = c.W<unsigned>(WS_DMASK);
    if (t0 < 256) {
        for (int e = c.tid; e < 16 * 64; e += NTHREADS) { const int qi = e >> 6, wd = e & 63, t = t0 + qi; const int nb = t + 1 - 32 * wd;
            dmask[(size_t)(b * T + t) * 64 + wd] = nb <= 0 ? 0u : (nb >= 32 ? 0xFFFFFFFFu : ((1u << nb) - 1u)); }
        return;
    }
    float* sc = (float*)c.lds;
    const h16* Z = c.W<h16>(WS_Z); const h16* IK = c.W<h16>(WS_IK) + (size_t)b * T * 64;
    const int r = lane & 31, hf = lane >> 5, hd = r & 3;
    half8 qf[2][4]; float iw[2];
    _Pragma("unroll") for (int cb = 0; cb < 2; ++cb) { const int mq = b * T + t0 + 8 * cb + (r >> 2); const h16* zq = Z + (size_t)mq * ZC;
        _Pragma("unroll") for (int ks = 0; ks < 4; ++ks) qf[cb][ks] = *(const half8*)(zq + C_IQ + hd * 64 + 16 * ks + 8 * hf);
        iw[cb] = (float)zq[C_IW + hd]; }
    const int ntile = (t0 + 15) / 32 + 1;
    for (int kt = w; kt < ntile; kt += 8) {
        const h16* kr = IK + (size_t)(32 * kt + r) * 64 + 8 * hf;
        f32x16 s0 = {}, s1 = {};
        _Pragma("unroll") for (int ks = 0; ks < 4; ++ks) { const half8 kf = *(const half8*)(kr + 16 * ks); s0 = MFMA32(kf, qf[0][ks], s0); s1 = MFMA32(kf, qf[1][ks], s1); }
        _Pragma("unroll") for (int i = 0; i < 16; ++i) { const int key = 32 * kt + crow(i, hf);
            const float v0 = quad_sum(iw[0] * fmaxf(s0[i], 0.f)), v1 = quad_sum(iw[1] * fmaxf(s1[i], 0.f));
            if (hd == 0) { sc[(r >> 2) * SCS + key] = v0; sc[(8 + (r >> 2)) * SCS + key] = v1; } }
    }
    __syncthreads();
    _Pragma("unroll") for (int qq = 0; qq < 2; ++qq) {
        const int qi = 2 * w + qq, t = t0 + qi; unsigned u[32];
        _Pragma("unroll") for (int i = 0; i < 32; ++i) { const int key = 64 * i + lane; u[i] = key <= t ? sortable(sc[qi * SCS + key]) : 0u; }
        unsigned thr = 0u; bool exact = false;
        for (int bit = 31; bit >= 0; --bit) { const unsigned cand = thr | (1u << bit); int cnt = 0;
            _Pragma("unroll") for (int i = 0; i < 32; ++i) cnt += __popcll(__ballot(u[i] >= cand));
            if (cnt >= 256) { thr = cand; if (cnt == 256) { exact = true; break; } } }
        int need = 0;
        if (!exact) { int cg_ = 0; _Pragma("unroll") for (int i = 0; i < 32; ++i) cg_ += __popcll(__ballot(u[i] > thr)); need = 256 - cg_; }
        unsigned long long mine = 0ull; int run = 0;
        _Pragma("unroll") for (int i = 0; i < 32; ++i) { bool sel;
            if (exact) sel = u[i] >= thr;
            else { const bool eq = (u[i] == thr); const unsigned long long be = __ballot(eq); const int pre = run + __popcll(be & ((1ull << lane) - 1ull)); sel = (u[i] > thr) || (eq && pre < need); run += __popcll(be); }
            const unsigned long long bs = __ballot(sel); if (lane == i) mine = bs; }
        if (lane < 32) *(unsigned long long*)(dmask + (size_t)(b * T + t) * 64 + 2 * lane) = mine;
    }
}

struct Flash { f32x16 o0, o1; float mx, l; DI void init() { _Pragma("unroll") for (int i = 0; i < 16; ++i) { o0[i] = 0.f; o1[i] = 0.f; } mx = -1e30f; l = 0.f; } };
template <class VF>
DI void flash_tile(Flash& f, const half8 (&qf)[4], const h16* Kb, const h16* Vt, int ldv, int key0, int lane, VF valid) {
    const int r = lane & 31, hf = lane >> 5;
    const h16* kr = Kb + (size_t)(key0 + r) * 64 + 8 * hf;
    f32x16 s = {};
    _Pragma("unroll") for (int ks = 0; ks < 4; ++ks) { const half8 kf = *(const half8*)(kr + 16 * ks); s = MFMA32(kf, qf[ks], s); }
    float tmax = -1e30f;
    _Pragma("unroll") for (int i = 0; i < 16; ++i) { s[i] = valid(i) ? s[i] : -1e30f; tmax = fmaxf(tmax, s[i]); }
    tmax = fmaxf(tmax, __shfl_xor(tmax, 32));
    const float mnew = fmaxf(f.mx, tmax), alpha = __expf(f.mx - mnew);
    float psum = 0.f;
    _Pragma("unroll") for (int i = 0; i < 16; ++i) { const float p = s[i] > -1e29f ? __expf(s[i] - mnew) : 0.f; s[i] = p; psum += p; }
    f.l = f.l * alpha + psum; f.mx = mnew;
    _Pragma("unroll") for (int i = 0; i < 16; ++i) { f.o0[i] *= alpha; f.o1[i] *= alpha; }
    _Pragma("unroll") for (int st = 0; st < 2; ++st) { half8 pf; _Pragma("unroll") for (int j = 0; j < 8; ++j) pf[j] = (h16)s[8 * st + j];
        const h16* vp0 = Vt + (size_t)r * ldv + key0 + 16 * st + 4 * hf; const h16* vp1 = vp0 + (size_t)32 * ldv;
        const half4 a0 = *(const half4*)vp0, b0 = *(const half4*)(vp0 + 8), a1 = *(const half4*)vp1, b1 = *(const half4*)(vp1 + 8);
        const half8 v0 = __builtin_shufflevector(a0, b0, 0, 1, 2, 3, 4, 5, 6, 7), v1 = __builtin_shufflevector(a1, b1, 0, 1, 2, 3, 4, 5, 6, 7);
        f.o0 = MFMA32(v0, pf, f.o0); f.o1 = MFMA32(v1, pf, f.o1); }
}
DI void store_o(h16* dst  , const f32x16& o0, const f32x16& o1, int hf) {
    _Pragma("unroll") for (int g = 0; g < 4; ++g) { half4 a, b; _Pragma("unroll") for (int j = 0; j < 4; ++j) { a[j] = (h16)o0[4 * g + j]; b[j] = (h16)o1[4 * g + j]; }
        *(half4*)(dst + 8 * g + 4 * hf) = a; *(half4*)(dst + 32 + 8 * g + 4 * hf) = b; }
}
DI void dsa_attn_wave(const Ctx& c, int b, int t0) {
    const int lane = c.lane, r = lane & 31, hf = lane >> 5, hd = r & 3, t = t0 + (r >> 2), m = b * T + t;
    const h16* zq = c.W<h16>(WS_Z) + (size_t)m * ZC + C_QA + hd * 64 + 8 * hf;
    half8 qf[4]; _Pragma("unroll") for (int ks = 0; ks < 4; ++ks) qf[ks] = *(const half8*)(zq + 16 * ks);
    const h16* Kb = c.W<h16>(WS_KA) + (size_t)b * T * 64; const h16* Vt = c.W<h16>(WS_VAT) + (size_t)b * 64 * T;
    const unsigned* mrow = c.W<unsigned>(WS_DMASK) + (size_t)m * 64;
    Flash f; f.init();
    const int ntile = (t0 + 7) / 32 + 1;
    for (int kt = 0; kt < ntile; ++kt) { const unsigned word = mrow[kt]; if (__ballot(word != 0u) == 0ull) continue;
        flash_tile(f, qf, Kb, Vt, T, 32 * kt, lane, [&](int i) { return ((word >> crow(i, hf)) & 1u) != 0u; }); }
    const float lt = f.l + __shfl_xor(f.l, 32), inv = rcpf_(lt);
    _Pragma("unroll") for (int i = 0; i < 16; ++i) { f.o0[i] *= inv; f.o1[i] *= inv; }
    store_o(c.W<h16>(WS_ACT) + (size_t)m * D + hd * 64, f.o0, f.o1, hf);
}
DI void nsa_attn_wave(const Ctx& c, int b, int t0) {
    const int lane = c.lane, w = c.wave, r = lane & 31, hf = lane >> 5, hd = r & 3, qi = r >> 2, t = t0 + qi, m = b * T + t;
    const h16* zrow = c.W<h16>(WS_Z) + (size_t)m * ZC;
    half8 qf[4]; _Pragma("unroll") for (int ks = 0; ks < 4; ++ks) qf[ks] = *(const half8*)(zrow + C_QC + hd * 64 + 8 * hf + 16 * ks);
    const float g0 = sigmoidf_((float)zrow[C_GC + hd * 3 + 0]), g1 = sigmoidf_((float)zrow[C_GC + hd * 3 + 1]), g2 = sigmoidf_((float)zrow[C_GC + hd * 3 + 2]);
    float* GS = (float*)(c.lds + w * 4096); float* LA = GS + 256; float* IMPF = GS + 512; unsigned* SELM = (unsigned*)(GS + 768);
    f32x16 a0, a1;
    {
        const h16* Kc = c.W<h16>(WS_KCMP) + (size_t)b * 128 * 64; const h16* Vc = c.W<h16>(WS_VCMPT) + (size_t)b * 64 * 128;
        const int nmax = t >= 31 ? ((t - 31) >> 4) : -1;
        f32x16 s[4]; float mxv = -1e30f;
        _Pragma("unroll") for (int tl = 0; tl < 4; ++tl) { const h16* kr = Kc + (size_t)(32 * tl + r) * 64 + 8 * hf; f32x16 a = {};
            _Pragma("unroll") for (int ks = 0; ks < 4; ++ks) { const half8 kf = *(const half8*)(kr + 16 * ks); a = MFMA32(kf, qf[ks], a); }
            _Pragma("unroll") for (int i = 0; i < 16; ++i) { const int n = 32 * tl + crow(i, hf); a[i] = n <= nmax ? a[i] : -1e30f; mxv = fmaxf(mxv, a[i]); }
            s[tl] = a; }
        mxv = fmaxf(mxv, __shfl_xor(mxv, 32));
        float sum = 0.f;
        _Pragma("unroll") for (int tl = 0; tl < 4; ++tl) _Pragma("unroll") for (int i = 0; i < 16; ++i) { const float p = s[tl][i] > -1e29f ? __expf(s[tl][i] - mxv) : 0.f; s[tl][i] = p; sum += p; }
        sum += __shfl_xor(sum, 32);
        const float inv = sum > 0.f ? rcpf_(sum) : 0.f;
        f32x16 o0 = {}, o1 = {};
        _Pragma("unroll") for (int tl = 0; tl < 4; ++tl) { _Pragma("unroll") for (int i = 0; i < 16; ++i) s[tl][i] *= inv;
            _Pragma("unroll") for (int st = 0; st < 2; ++st) { half8 pf; _Pragma("unroll") for (int j = 0; j < 8; ++j) pf[j] = (h16)s[tl][8 * st + j];
                const h16* vp0 = Vc + (size_t)r * 128 + 32 * tl + 16 * st + 4 * hf; const h16* vp1 = vp0 + 32 * 128;
                const half4 x0 = *(const half4*)vp0, y0 = *(const half4*)(vp0 + 8), x1 = *(const half4*)vp1, y1 = *(const half4*)(vp1 + 8);
                o0 = MFMA32(__builtin_shufflevector(x0, y0, 0, 1, 2, 3, 4, 5, 6, 7), pf, o0); o1 = MFMA32(__builtin_shufflevector(x1, y1, 0, 1, 2, 3, 4, 5, 6, 7), pf, o1); } }
        _Pragma("unroll") for (int i = 0; i < 16; ++i) { a0[i] = g0 * o0[i]; a1[i] = g0 * o1[i]; }
        _Pragma("unroll") for (int tl = 0; tl < 4; ++tl) _Pragma("unroll") for (int g = 0; g < 4; ++g) { const int G = 8 * tl + 2 * g + hf;
            const float gs = quad_sum((s[tl][4 * g] + s[tl][4 * g + 1]) + (s[tl][4 * g + 2] + s[tl][4 * g + 3])); const float la = quad_sum(s[tl][4 * g + 3]);
            if (hd == 0) { GS[qi * 32 + G] = gs; LA[qi * 32 + G] = la; } }
        WSYNC();
        _Pragma("unroll") for (int it = 0; it < 4; ++it) { const int q = (lane >> 5) + 2 * it, j = lane & 31, tq = t0 + q, cur = tq >> 6;
            const float imp = GS[q * 32 + j] + (j > 0 ? LA[q * 32 + j - 1] : 0.f);
            const bool adm = (j * 64 <= tq), forced = (j == 0) || (j == cur) || (j == cur - 1);
            IMPF[q * 32 + j] = adm ? (forced ? __builtin_inff() : imp) : -__builtin_inff(); }
        WSYNC();
        _Pragma("unroll") for (int it = 0; it < 4; ++it) { const int q = (lane >> 5) + 2 * it, j = lane & 31; const float mv = IMPF[q * 32 + j]; int rank = 0;
            _Pragma("unroll") for (int jj = 0; jj < 32; ++jj) { const float ov = IMPF[q * 32 + jj]; rank += (ov > mv || (ov == mv && jj < j)) ? 1 : 0; }
            const unsigned long long bs = __ballot(rank < 16);
            if (lane == 0) { SELM[2 * it] = (unsigned)bs; SELM[2 * it + 1] = (unsigned)(bs >> 32); } }
        WSYNC();
    }
    const unsigned selmask = SELM[qi];
    WSYNC();
    {
        const h16* Kb = c.W<h16>(WS_KS) + (size_t)b * T * 64; const h16* Vt = c.W<h16>(WS_VST) + (size_t)b * 64 * T;
        Flash f; f.init();
        const int ntile = (t0 + 7) / 32 + 1;
        for (int kt = 0; kt < ntile; ++kt) { const bool bit = ((selmask >> (kt >> 1)) & 1u) != 0u; if (__ballot(bit) == 0ull) continue;
            const int key0 = 32 * kt; flash_tile(f, qf, Kb, Vt, T, key0, lane, [&](int i) { return bit && (key0 + crow(i, hf) <= t); }); }
        const float lt = f.l + __shfl_xor(f.l, 32), sc = g1 * rcpf_(lt);
        _Pragma("unroll") for (int i = 0; i < 16; ++i) { a0[i] += sc * f.o0[i]; a1[i] += sc * f.o1[i]; }
    }
    {
        const h16* Kb = c.W<h16>(WS_KW) + (size_t)b * T * 64; const h16* Vt = c.W<h16>(WS_VWT) + (size_t)b * 64 * T;
        Flash f; f.init();
        const int lo = (t0 - 511 > 0 ? t0 - 511 : 0) >> 5, hiT = (t0 + 7) >> 5;
        for (int kt = lo; kt <= hiT; ++kt) { const int key0 = 32 * kt;
            flash_tile(f, qf, Kb, Vt, T, key0, lane, [&](int i) { const int key = key0 + crow(i, hf); return key <= t && key > t - 512; }); }
        const float lt = f.l + __shfl_xor(f.l, 32), sc = g2 * rcpf_(lt);
        _Pragma("unroll") for (int i = 0; i < 16; ++i) { a0[i] += sc * f.o0[i]; a1[i] += sc * f.o1[i]; }
    }
    store_o(c.W<h16>(WS_ACT) + (size_t)m * D + 768 + hd * 64, a0, a1, hf);
}

DI void rwkv_item(const Ctx& c, int l, int item) {
    const int b = item >> 3, h = item & 7; const int tid = c.tid, lane = c.lane, w = c.wave;
    float* kkL = (float*)c.lds; float* wL = kkL + 2048; float* kpL = wL + 2048; float* bbL = kpL + 2048; float* rrL = bbL + 2048; float* vvL = rrL + 2048; float* yL = vvL + 2048;
    const h16* Z = c.W<h16>(WS_Z); const h16* DEC = c.W<h16>(WS_DEC); const h16* AA = c.W<h16>(WS_A); const h16* GG = c.W<h16>(WS_G); h16* MIX = c.W<h16>(WS_ACT);
    const float* mu = c.inl(I_MU, l, 1792); const float* k_k = c.inl(I_KK, l, 512); const float* k_a = c.inl(I_KA, l, 512); const float* r_k = c.inl(I_RK, l, 512);
    const float* ln_w = c.inl(I_LNW, l, 512); const float* ln_b = c.inl(I_LNB, l, 512);
    const int s_ = tid >> 4, ch = (tid & 15) * 4, col = h * 64 + ch;
    float mur[4], muk[4], muv[4], kkc[4], kac[4], rkc[4], lw[4], lb[4];
    _Pragma("unroll") for (int q = 0; q < 4; ++q) { mur[q] = mu[col + q]; muk[q] = mu[512 + col + q]; muv[q] = mu[1024 + col + q]; kkc[q] = k_k[col + q]; kac[q] = k_a[col + q]; rkc[q] = r_k[col + q]; lw[q] = ln_w[col + q]; lb[q] = ln_b[col + q]; }
    const int rl = lane >> 3, cc = lane & 7, irow = 8 * w + rl, j0 = 8 * cc;
    float S[8]; _Pragma("unroll") for (int q = 0; q < 8; ++q) S[q] = 0.f;
    for (int chunk = 0; chunk < 64; ++chunk) {
        const int tt0 = chunk * 32; const int m = b * T + tt0 + s_;
        __syncthreads();
        {
            const h16* zr = Z + (size_t)m * ZC; const bool hasp = (tt0 + s_) > 0;
            const half4 r4 = *(const half4*)(zr + C_R + col), k4 = *(const half4*)(zr + C_K + col), v4 = *(const half4*)(zr + C_V + col);
            half4 rp = {0, 0, 0, 0}, kp_ = {0, 0, 0, 0}, vp = {0, 0, 0, 0};
            if (hasp) { rp = *(const half4*)(zr - ZC + C_R + col); kp_ = *(const half4*)(zr - ZC + C_K + col); vp = *(const half4*)(zr - ZC + C_V + col); }
            const half4 d4 = *(const half4*)(DEC + (size_t)m * 512 + col), a4 = *(const half4*)(AA + (size_t)m * 512 + col);
            float rr[4], kx[4], vv[4], kr[4]; float ss = 0.f;
            _Pragma("unroll") for (int q = 0; q < 4; ++q) { const float r0 = (float)r4[q], k0 = (float)k4[q], v0 = (float)v4[q];
                rr[q] = r0 + ((float)rp[q] - r0) * mur[q]; kx[q] = k0 + ((float)kp_[q] - k0) * muk[q]; vv[q] = v0 + ((float)vp[q] - v0) * muv[q];
                kr[q] = kx[q] * kkc[q]; ss += kr[q] * kr[q]; }
            ss = red16(ss); const float inrm = rcpf_(fmaxf(__builtin_amdgcn_sqrtf(ss), 1e-12f));
            f32x4 o_kk, o_w, o_kp, o_bb, o_r, o_v;
            _Pragma("unroll") for (int q = 0; q < 4; ++q) { const float a = (float)a4[q]; const float kk = kr[q] * inrm;
                o_kk[q] = kk; o_w[q] = (float)d4[q]; o_kp[q] = kx[q] * (1.f + (a - 1.f) * kac[q]); o_bb[q] = kk * a; o_r[q] = rr[q]; o_v[q] = vv[q]; }
            *(f32x4*)(kkL + s_ * 64 + ch) = o_kk; *(f32x4*)(wL + s_ * 64 + ch) = o_w; *(f32x4*)(kpL + s_ * 64 + ch) = o_kp;
            *(f32x4*)(bbL + s_ * 64 + ch) = o_bb; *(f32x4*)(rrL + s_ * 64 + ch) = o_r; *(f32x4*)(vvL + s_ * 64 + ch) = o_v;
        }
        __syncthreads();
#pragma unroll 4
        for (int s = 0; s < 32; ++s) {
            const f32x4 ka = *(const f32x4*)(kkL + s * 64 + j0), kb = *(const f32x4*)(kkL + s * 64 + j0 + 4);
            const f32x4 wa = *(const f32x4*)(wL + s * 64 + j0), wb = *(const f32x4*)(wL + s * 64 + j0 + 4);
            const f32x4 pa = *(const f32x4*)(kpL + s * 64 + j0), pb = *(const f32x4*)(kpL + s * 64 + j0 + 4);
            const f32x4 ba = *(const f32x4*)(bbL + s * 64 + j0), bb = *(const f32x4*)(bbL + s * 64 + j0 + 4);
            const f32x4 ra = *(const f32x4*)(rrL + s * 64 + j0), rb = *(const f32x4*)(rrL + s * 64 + j0 + 4);
            const float vv = vvL[s * 64 + irow];
            float sa = 0.f, sb = 0.f;
            _Pragma("unroll") for (int q = 0; q < 4; ++q) { sa += S[q] * ka[q]; sb += S[4 + q] * kb[q]; }
            sa = red8(sa + sb);
            float ya = 0.f, yb = 0.f;
            _Pragma("unroll") for (int q = 0; q < 4; ++q) { S[q] = S[q] * wa[q] + (vv * pa[q] - sa * ba[q]); S[4 + q] = S[4 + q] * wb[q] + (vv * pb[q] - sa * bb[q]); ya += S[q] * ra[q]; yb += S[4 + q] * rb[q]; }
            const float y = red8(ya + yb);
            if (cc == 0) yL[s * 64 + irow] = y;
        }
        __syncthreads();
        {
            const f32x4 y4 = *(const f32x4*)(yL + s_ * 64 + ch); const f32x4 r4 = *(const f32x4*)(rrL + s_ * 64 + ch), p4 = *(const f32x4*)(kpL + s_ * 64 + ch), v4 = *(const f32x4*)(vvL + s_ * 64 + ch);
            const float mean = red16((y4[0] + y4[1]) + (y4[2] + y4[3])) * (1.f / 64.f);
            float vs = 0.f, bs = 0.f; _Pragma("unroll") for (int q = 0; q < 4; ++q) { const float d = y4[q] - mean; vs += d * d; bs += r4[q] * p4[q] * rkc[q]; }
            const float rstd = rsqf_(red16(vs) * (1.f / 64.f) + 64e-5f); bs = red16(bs);
            const half4 g4 = *(const half4*)(GG + (size_t)m * 512 + col); half4 o;
            _Pragma("unroll") for (int q = 0; q < 4; ++q) o[q] = (h16)((((y4[q] - mean) * rstd * lw[q] + lb[q]) + bs * v4[q]) * (float)g4[q]);
            *(half4*)(MIX + (size_t)m * D + 256 + col) = o;
        }
    }
}

DI void phase_cmp2(const Ctx& c, int l) {
    const h16* HID = c.W<h16>(WS_HID); const float* w2 = c.inl(I_NW2, l, 2 * 256 * 64); const float* nkg = c.inl(I_NKG, l, 64);
    const int lane = c.lane; const bool hi = lane >= 32; const float inv = powf(10000.f, -(float)(lane & 31) * (1.f / 32.f));
    for (int it = c.gw; it < 2 * 1024; it += c.ngw) { const int j = it >> 10, rrow = it & 1023, b = rrow >> 7, n = rrow & 127;
        float acc = 0.f;
        if (n < 127) { const h16* hr = HID + ((size_t)j * 1024 + rrow) * 256; const float* wj = w2 + (size_t)j * 256 * 64;
            for (int k = 0; k < 256; k += 8) { const half8 hv = *(const half8*)(hr + k); _Pragma("unroll") for (int q = 0; q < 8; ++q) acc += (float)hv[q] * wj[(k + q) * 64 + lane]; } }
        if (j == 0) { const float ss = wave_sum(acc * acc); float y = acc * rsqf_(ss * (1.f / 64.f) + 1e-6f) * nkg[lane];
            const float ang = (float)(16 * n + 31) * inv; const float cs = cosf(ang), sn = sinf(ang); const float o = __shfl_xor(y, 32); y = hi ? y * cs + o * sn : y * cs - o * sn;
            c.W<h16>(WS_KCMP)[((size_t)b * 128 + n) * 64 + lane] = (h16)(n < 127 ? y : 0.f); }
        else c.W<h16>(WS_VCMPT)[((size_t)b * 64 + lane) * 128 + n] = (h16)acc; }
}

__global__ void __launch_bounds__(NTHREADS) fwd_kernel(Params p) {
    extern __shared__ __attribute__((aligned(16))) char lds[];
    cg::grid_group grid = cg::this_grid();
    Ctx c; c.out = p.out; c.ws = p.ws; c.lds = lds; c.ctl = (unsigned*)(p.ws + WS_CTL);
    c.wave = __builtin_amdgcn_readfirstlane(threadIdx.x >> 6); c.lane = lane_id(); c.tid = c.wave * 64 + c.lane; c.gw = blockIdx.x * 8 + c.wave; c.ngw = gridDim.x * 8;
    if (c.tid < 28) ((const float**)(p.ws + WS_PTRS))[c.tid] = p.in[c.tid];
    unsigned* xbar = c.ctl + 4096;
    if (c.tid == 0) { s_xb[0] = 0u; s_xb[1] = 0u; (void)xb_add(&xbar[XB_XCNT(xb_xcc_id())], 1u); }
    __threadfence(); __syncthreads();
#define GSYNC() do { xcd_barrier(c.ctl + 4096, c.tid); PH(); } while (0)
    h16* ACT = c.W<h16>(WS_ACT); h16* Z = c.W<h16>(WS_Z);

#define PH() do { c.ws = launder_ptr(c.ws); c.out = launder_ptr(c.out); c.lane = lane_id(); asm volatile("" : "+v"(c.lane)); c.tid = c.wave * 64 + c.lane; c.gw = blockIdx.x * 8 + c.wave; } while (0)
    phase_mod(c);
#pragma unroll 1
    for (int l = 0; l < DEPTH; ++l) {
        const float* mod_l = c.W<float>(WS_MOD) + (size_t)l * 8 * 6144;
        PH(); convert_weights(c, l);
        PH(); phase_cbias(c, l);
        if (l == 0) grid.sync();
        PH();
        phase_norm(c, l == 0 ? c.inp(I_X) : c.out, c.inl(I_N1G, l, D), mod_l, 0, 1024);
        GSYNC();
        phase_gemm(c, ACT, D, c.W<h16>(WS_WIN), D, D, 64, 13, EpiZ{Z, ZC});
        GSYNC();
        phase_prep(c, l);
        GSYNC();
        {
            unsigned* ctr = c.ctl + 16 * (2 * l);
            for (;;) { const int it = next_item(ctr, c.tid); if (it >= 8 + 384 + 1024) break; PH();
                if (it < 8) { const int j = it >> 2, pm = it & 3;
                    gemm_unit(c.tid, c.W<h16>(j ? WS_VC : WS_KC), 1024, c.W<h16>(WS_W1) + (size_t)j * 256 * 2048, 2048, 2048, pm * 256, 0, (h16*)lds, EpiCmp{c.W<h16>(WS_HID) + (size_t)j * 1024 * 256, c.W<float>(WS_CBIAS) + j * 256}); }
                else if (it < 392) { const int u = it - 8, pm = u / 6, pn = u % 6;
                    gemm_unit(c.tid, c.W<h16>(WS_L16), 256, c.W<h16>(WS_WL), 256, 256, pm * 256, pn * 256, (h16*)lds, EpiLora{c.W<h16>(WS_DEC), c.W<h16>(WS_A), c.W<h16>(WS_G), c.inl(I_W0, l, 512), c.inl(I_A0, l, 512)}); }
                else dsa_select_item(c, 1023 - (it - 392)); }
        }
        GSYNC();
        phase_cmp2(c, l);
        GSYNC();
        {
            unsigned* ctr = c.ctl + 16 * (2 * l + 1);
            for (;;) { const int it = next_item(ctr, c.tid); if (it >= 64 + 512) break; PH();
                if (it < 64) rwkv_item(c, l, it);
                else { const int a = it - 64; const int kind = a >> 8, idx = 255 - (a & 255); const int b = idx & 7, qb = idx >> 3; const int t0 = qb * 64 + c.wave * 8;
                    if (kind == 0) nsa_attn_wave(c, b, t0); else dsa_attn_wave(c, b, t0); } }
        }
        GSYNC();
        phase_gemm(c, ACT, D, c.W<h16>(WS_WOUT), D, D, 64, 4, EpiRes{l == 0 ? c.inp(I_X) : c.out, c.out, mod_l + 2048});
        GSYNC();
        phase_norm(c, c.out, c.inl(I_N2G, l, D), mod_l, 3072, 4096);
        GSYNC();
        phase_gemm(c, ACT, D, c.W<h16>(WS_WI), D, D, 64, 22, EpiSwiglu{Z});
        GSYNC();
        phase_gemm(c, Z, FF, c.W<h16>(WS_WO), FF, FF, 64, 4, EpiRes{c.out, c.out, mod_l + 5120});
        GSYNC();
    }
}

extern "C" void kernel_launch(void* const* d_in, const int* in_sizes, int n_in, void* d_out, int out_size, void* d_ws, size_t ws_size, hipStream_t stream) {
    static int grid_blocks = 0;
    if (grid_blocks == 0) {
        if (n_in != 28 || ws_size < WS_END) { fprintf(stderr, "kernel_launch: unexpected n_in %d / ws %zu\n", n_in, ws_size); grid_blocks = -1; return; }
        int dev = 0, cus = 0, per_cu = 0;
        hipGetDevice(&dev); hipDeviceGetAttribute(&cus, hipDeviceAttributeMultiprocessorCount, dev);
        hipFuncSetAttribute((const void*)fwd_kernel, hipFuncAttributeMaxDynamicSharedMemorySize, LDS_BYTES);
        hipOccupancyMaxActiveBlocksPerMultiprocessor(&per_cu, (const void*)fwd_kernel, NTHREADS, LDS_BYTES);
        if (per_cu < 1) { fprintf(stderr, "kernel_launch: occupancy query says %d blocks/CU\n", per_cu); per_cu = 1; }
        grid_blocks = cus * 1;
    }
    if (grid_blocks < 0) return;
    hipMemsetAsync((char*)d_ws + WS_CTL, 0, 64 * 1024, stream);
    Params p{};
    for (int i = 0; i < 28; ++i) p.in[i] = (const float*)d_in[i];
    p.out = (float*)d_out; p.ws = (unsigned char*)d_ws;
    void* args[] = {&p};
    hipError_t e = hipLaunchCooperativeKernel((const void*)fwd_kernel, dim3(grid_blocks), dim3(NTHREADS), args, LDS_BYTES, stream);
    if (e != hipSuccess) fprintf(stderr, "cooperative launch failed: %s (grid %d)\n", hipGetErrorString(e), grid_blocks);
}
```

```cpp
#include <hip/hip_runtime.h>
#include <hip/hip_cooperative_groups.h>
#include <cstdio>
#include <cstdint>
namespace cg = cooperative_groups;

typedef _Float16 h16;
typedef _Float16 half8 __attribute__((ext_vector_type(8)));
typedef _Float16 half4 __attribute__((ext_vector_type(4)));
typedef float f32x4 __attribute__((ext_vector_type(4)));
typedef float f32x16 __attribute__((ext_vector_type(16)));
#define LAS __attribute__((address_space(3)))
#define DI __device__ __forceinline__

constexpr int D = 1024, NB = 8, T = 2048, M = NB * T, FF = 2816, DEPTH = 2;
constexpr int ZC = 3328;
constexpr int C_QA = 0, C_KA = 256, C_VA = 320, C_IQ = 384, C_IK = 640, C_IW = 704;
constexpr int C_R = 768, C_K = 1280, C_V = 1792, C_WD = 2304;
constexpr int C_QC = 2560, C_KC = 2816, C_VC = 2880, C_KS = 2944, C_VS = 3008, C_KW = 3072, C_VW = 3136, C_GC = 3200;
constexpr int NTHREADS = 512;
constexpr int LDS_BYTES = 139264;

constexpr size_t MiB = 1u << 20;
constexpr size_t WS_CTL = 0;
constexpr size_t WS_PTRS = 60 * 1024;
constexpr size_t WS_MOD = 64 * 1024;
constexpr size_t WS_CBIAS = 512 * 1024;
constexpr size_t WS_KCMP = 1 * MiB;
constexpr size_t WS_VCMPT = 1 * MiB + 128 * 1024;
constexpr size_t WS_HID = 2 * MiB;
constexpr size_t WS_KA = 4 * MiB, WS_IK = 6 * MiB, WS_KS = 8 * MiB, WS_KW = 10 * MiB;
constexpr size_t WS_VAT = 12 * MiB, WS_VST = 14 * MiB, WS_VWT = 16 * MiB;
constexpr size_t WS_DMASK = 18 * MiB;
constexpr size_t WS_WIN = 22 * MiB;
constexpr size_t WS_WOUT = WS_WIN + 6656 * 1024;
constexpr size_t WS_WI = WS_WOUT + 2 * MiB;
constexpr size_t WS_WO = WS_WI + 11 * MiB;
constexpr size_t WS_W1 = WS_WO + 5632 * 1024;
constexpr size_t WS_WL = WS_W1 + 2 * MiB;
constexpr size_t WS_ACT = 50 * MiB;
constexpr size_t WS_L16 = WS_ACT, WS_KC = WS_ACT + 8 * MiB, WS_VC = WS_ACT + 12 * MiB;
constexpr size_t WS_DEC = 82 * MiB, WS_A = 98 * MiB, WS_G = 114 * MiB;
constexpr size_t WS_Z = 130 * MiB;
constexpr size_t WS_END = 234 * MiB;
static_assert(WS_WL + 768 * 1024 <= WS_ACT, "weights fit");

struct Params { const float* in[28]; float* out; unsigned char* ws; };
enum { I_X = 0, I_C, I_ADAW, I_ADAB, I_N1G, I_WIN, I_DQG, I_DKG, I_MU, I_W0, I_W2, I_A0, I_A2, I_G2, I_KK, I_KA, I_RK, I_LNW, I_LNB,
       I_NQG, I_NKG, I_PE, I_NW1, I_NW2, I_WOUT, I_N2G, I_FWI, I_FWO };

template <int CTRL> DI float dpp_f(float x) { return __builtin_bit_cast(float, __builtin_amdgcn_update_dpp(0, __builtin_bit_cast(int, x), CTRL, 0xF, 0xF, true)); }
DI float quad_sum(float x) { x += dpp_f<0xB1>(x); x += dpp_f<0x4E>(x); return x; }
DI float red8(float x) { x += dpp_f<0xB1>(x); x += dpp_f<0x4E>(x); x += dpp_f<0x141>(x); return x; }
DI float red16(float x) { x += __shfl_xor(x, 1); x += __shfl_xor(x, 2); x += __shfl_xor(x, 4); x += __shfl_xor(x, 8); return x; }
DI float wave_sum(float x) { for (int o = 1; o < 64; o <<= 1) x += __shfl_xor(x, o); return x; }
DI float rcpf_(float x) { return __builtin_amdgcn_rcpf(x); }
DI float rsqf_(float x) { return __builtin_amdgcn_rsqf(x); }
DI float sigmoidf_(float x) { return rcpf_(1.f + __expf(-x)); }
DI int crow(int i, int h) { return (i & 3) + 8 * (i >> 2) + 4 * h; }
#define WSYNC() asm volatile("s_waitcnt lgkmcnt(0)" ::: "memory")
#define MFMA32(a, b, c) __builtin_amdgcn_mfma_f32_32x32x16_f16((a), (b), (c), 0, 0, 0)

template <class Tp> DI Tp* launder_ptr(Tp* p) {
    unsigned lo = (unsigned)(uintptr_t)p, hi = (unsigned)((uintptr_t)p >> 32); asm volatile("" : "+v"(lo), "+v"(hi));
    lo = __builtin_amdgcn_readfirstlane(lo); hi = __builtin_amdgcn_readfirstlane(hi); return (Tp*)(((uintptr_t)hi << 32) | lo); }
DI int lane_id() { return (int)__builtin_amdgcn_mbcnt_hi(~0u, __builtin_amdgcn_mbcnt_lo(~0u, 0u)); }
__shared__ int s_item;
DI int next_item(unsigned* ctr, int tid) {
    __syncthreads();
    if (tid == 0) s_item = (int)atomicAdd(ctr, 1u);
    __syncthreads();
    return s_item;
}


#define XB_TMO      128
#define XB_XCNT(j)  (256  + 64 * (j))
#define XB_XSUB(j)  (1280 + 64 * (j))
#define XB_XGEN(j)  (2304 + 64 * (j))
#define XB_TOP      3328
#define XB_TOPGEN   3392
#define XB_SPIN_CAP (1u << 22)
DI unsigned xb_ld(unsigned* p) { return __hip_atomic_load(p, __ATOMIC_RELAXED, __HIP_MEMORY_SCOPE_AGENT); }
DI unsigned xb_add(unsigned* p, unsigned v) { return __hip_atomic_fetch_add(p, v, __ATOMIC_RELAXED, __HIP_MEMORY_SCOPE_AGENT); }
DI unsigned xb_xcc_id() { return (unsigned)__builtin_amdgcn_s_getreg((3 << 11) | 20) & 0xFu; }
#define XB_SPIN(cond, bar) do { unsigned _sp = 0; while (cond) { __builtin_amdgcn_s_sleep(1); \
    if ((++_sp & 255u) == 0u) { if (xb_ld(&(bar)[XB_TMO])) break; if (_sp > XB_SPIN_CAP) { atomicAdd(&(bar)[XB_TMO], 1u); break; } } } } while (0)
__shared__ unsigned s_xb[2];
DI void xcd_barrier_complete(unsigned* bar, unsigned x, unsigned& nloc, unsigned& nx) {
    const unsigned G = gridDim.x; unsigned sum, cnt, mine, sp = 0u;
    for (;;) { sum = 0u; cnt = 0u; mine = 0u;
        _Pragma("unroll") for (unsigned j = 0; j < 16; ++j) { const unsigned c = xb_ld(&bar[XB_XCNT(j)]); sum += c; cnt += (c > 0u) ? 1u : 0u; mine = (j == x) ? c : mine; }
        if (sum == G) break;
        __builtin_amdgcn_s_sleep(1);
        if ((++sp & 255u) == 0u) { if (xb_ld(&bar[XB_TMO])) break; if (sp > XB_SPIN_CAP) { atomicAdd(&bar[XB_TMO], 1u); break; } } }
    nloc = mine > 0u ? mine : 1u; nx = cnt > 0u ? cnt : 1u;
}
DI void xcd_barrier(unsigned* bar, int tid) {
    asm volatile("s_waitcnt vmcnt(0)" ::: "memory");
    __syncthreads();
    if (tid == 0) {
        __builtin_amdgcn_s_waitcnt(0);
        const unsigned x = xb_xcc_id();
        unsigned nloc = s_xb[0], nx = s_xb[1];
        if (nloc == 0u) { xcd_barrier_complete(bar, x, nloc, nx); s_xb[0] = nloc; s_xb[1] = nx; }
        const unsigned old = xb_add(&bar[XB_XSUB(x)], 1u);
        const unsigned gen = old / nloc;
        if (old + 1u == (gen + 1u) * nloc) {
            __builtin_amdgcn_fence(__ATOMIC_RELEASE, "agent");
            asm volatile("s_waitcnt vmcnt(0)" ::: "memory");
            const unsigned og = xb_add(&bar[XB_TOP], 1u);
            const unsigned tg = og / nx;
            if (og + 1u == (tg + 1u) * nx) xb_add(&bar[XB_TOPGEN], 1u);
            else XB_SPIN(xb_ld(&bar[XB_TOPGEN]) == tg, bar);
            __builtin_amdgcn_fence(__ATOMIC_ACQUIRE, "agent");
            xb_add(&bar[XB_XGEN(x)], 1u);
            asm volatile("s_waitcnt vmcnt(0)" ::: "memory");
        } else {
            XB_SPIN(xb_ld(&bar[XB_XGEN(x)]) == gen, bar);
            __builtin_amdgcn_fence(__ATOMIC_ACQUIRE, "agent");
            asm volatile("s_waitcnt vmcnt(0)" ::: "memory");
        }
    }
    __syncthreads();
}

constexpr int BK = 64, HALF = 128, HT = HALF * BK;
DI void stage_rc(int b, int& R, int& C) { int st = b / 1024, sb = b % 1024, swz = sb ^ (((sb >> 9) & 1) << 5); R = (st >> 1) * 16 + swz / 64; C = (st & 1) * 32 + (swz % 64) / 2; }

template <class Epi>
DI void gemm_unit(int tid_in, const h16* __restrict__ A, int lda, const h16* __restrict__ Bt, int ldb, int K, int brow, int bcol, h16* shm, const Epi& epi) {
#define SA(b, h) (shm + ((b) * 2 + (h)) * HT)
#define SB(b, h) (shm + (4 + (b) * 2 + (h)) * HT)
#define STAGE_A(P, br, kt) do { const char* _g = (const char*)(A + ((long)(br) * lda + (long)(kt) * BK)); \
    __builtin_amdgcn_global_load_lds((const unsigned*)(_g + oa0), (LAS unsigned*)((char*)(P) + tidx * 16), 16, 0, 0); \
    __builtin_amdgcn_global_load_lds((const unsigned*)(_g + (size_t)lda * 128 + oa0), (LAS unsigned*)((char*)(P) + tidx * 16 + 8192), 16, 0, 0); } while (0)
#define STAGE_B(P, br, kt) do { const char* _g = (const char*)(Bt + ((long)(br) * ldb + (long)(kt) * BK)); \
    __builtin_amdgcn_global_load_lds((const unsigned*)(_g + ob0), (LAS unsigned*)((char*)(P) + tidx * 16), 16, 0, 0); \
    __builtin_amdgcn_global_load_lds((const unsigned*)(_g + (size_t)ldb * 128 + ob0), (LAS unsigned*)((char*)(P) + tidx * 16 + 8192), 16, 0, 0); } while (0)
#define LDA(dst, b, h) _Pragma("unroll") for (int m = 0; m < 4; ++m) _Pragma("unroll") for (int k = 0; k < 2; ++k) dst[m][k] = *reinterpret_cast<const half8*>((char*)SA(b, h) + la + (m * 2 + k) * 1024)
#define LDB(dst, b, h) _Pragma("unroll") for (int n = 0; n < 2; ++n) _Pragma("unroll") for (int k = 0; k < 2; ++k) dst[n][k] = *reinterpret_cast<const half8*>((char*)SB(b, h) + lb + (n * 2 + k) * 1024)
#define MMA(ai, bj, At_, Bt_) do { __builtin_amdgcn_s_setprio(1); \
    _Pragma("unroll") for (int m = 0; m < 4; ++m) _Pragma("unroll") for (int n = 0; n < 2; ++n) _Pragma("unroll") for (int k = 0; k < 2; ++k) \
        acc[ai][bj][m][n] = __builtin_amdgcn_mfma_f32_16x16x32_f16(Bt_[n][k], At_[m][k], acc[ai][bj][m][n], 0, 0, 0); \
    __builtin_amdgcn_s_setprio(0); } while (0)
#define WAIT_V(n) asm volatile("s_waitcnt vmcnt(" #n ")" ::: "memory")
#define WAIT_L(n) asm volatile("s_waitcnt lgkmcnt(" #n ")" ::: "memory")
#define BAR __builtin_amdgcn_s_barrier()
#define SCHED __builtin_amdgcn_sched_barrier(0)
    int tidx = tid_in; asm volatile("" : "+v"(tidx));
    const int wid = tidx >> 6, lane = tidx & 63, wr = wid >> 2, wc = wid & 3, fr = lane & 15, fq = lane >> 4;
    const int lpart = ((fr * 64 + fq * 16) ^ ((fr >> 3) << 5));
    const int la = wr * 8192 + lpart, lb = wc * 4096 + lpart;
    unsigned oa0, ob0;
    { int _r, _c; stage_rc(tidx * 16, _r, _c); oa0 = (unsigned)(_r * lda + _c) * 2u; ob0 = (unsigned)(_r * ldb + _c) * 2u; }
    f32x4 acc[2][2][4][2] = {};
    half8 At[4][2], B0[2][2], B1[2][2];
    const int nt = K / BK;
    STAGE_B(SB(0, 0), bcol, 0); STAGE_A(SA(0, 0), brow, 0);
    STAGE_B(SB(0, 1), bcol + HALF, 0); STAGE_A(SA(0, 1), brow + HALF, 0);
    if (wr == 1) BAR;
    WAIT_V(4); BAR;
    STAGE_B(SB(1, 0), bcol, 1); STAGE_A(SA(1, 0), brow, 1); STAGE_B(SB(1, 1), bcol + HALF, 1);
    WAIT_V(6); BAR;
    for (int t = 0; t < nt - 2; t += 2) {
        LDB(B0, 0, 0); SCHED; LDA(At, 0, 0); STAGE_A(SA(1, 1), brow + HALF, t + 1);
        WAIT_L(8); BAR; WAIT_L(0); MMA(0, 0, At, B0); BAR; SCHED;
        LDB(B1, 0, 1); STAGE_B(SB(0, 0), bcol, t + 2);
        BAR; WAIT_L(0); MMA(0, 1, At, B1); BAR;
        LDA(At, 0, 1); STAGE_A(SA(0, 0), brow, t + 2);
        BAR; WAIT_L(0); MMA(1, 0, At, B0); BAR; SCHED;
        STAGE_B(SB(0, 1), bcol + HALF, t + 2);
        WAIT_V(6); BAR; MMA(1, 1, At, B1); BAR;
        LDB(B0, 1, 0); SCHED; LDA(At, 1, 0); STAGE_A(SA(0, 1), brow + HALF, t + 2);
        WAIT_L(8); BAR; WAIT_L(0); MMA(0, 0, At, B0); BAR; SCHED;
        LDB(B1, 1, 1); STAGE_B(SB(1, 0), bcol, t + 3);
        BAR; WAIT_L(0); MMA(0, 1, At, B1); BAR;
        LDA(At, 1, 1); STAGE_A(SA(1, 0), brow, t + 3);
        BAR; WAIT_L(0); MMA(1, 0, At, B0); BAR; SCHED;
        STAGE_B(SB(1, 1), bcol + HALF, t + 3);
        WAIT_V(6); BAR; MMA(1, 1, At, B1); BAR;
    }
    { LDB(B0, 0, 0); LDA(At, 0, 0); STAGE_A(SA(1, 1), brow + HALF, nt - 1);
      BAR; WAIT_L(0); MMA(0, 0, At, B0); BAR;
      LDB(B1, 0, 1); BAR; WAIT_L(0); MMA(0, 1, At, B1); BAR;
      LDA(At, 0, 1); WAIT_V(4); BAR; WAIT_L(0); MMA(1, 0, At, B0); MMA(1, 1, At, B1); BAR; }
    { LDB(B0, 1, 0); LDA(At, 1, 0); WAIT_V(2); BAR; WAIT_L(0); MMA(0, 0, At, B0); BAR;
      LDB(B1, 1, 1); WAIT_V(0); BAR; WAIT_L(0); MMA(0, 1, At, B1); BAR;
      LDA(At, 1, 1); BAR; WAIT_L(0); MMA(1, 0, At, B0); MMA(1, 1, At, B1); BAR; }
    if (wr == 0) BAR;
    epi(acc, brow + wr * 64 + fr, bcol + wc * 32 + fq * 4);
    __syncthreads();
}
DI bool unit_order(int L, int nM, int nN, int& pm, int& pn) {
    const int nwg = nM * nN; if (L >= nwg) return false;
    int wgid = L; { const int q = nwg / 8, r = nwg % 8, xcd = wgid % 8, off = wgid / 8; wgid = (xcd < r ? xcd * (q + 1) : r * (q + 1) + (xcd - r) * q) + off; }
    const int nig = 8 * nN, gid = wgid / nig, fm = gid * 8, gsz = (nM - fm) < 8 ? (nM - fm) : 8;
    pm = fm + ((wgid % nig) % gsz); pn = (wgid % nig) / gsz; return true;
}
typedef f32x4 Acc[2][2][4][2];
#define EPI_LOOP _Pragma("unroll") for (int ai = 0; ai < 2; ++ai) _Pragma("unroll") for (int bj = 0; bj < 2; ++bj) _Pragma("unroll") for (int m = 0; m < 4; ++m) _Pragma("unroll") for (int n = 0; n < 2; ++n)
struct EpiZ { h16* z; int ld;
    DI void operator()(Acc& acc, int r0, int c0) const { EPI_LOOP { const int row = r0 + ai * 128 + m * 16, col = c0 + bj * 128 + n * 16;
        half4 v; _Pragma("unroll") for (int j = 0; j < 4; ++j) v[j] = (h16)acc[ai][bj][m][n][j]; *(half4*)(z + (size_t)row * ld + col) = v; } } };
struct EpiLora { h16 *dec, *a, *g; const float *w0, *a0;
    DI void operator()(Acc& acc, int r0, int c0) const { EPI_LOOP { const int row = r0 + ai * 128 + m * 16, col = c0 + bj * 128 + n * 16; half4 v;
        if (col < 512) { _Pragma("unroll") for (int j = 0; j < 4; ++j) { const float lw = w0[col + j] + acc[ai][bj][m][n][j]; v[j] = (h16)__expf(-0.60653066f * sigmoidf_(lw)); } *(half4*)(dec + (size_t)row * 512 + col) = v; }
        else if (col < 1024) { _Pragma("unroll") for (int j = 0; j < 4; ++j) v[j] = (h16)sigmoidf_(a0[col - 512 + j] + acc[ai][bj][m][n][j]); *(half4*)(a + (size_t)row * 512 + col - 512) = v; }
        else { _Pragma("unroll") for (int j = 0; j < 4; ++j) v[j] = (h16)acc[ai][bj][m][n][j]; *(half4*)(g + (size_t)row * 512 + col - 1024) = v; } } } };
struct EpiCmp { h16* hid; const float* bias;
    DI void operator()(Acc& acc, int r0, int c0) const { EPI_LOOP { const int row = r0 + ai * 128 + m * 16, col = c0 + bj * 128 + n * 16; half4 v;
        _Pragma("unroll") for (int j = 0; j < 4; ++j) { const float x = acc[ai][bj][m][n][j] + bias[col + j]; const float u = 0.7978845608f * (x + 0.044715f * x * x * x);
            const float th = 1.f - 2.f * rcpf_(1.f + __expf(2.f * u)); v[j] = (h16)(0.5f * x * (1.f + th)); }
        *(half4*)(hid + (size_t)row * 256 + col) = v; } } };
struct EpiRes { const float* xin; float* xout; const float* gate;
    DI void operator()(Acc& acc, int r0, int c0) const { EPI_LOOP { const int row = r0 + ai * 128 + m * 16, col = c0 + bj * 128 + n * 16;
        const f32x4 xi = *(const f32x4*)(xin + (size_t)row * D + col); const f32x4 gg = *(const f32x4*)(gate + (size_t)(row >> 11) * 6144 + col);
        f32x4 o; _Pragma("unroll") for (int j = 0; j < 4; ++j) o[j] = xi[j] + gg[j] * acc[ai][bj][m][n][j]; *(f32x4*)(xout + (size_t)row * D + col) = o; } } };
struct EpiSwiglu { h16* hid;
    DI void operator()(Acc& acc, int r0, int c0) const { _Pragma("unroll") for (int ai = 0; ai < 2; ++ai) _Pragma("unroll") for (int m = 0; m < 4; ++m) _Pragma("unroll") for (int n = 0; n < 2; ++n) {
        const int row = r0 + ai * 128 + m * 16; const int tcol = c0 & 255, pn = c0 >> 8; const int col = pn * 128 + tcol + n * 16; half4 v;
        _Pragma("unroll") for (int j = 0; j < 4; ++j) { const float gt = acc[ai][0][m][n][j], up = acc[ai][1][m][n][j]; v[j] = (h16)(gt * sigmoidf_(gt) * up); }
        *(half4*)(hid + (size_t)row * FF + col) = v; } } };

struct Ctx {
    float* out; unsigned char* ws; char* lds; unsigned* ctl;
    int tid, lane, wave, gw, ngw;
    template <class Tp> DI Tp* W(size_t off) const { return (Tp*)(ws + off); }
    DI const float* inp(int i) const { const unsigned* t = (const unsigned*)(ws + WS_PTRS) + 2 * i;
        const unsigned lo = __builtin_amdgcn_readfirstlane(t[0]), hi = __builtin_amdgcn_readfirstlane(t[1]); return (const float*)(((uintptr_t)hi << 32) | lo); }
    DI const float* inl(int i, int l, size_t per_layer) const { return inp(i) + (size_t)l * per_layer; }
};

template <class CM>
DI void tr_item(const float* __restrict__ Wsrc, int K, int Nsrc, h16* WT, int k0, int n0, float* scr, int lane, CM cm) {
    const int sc = cm(n0 + (lane & 31));
#pragma unroll 8
    for (int i = 0; i < 32; ++i) { const int kk = 2 * i + (lane >> 5); scr[kk * 33 + (lane & 31)] = sc >= 0 ? Wsrc[(size_t)(k0 + kk) * Nsrc + sc] : 0.f; }
    WSYNC();
    const int c = lane & 7;
#pragma unroll
    for (int j = 0; j < 4; ++j) { const int n = (lane >> 3) + 8 * j; const float* s = scr + (8 * c) * 33 + n; half8 o;
        _Pragma("unroll") for (int q = 0; q < 8; ++q) o[q] = (h16)s[q * 33];
        *(half8*)(WT + (size_t)(n0 + n) * K + k0 + 8 * c) = o; }
    WSYNC();
}
DI void convert_weights(const Ctx& c, int l) {
    float* scr = (float*)(c.lds + c.wave * 8448);
    constexpr int I_IN = 16 * 104, I_OUT = 16 * 32, I_FI = 16 * 176, I_FO = 44 * 32, I_W1 = 32 * 8;
    constexpr int NIT = I_IN + I_OUT + I_FI + I_FO + 2 * I_W1;
    for (int it = c.gw; it < NIT; it += c.ngw) {
        int r = it;
        if (r < I_IN) { tr_item(c.inl(I_WIN, l, (size_t)D * 3152), D, 3152, c.W<h16>(WS_WIN), (r / 104) * 64, (r % 104) * 32, scr, c.lane,
                                [](int n) { return n < 708 ? n : (n < 768 ? -1 : (n < 3212 ? n - 60 : -1)); }); continue; } r -= I_IN;
        if (r < I_OUT) { tr_item(c.inl(I_WOUT, l, (size_t)D * D), D, D, c.W<h16>(WS_WOUT), (r / 32) * 64, (r % 32) * 32, scr, c.lane, [](int n) { return n; }); continue; } r -= I_OUT;
        if (r < I_FI) { tr_item(c.inl(I_FWI, l, (size_t)D * 2 * FF), D, 2 * FF, c.W<h16>(WS_WI), (r / 176) * 64, (r % 176) * 32, scr, c.lane,
                                [](int n) { const int pn = n >> 8, q = n & 255; return q < 128 ? pn * 128 + q : FF + pn * 128 + (q - 128); }); continue; } r -= I_FI;
        if (r < I_FO) { tr_item(c.inl(I_FWO, l, (size_t)FF * D), FF, D, c.W<h16>(WS_WO), (r / 32) * 64, (r % 32) * 32, scr, c.lane, [](int n) { return n; }); continue; } r -= I_FO;
        const int j = r / I_W1; r %= I_W1;
        tr_item(c.inl(I_NW1, l, (size_t)2 * 2048 * 256) + (size_t)j * 2048 * 256, 2048, 256, c.W<h16>(WS_W1) + (size_t)j * 256 * 2048, (r / 8) * 64, (r % 8) * 32, scr, c.lane, [](int n) { return n; });
    }
    const float* w2 = c.inl(I_W2, l, 64 * 512); const float* a2 = c.inl(I_A2, l, 64 * 512); const float* g2 = c.inl(I_G2, l, 128 * 512);
    h16* wl = c.W<h16>(WS_WL);
    for (int e = blockIdx.x * NTHREADS + c.tid; e < 1536 * 256; e += gridDim.x * NTHREADS) {
        const int n = e >> 8, k = e & 255; float v = 0.f;
        if (n < 512) { if (k < 64) v = w2[k * 512 + n]; }
        else if (n < 1024) { if (k >= 64 && k < 128) v = a2[(k - 64) * 512 + n - 512]; }
        else { if (k >= 128) v = g2[(k - 128) * 512 + n - 1024]; }
        wl[e] = (h16)v;
    }
}
template <int NV>
DI void gemv_item(const Ctx& c, const float* aL, int K, const float* __restrict__ Wsrc, int N, int n0, const float* bias, float* out, int out_stride, float* red) {
    const int nl = c.tid & 31, kc = c.tid >> 5, kper = K / 16;
    float acc[NV]; for (int v = 0; v < NV; ++v) acc[v] = 0.f;
    for (int k = kc * kper; k < (kc + 1) * kper; ++k) { const float w = Wsrc[(size_t)k * N + n0 + nl]; for (int v = 0; v < NV; ++v) acc[v] += aL[v * K + k] * w; }
    for (int v = 0; v < NV; ++v) red[(kc * NV + v) * 32 + nl] = acc[v];
    __syncthreads();
    if (c.tid < 32 * NV) { const int v = c.tid >> 5; float s = bias ? bias[n0 + nl] : 0.f; _Pragma("unroll") for (int q = 0; q < 16; ++q) s += red[(q * NV + v) * 32 + nl]; out[(size_t)v * out_stride + n0 + nl] = s; }
    __syncthreads();
}
DI void phase_mod(const Ctx& c) {
    float* sil = (float*)(c.lds + 70000); float* red = (float*)(c.lds + 70000 + 32768);
    for (int e = c.tid; e < 8 * 1024; e += NTHREADS) { const float x = c.inp(I_C)[e]; sil[e] = x * sigmoidf_(x); }
    __syncthreads();
    for (int it = blockIdx.x; it < 2 * 192; it += gridDim.x) { const int l = it / 192, n0 = (it % 192) * 32;
        gemv_item<8>(c, sil, 1024, c.inl(I_ADAW, l, (size_t)1024 * 6144), 6144, n0, c.inl(I_ADAB, l, 6144), c.W<float>(WS_MOD) + (size_t)l * 8 * 6144, 6144, red); }
}
DI void phase_cbias(const Ctx& c, int l) {
    float* pe = (float*)(c.lds + 70000); float* red = (float*)(c.lds + 70000 + 32768);
    __syncthreads();
    for (int e = c.tid; e < 2 * 2048; e += NTHREADS) pe[e] = c.inl(I_PE, l, 2 * 2048)[e];
    __syncthreads();
    for (int it = (int)gridDim.x - 1 - (int)blockIdx.x; it < 16; it += gridDim.x) { const int j = it >> 3, n0 = (it & 7) * 32;
        gemv_item<1>(c, pe + j * 2048, 2048, c.inl(I_NW1, l, (size_t)2 * 2048 * 256) + (size_t)j * 2048 * 256, 256, n0, nullptr, c.W<float>(WS_CBIAS) + j * 256, 256, red); }
}
DI void phase_norm(const Ctx& c, const float* x, const float* g, const float* mod_l, int sh_off, int sc_off) {
    h16* act = c.W<h16>(WS_ACT);
    for (int m = c.gw; m < M; m += c.ngw) {
        const f32x4* xr = (const f32x4*)(x + (size_t)m * D) + c.lane; f32x4 v[4]; float s = 0.f;
        _Pragma("unroll") for (int j = 0; j < 4; ++j) { v[j] = xr[64 * j]; s += v[j].x * v[j].x + v[j].y * v[j].y + v[j].z * v[j].z + v[j].w * v[j].w; }
        const float rstd = rsqf_(wave_sum(s) * (1.f / D) + 1e-6f);
        const float* mb = mod_l + (size_t)(m >> 11) * 6144;
        _Pragma("unroll") for (int j = 0; j < 4; ++j) { const int col = 4 * c.lane + 256 * j; const f32x4 gg = *(const f32x4*)(g + col), sc = *(const f32x4*)(mb + sc_off + col), sh = *(const f32x4*)(mb + sh_off + col);
            half4 o; _Pragma("unroll") for (int q = 0; q < 4; ++q) o[q] = (h16)(v[j][q] * rstd * gg[q] * (1.f + sc[q]) + sh[q]);
            *(half4*)(act + (size_t)m * D + col) = o; }
    }
}
template <class Epi>
DI void phase_gemm(const Ctx& c, const h16* A, int lda, const h16* Bt, int ldb, int K, int nM, int nN, const Epi& epi) {
    for (int i = 0;; ++i) { int pm, pn; if (!unit_order(i * (int)gridDim.x + (int)blockIdx.x, nM, nN, pm, pn)) break;
        gemm_unit(c.tid, A, lda, Bt, ldb, K, pm * 256, pn * 256, (h16*)c.lds, epi); }
}

DI void phase_prep(const Ctx& c, int l) {
    h16* Z = c.W<h16>(WS_Z);
    const float* dqg = c.inl(I_DQG, l, 64); const float* dkg = c.inl(I_DKG, l, 64); const float* nqg = c.inl(I_NQG, l, 64); const float* nkg = c.inl(I_NKG, l, 64);
    const float* mu = c.inl(I_MU, l, 1792);
    const int lane = c.lane; const bool hi = lane >= 32;
    const float inv = powf(10000.f, -(float)(lane & 31) * (1.f / 32.f));
    const float g_dq = dqg[lane], g_dk = dkg[lane], g_nq = nqg[lane], g_nk = nkg[lane];
    for (int m = c.gw; m < M; m += c.ngw) {
        const int b = m >> 11, t = m & 2047; h16* zr = Z + (size_t)m * ZC;
        const float ang = (float)t * inv; const float cs = cosf(ang), sn = sinf(ang);
        auto rope = [&](float x) { const float o = __shfl_xor(x, 32); return hi ? x * cs + o * sn : x * cs - o * sn; };
        auto normrope = [&](float x, float g) { const float ss = wave_sum(x * x); return rope(x * rsqf_(ss * (1.f / 64.f) + 1e-6f) * g); };
        _Pragma("unroll") for (int h = 0; h < 4; ++h) { h16* p = zr + C_QA + h * 64 + lane; *p = (h16)(normrope((float)*p, g_dq) * 0.125f); }
        c.W<h16>(WS_KA)[(size_t)m * 64 + lane] = (h16)normrope((float)zr[C_KA + lane], g_dk);
        c.W<h16>(WS_VAT)[((size_t)b * 64 + lane) * T + t] = zr[C_VA + lane];
        _Pragma("unroll") for (int h = 0; h < 4; ++h) { h16* p = zr + C_IQ + h * 64 + lane; *p = (h16)rope((float)*p); }
        c.W<h16>(WS_IK)[(size_t)m * 64 + lane] = (h16)rope((float)zr[C_IK + lane]);
        _Pragma("unroll") for (int h = 0; h < 4; ++h) { h16* p = zr + C_QC + h * 64 + lane; *p = (h16)(normrope((float)*p, g_nq) * 0.125f); }
        c.W<h16>(WS_KC)[(size_t)m * 64 + lane] = zr[C_KC + lane];
        c.W<h16>(WS_VC)[(size_t)m * 64 + lane] = zr[C_VC + lane];
        c.W<h16>(WS_KS)[(size_t)m * 64 + lane] = (h16)normrope((float)zr[C_KS + lane], g_nk);
        c.W<h16>(WS_VST)[((size_t)b * 64 + lane) * T + t] = zr[C_VS + lane];
        c.W<h16>(WS_KW)[(size_t)m * 64 + lane] = (h16)normrope((float)zr[C_KW + lane], g_nk);
        c.W<h16>(WS_VWT)[((size_t)b * 64 + lane) * T + t] = zr[C_VW + lane];
        { const int c4 = lane * 4; const half4 zc = *(const half4*)(zr + C_WD + c4); half4 zp = {0, 0, 0, 0}; if (t > 0) zp = *(const half4*)(zr - ZC + C_WD + c4);
          half4 o; _Pragma("unroll") for (int q = 0; q < 4; ++q) { const float a = (float)zc[q], v = a + ((float)zp[q] - a) * mu[1536 + c4 + q];
              o[q] = (h16)(c4 < 64 ? tanhf(v) : (c4 < 128 ? v : sigmoidf_(v))); }
          *(half4*)(c.W<h16>(WS_L16) + (size_t)m * 256 + c4) = o; }
    }
}

constexpr int SCS = 2056;
DI unsigned sortable(float v) { if (v == 0.f) v = 0.f; const unsigned u = __builtin_bit_cast(unsigned, v); return (u & 0x80000000u) ? ~u : (u | 0x80000000u); }
DI void dsa_select_item(const Ctx& c, int item) {
    const int b = item >> 7, t0 = (item & 127) * 16; const int lane = c.lane, w = c.wave;
    unsigned* dmask = c.W<unsigned>(WS_DMASK);
    if (t0 < 256) {
        for (int e = c.tid; e < 16 * 64; e += NTHREADS) { const int qi = e >> 6, wd = e & 63, t = t0 + qi; const int nb = t + 1 - 32 * wd;
            dmask[(size_t)(b * T + t) * 64 + wd] = nb <= 0 ? 0u : (nb >= 32 ? 0xFFFFFFFFu : ((1u << nb) - 1u)); }
        return;
    }
    float* sc = (float*)c.lds;
    const h16* Z = c.W<h16>(WS_Z); const h16* IK = c.W<h16>(WS_IK) + (size_t)b * T * 64;
    const int r = lane & 31, hf = lane >> 5, hd = r & 3;
    half8 qf[2][4]; float iw[2];
    _Pragma("unroll") for (int cb = 0; cb < 2; ++cb) { const int mq = b * T + t0 + 8 * cb + (r >> 2); const h16* zq = Z + (size_t)mq * ZC;
        _Pragma("unroll") for (int ks = 0; ks < 4; ++ks) qf[cb][ks] = *(const half8*)(zq + C_IQ + hd * 64 + 16 * ks + 8 * hf);
        iw[cb] = (float)zq[C_IW + hd]; }
    const int ntile = (t0 + 15) / 32 + 1;
    for (int kt = w; kt < ntile; kt += 8) {
        const h16* kr = IK + (size_t)(32 * kt + r) * 64 + 8 * hf;
        f32x16 s0 = {}, s1 = {};
        _Pragma("unroll") for (int ks = 0; ks < 4; ++ks) { const half8 kf = *(const half8*)(kr + 16 * ks); s0 = MFMA32(kf, qf[0][ks], s0); s1 = MFMA32(kf, qf[1][ks], s1); }
        _Pragma("unroll") for (int i = 0; i < 16; ++i) { const int key = 32 * kt + crow(i, hf);
            const float v0 = quad_sum(iw[0] * fmaxf(s0[i], 0.f)), v1 = quad_sum(iw[1] * fmaxf(s1[i], 0.f));
            if (hd == 0) { sc[(r >> 2) * SCS + key] = v0; sc[(8 + (r >> 2)) * SCS + key] = v1; } }
    }
    __syncthreads();
    _Pragma("unroll") for (int qq = 0; qq < 2; ++qq) {
        const int qi = 2 * w + qq, t = t0 + qi; unsigned u[32];
        _Pragma("unroll") for (int i = 0; i < 32; ++i) { const int key = 64 * i + lane; u[i] = key <= t ? sortable(sc[qi * SCS + key]) : 0u; }
        unsigned thr = 0u; bool exact = false;
        for (int bit = 31; bit >= 0; --bit) { const unsigned cand = thr | (1u << bit); int cnt = 0;
            _Pragma("unroll") for (int i = 0; i < 32; ++i) cnt += __popcll(__ballot(u[i] >= cand));
            if (cnt >= 256) { thr = cand; if (cnt == 256) { exact = true; break; } } }
        int need = 0;
        if (!exact) { int cg_ = 0; _Pragma("unroll") for (int i = 0; i < 32; ++i) cg_ += __popcll(__ballot(u[i] > thr)); need = 256 - cg_; }
        unsigned long long mine = 0ull; int run = 0;
        _Pragma("unroll") for (int i = 0; i < 32; ++i) { bool sel;
            if (exact) sel = u[i] >= thr;
            else { const bool eq = (u[i] == thr); const unsigned long long be = __ballot(eq); const int pre = run + __popcll(be & ((1ull << lane) - 1ull)); sel = (u[i] > thr) || (eq && pre < need); run += __popcll(be); }
            const unsigned long long bs = __ballot(sel); if (lane == i) mine = bs; }
        if (lane < 32) *(unsigned long long*)(dmask + (size_t)(b * T + t) * 64 + 2 * lane) = mine;
    }
}

struct Flash { f32x16 o0, o1; float mx, l; DI void init() { _Pragma("unroll") for (int i = 0; i < 16; ++i) { o0[i] = 0.f; o1[i] = 0.f; } mx = -1e30f; l = 0.f; } };
template <class VF>
DI void flash_tile(Flash& f, const half8 (&qf)[4], const h16* Kb, const h16* Vt, int ldv, int key0, int lane, VF valid) {
    const int r = lane & 31, hf = lane >> 5;
    const h16* kr = Kb + (size_t)(key0 + r) * 64 + 8 * hf;
    f32x16 s = {};
    _Pragma("unroll") for (int ks = 0; ks < 4; ++ks) { const half8 kf = *(const half8*)(kr + 16 * ks); s = MFMA32(kf, qf[ks], s); }
    float tmax = -1e30f;
    _Pragma("unroll") for (int i = 0; i < 16; ++i) { s[i] = valid(i) ? s[i] : -1e30f; tmax = fmaxf(tmax, s[i]); }
    tmax = fmaxf(tmax, __shfl_xor(tmax, 32));
    const float mnew = fmaxf(f.mx, tmax), alpha = __expf(f.mx - mnew);
    float psum = 0.f;
    _Pragma("unroll") for (int i = 0; i < 16; ++i) { const float p = s[i] > -1e29f ? __expf(s[i] - mnew) : 0.f; s[i] = p; psum += p; }
    f.l = f.l * alpha + psum; f.mx = mnew;
    _Pragma("unroll") for (int i = 0; i < 16; ++i) { f.o0[i] *= alpha; f.o1[i] *= alpha; }
    _Pragma("unroll") for (int st = 0; st < 2; ++st) { half8 pf; _Pragma("unroll") for (int j = 0; j < 8; ++j) pf[j] = (h16)s[8 * st + j];
        const h16* vp0 = Vt + (size_t)r * ldv + key0 + 16 * st + 4 * hf; const h16* vp1 = vp0 + (size_t)32 * ldv;
        const half4 a0 = *(const half4*)vp0, b0 = *(const half4*)(vp0 + 8), a1 = *(const half4*)vp1, b1 = *(const half4*)(vp1 + 8);
        const half8 v0 = __builtin_shufflevector(a0, b0, 0, 1, 2, 3, 4, 5, 6, 7), v1 = __builtin_shufflevector(a1, b1, 0, 1, 2, 3, 4, 5, 6, 7);
        f.o0 = MFMA32(v0, pf, f.o0); f.o1 = MFMA32(v1, pf, f.o1); }
}
DI void store_o(h16* dst  , const f32x16& o0, const f32x16& o1, int hf) {
    _Pragma("unroll") for (int g = 0; g < 4; ++g) { half4 a, b; _Pragma("unroll") for (int j = 0; j < 4; ++j) { a[j] = (h16)o0[4 * g + j]; b[j] = (h16)o1[4 * g + j]; }
        *(half4*)(dst + 8 * g + 4 * hf) = a; *(half4*)(dst + 32 + 8 * g + 4 * hf) = b; }
}
DI void dsa_attn_wave(const Ctx& c, int b, int t0) {
    const int lane = c.lane, r = lane & 31, hf = lane >> 5, hd = r & 3, t = t0 + (r >> 2), m = b * T + t;
    const h16* zq = c.W<h16>(WS_Z) + (size_t)m * ZC + C_QA + hd * 64 + 8 * hf;
    half8 qf[4]; _Pragma("unroll") for (int ks = 0; ks < 4; ++ks) qf[ks] = *(const half8*)(zq + 16 * ks);
    const h16* Kb = c.W<h16>(WS_KA) + (size_t)b * T * 64; const h16* Vt = c.W<h16>(WS_VAT) + (size_t)b * 64 * T;
    const unsigned* mrow = c.W<unsigned>(WS_DMASK) + (size_t)m * 64;
    Flash f; f.init();
    const int ntile = (t0 + 7) / 32 + 1;
    for (int kt = 0; kt < ntile; ++kt) { const unsigned word = mrow[kt]; if (__ballot(word != 0u) == 0ull) continue;
        flash_tile(f, qf, Kb, Vt, T, 32 * kt, lane, [&](int i) { return ((word >> crow(i, hf)) & 1u) != 0u; }); }
    const float lt = f.l + __shfl_xor(f.l, 32), inv = rcpf_(lt);
    _Pragma("unroll") for (int i = 0; i < 16; ++i) { f.o0[i] *= inv; f.o1[i] *= inv; }
    store_o(c.W<h16>(WS_ACT) + (size_t)m * D + hd * 64, f.o0, f.o1, hf);
}
DI void nsa_attn_wave(const Ctx& c, int b, int t0) {
    const int lane = c.lane, w = c.wave, r = lane & 31, hf = lane >> 5, hd = r & 3, qi = r >> 2, t = t0 + qi, m = b * T + t;
    const h16* zrow = c.W<h16>(WS_Z) + (size_t)m * ZC;
    half8 qf[4]; _Pragma("unroll") for (int ks = 0; ks < 4; ++ks) qf[ks] = *(const half8*)(zrow + C_QC + hd * 64 + 8 * hf + 16 * ks);
    const float g0 = sigmoidf_((float)zrow[C_GC + hd * 3 + 0]), g1 = sigmoidf_((float)zrow[C_GC + hd * 3 + 1]), g2 = sigmoidf_((float)zrow[C_GC + hd * 3 + 2]);
    float* GS = (float*)(c.lds + w * 4096); float* LA = GS + 256; float* IMPF = GS + 512; unsigned* SELM = (unsigned*)(GS + 768);
    f32x16 a0, a1;
    {
        const h16* Kc = c.W<h16>(WS_KCMP) + (size_t)b * 128 * 64; const h16* Vc = c.W<h16>(WS_VCMPT) + (size_t)b * 64 * 128;
        const int nmax = t >= 31 ? ((t - 31) >> 4) : -1;
        f32x16 s[4]; float mxv = -1e30f;
        _Pragma("unroll") for (int tl = 0; tl < 4; ++tl) { const h16* kr = Kc + (size_t)(32 * tl + r) * 64 + 8 * hf; f32x16 a = {};
            _Pragma("unroll") for (int ks = 0; ks < 4; ++ks) { const half8 kf = *(const half8*)(kr + 16 * ks); a = MFMA32(kf, qf[ks], a); }
            _Pragma("unroll") for (int i = 0; i < 16; ++i) { const int n = 32 * tl + crow(i, hf); a[i] = n <= nmax ? a[i] : -1e30f; mxv = fmaxf(mxv, a[i]); }
            s[tl] = a; }
        mxv = fmaxf(mxv, __shfl_xor(mxv, 32));
        float sum = 0.f;
        _Pragma("unroll") for (int tl = 0; tl < 4; ++tl) _Pragma("unroll") for (int i = 0; i < 16; ++i) { const float p = s[tl][i] > -1e29f ? __expf(s[tl][i] - mxv) : 0.f; s[tl][i] = p; sum += p; }
        sum += __shfl_xor(sum, 32);
        const float inv = sum > 0.f ? rcpf_(sum) : 0.f;
        f32x16 o0 = {}, o1 = {};
        _Pragma("unroll") for (int tl = 0; tl < 4; ++tl) { _Pragma("unroll") for (int i = 0; i < 16; ++i) s[tl][i] *= inv;
            _Pragma("unroll") for (int st = 0; st < 2; ++st) { half8 pf; _Pragma("unroll") for (int j = 0; j < 8; ++j) pf[j] = (h16)s[tl][8 * st + j];
                const h16* vp0 = Vc + (size_t)r * 128 + 32 * tl + 16 * st + 4 * hf; const h16* vp1 = vp0 + 32 * 128;
                const half4 x0 = *(const half4*)vp0, y0 = *(const half4*)(vp0 + 8), x1 = *(const half4*)vp1, y1 = *(const half4*)(vp1 + 8);
                o0 = MFMA32(__builtin_shufflevector(x0, y0, 0, 1, 2, 3, 4, 5, 6, 7), pf, o0); o1 = MFMA32(__builtin_shufflevector(x1, y1, 0, 1, 2, 3, 4, 5, 6, 7), pf, o1); } }
        _Pragma("unroll") for (int i = 0; i < 16; ++i) { a0[i] = g0 * o0[i]; a1[i] = g0 * o1[i]; }
        _Pragma("unroll") for (int tl = 0; tl < 4; ++tl) _Pragma("unroll") for (int g = 0; g < 4; ++g) { const int G = 8 * tl + 2 * g + hf;
            const float gs = quad_sum((s[tl][4 * g] + s[tl][4 * g + 1]) + (s[tl][4 * g + 2] + s[tl][4 * g + 3])); const float la = quad_sum(s[tl][4 * g + 3]);
            if (hd == 0) { GS[qi * 32 + G] = gs; LA[qi * 32 + G] = la; } }
        WSYNC();
        _Pragma("unroll") for (int it = 0; it < 4; ++it) { const int q = (lane >> 5) + 2 * it, j = lane & 31, tq = t0 + q, cur = tq >> 6;
            const float imp = GS[q * 32 + j] + (j > 0 ? LA[q * 32 + j - 1] : 0.f);
            const bool adm = (j * 64 <= tq), forced = (j == 0) || (j == cur) || (j == cur - 1);
            IMPF[q * 32 + j] = adm ? (forced ? __builtin_inff() : imp) : -__builtin_inff(); }
        WSYNC();
        _Pragma("unroll") for (int it = 0; it < 4; ++it) { const int q = (lane >> 5) + 2 * it, j = lane & 31; const float mv = IMPF[q * 32 + j]; int rank = 0;
            _Pragma("unroll") for (int jj = 0; jj < 32; ++jj) { const float ov = IMPF[q * 32 + jj]; rank += (ov > mv || (ov == mv && jj < j)) ? 1 : 0; }
            const unsigned long long bs = __ballot(rank < 16);
            if (lane == 0) { SELM[2 * it] = (unsigned)bs; SELM[2 * it + 1] = (unsigned)(bs >> 32); } }
        WSYNC();
    }
    const unsigned selmask = SELM[qi];
    WSYNC();
    {
        const h16* Kb = c.W<h16>(WS_KS) + (size_t)b * T * 64; const h16* Vt = c.W<h16>(WS_VST) + (size_t)b * 64 * T;
        Flash f; f.init();
        const int ntile = (t0 + 7) / 32 + 1;
        for (int kt = 0; kt < ntile; ++kt) { const bool bit = ((selmask >> (kt >> 1)) & 1u) != 0u; if (__ballot(bit) == 0ull) continue;
            const int key0 = 32 * kt; flash_tile(f, qf, Kb, Vt, T, key0, lane, [&](int i) { return bit && (key0 + crow(i, hf) <= t); }); }
        const float lt = f.l + __shfl_xor(f.l, 32), sc = g1 * rcpf_(lt);
        _Pragma("unroll") for (int i = 0; i < 16; ++i) { a0[i] += sc * f.o0[i]; a1[i] += sc * f.o1[i]; }
    }
    {
        const h16* Kb = c.W<h16>(WS_KW) + (size_t)b * T * 64; const h16* Vt = c.W<h16>(WS_VWT) + (size_t)b * 64 * T;
        Flash f; f.init();
        const int lo = (t0 - 511 > 0 ? t0 - 511 : 0) >> 5, hiT = (t0 + 7) >> 5;
        for (int kt = lo; kt <= hiT; ++kt) { const int key0 = 32 * kt;
            flash_tile(f, qf, Kb, Vt, T, key0, lane, [&](int i) { const int key = key0 + crow(i, hf); return key <= t && key > t - 512; }); }
        const float lt = f.l + __shfl_xor(f.l, 32), sc = g2 * rcpf_(lt);
        _Pragma("unroll") for (int i = 0; i < 16; ++i) { a0[i] += sc * f.o0[i]; a1[i] += sc * f.o1[i]; }
    }
    store_o(c.W<h16>(WS_ACT) + (size_t)m * D + 768 + hd * 64, a0, a1, hf);
}

DI void rwkv_item(const Ctx& c, int l, int item) {
    const int b = item >> 3, h = item & 7; const int lane = c.lane, w = c.wave;
    float* base = (float*)c.lds;
    const h16* Z = c.W<h16>(WS_Z); const h16* DEC = c.W<h16>(WS_DEC); const h16* AA = c.W<h16>(WS_A); const h16* GG = c.W<h16>(WS_G); h16* MIX = c.W<h16>(WS_ACT);
    const float* mu = c.inl(I_MU, l, 1792); const float* k_k = c.inl(I_KK, l, 512); const float* k_a = c.inl(I_KA, l, 512); const float* r_k = c.inl(I_RK, l, 512);
    const float* ln_w = c.inl(I_LNW, l, 512); const float* ln_b = c.inl(I_LNB, l, 512);
    const int t2 = (w & 3) * 64 + lane; const int s_ = t2 >> 3, ch = (t2 & 7) * 8, col = h * 64 + ch;
    const int rl = lane >> 3, cc = lane & 7, i0 = 16 * (w & 3) + 2 * rl, j0 = 8 * cc;
    float S0[8], S1[8];
    _Pragma("unroll") for (int q = 0; q < 8; ++q) { S0[q] = 0.f; S1[q] = 0.f; }
    auto stage = [&](int chunk) {
        float* bf = base + (chunk & 1) * 6 * 2048; const int tt = chunk * 32 + s_; const int m = b * T + tt;
        const h16* zr = Z + (size_t)m * ZC;
        const half8 r8 = *(const half8*)(zr + C_R + col), k8 = *(const half8*)(zr + C_K + col), v8 = *(const half8*)(zr + C_V + col);
        half8 rp = {0, 0, 0, 0, 0, 0, 0, 0}, kp_ = rp, vp = rp;
        if (tt > 0) { rp = *(const half8*)(zr - ZC + C_R + col); kp_ = *(const half8*)(zr - ZC + C_K + col); vp = *(const half8*)(zr - ZC + C_V + col); }
        const half8 d8 = *(const half8*)(DEC + (size_t)m * 512 + col), a8 = *(const half8*)(AA + (size_t)m * 512 + col);
        float rr[8], kx[8], vv[8], kr[8]; float ss = 0.f;
        _Pragma("unroll") for (int q = 0; q < 8; ++q) { const float r0 = (float)r8[q], k0 = (float)k8[q], v0 = (float)v8[q];
            rr[q] = r0 + ((float)rp[q] - r0) * mu[col + q]; kx[q] = k0 + ((float)kp_[q] - k0) * mu[512 + col + q]; vv[q] = v0 + ((float)vp[q] - v0) * mu[1024 + col + q];
            kr[q] = kx[q] * k_k[col + q]; ss += kr[q] * kr[q]; }
        ss = red8(ss); const float inrm = rcpf_(fmaxf(__builtin_amdgcn_sqrtf(ss), 1e-12f));
        _Pragma("unroll") for (int hq = 0; hq < 2; ++hq) { f32x4 o_kk, o_w, o_kp, o_bb, o_r, o_v;
            _Pragma("unroll") for (int q = 0; q < 4; ++q) { const int e = 4 * hq + q; const float a = (float)a8[e]; const float kk = kr[e] * inrm;
                o_kk[q] = kk; o_w[q] = (float)d8[e]; o_kp[q] = kx[e] * (1.f + (a - 1.f) * k_a[col + e]); o_bb[q] = kk * a; o_r[q] = rr[e]; o_v[q] = vv[e]; }
            const int o = s_ * 64 + ch + 4 * hq;
            *(f32x4*)(bf + o) = o_kk; *(f32x4*)(bf + 2048 + o) = o_w; *(f32x4*)(bf + 4096 + o) = o_kp; *(f32x4*)(bf + 6144 + o) = o_bb; *(f32x4*)(bf + 8192 + o) = o_r; *(f32x4*)(bf + 10240 + o) = o_v; }
    };
    auto finish = [&](int chunk) {
        const float* bf = base + (chunk & 1) * 6 * 2048; const float* yb = base + 12 * 2048 + (chunk & 1) * 2048; const int m = b * T + chunk * 32 + s_;
        float y[8], rv[8], pv[8], vv[8]; float sum = 0.f, bs = 0.f;
        _Pragma("unroll") for (int hq = 0; hq < 2; ++hq) { const int o = s_ * 64 + ch + 4 * hq; const f32x4 y4 = *(const f32x4*)(yb + o), r4 = *(const f32x4*)(bf + 8192 + o), p4 = *(const f32x4*)(bf + 4096 + o), v4 = *(const f32x4*)(bf + 10240 + o);
            _Pragma("unroll") for (int q = 0; q < 4; ++q) { y[4 * hq + q] = y4[q]; rv[4 * hq + q] = r4[q]; pv[4 * hq + q] = p4[q]; vv[4 * hq + q] = v4[q]; } }
        _Pragma("unroll") for (int q = 0; q < 8; ++q) { sum += y[q]; bs += rv[q] * pv[q] * r_k[col + q]; }
        const float mean = red8(sum) * (1.f / 64.f); bs = red8(bs);
        float vs = 0.f; _Pragma("unroll") for (int q = 0; q < 8; ++q) { const float d = y[q] - mean; vs += d * d; }
        const float rstd = rsqf_(red8(vs) * (1.f / 64.f) + 64e-5f);
        const half8 g8 = *(const half8*)(GG + (size_t)m * 512 + col); half8 o;
        _Pragma("unroll") for (int q = 0; q < 8; ++q) o[q] = (h16)((((y[q] - mean) * rstd * ln_w[col + q] + ln_b[col + q]) + bs * vv[q]) * (float)g8[q]);
        *(half8*)(MIX + (size_t)m * D + 256 + col) = o;
    };
    __syncthreads();
    if (w >= 4) stage(0);
    __syncthreads();
    for (int i = 0; i <= 64; ++i) {
        if (w < 4) {
            if (i < 64) {
                const float* bf = base + (i & 1) * 6 * 2048; float* yb = base + 12 * 2048 + (i & 1) * 2048;
#pragma unroll 2
                for (int s = 0; s < 32; ++s) {
                    const float* p = bf + s * 64 + j0;
                    const f32x4 ka = *(const f32x4*)(p), kb = *(const f32x4*)(p + 4);
                    const f32x4 wa = *(const f32x4*)(p + 2048), wb = *(const f32x4*)(p + 2048 + 4);
                    const f32x4 pa = *(const f32x4*)(p + 4096), pb = *(const f32x4*)(p + 4096 + 4);
                    const f32x4 ba = *(const f32x4*)(p + 6144), bb = *(const f32x4*)(p + 6144 + 4);
                    const f32x4 ra = *(const f32x4*)(p + 8192), rb = *(const f32x4*)(p + 8192 + 4);
                    const float v0 = bf[10240 + s * 64 + i0], v1 = bf[10240 + s * 64 + i0 + 1];
                    float sa0 = 0.f, sb0 = 0.f, sa1 = 0.f, sb1 = 0.f;
                    _Pragma("unroll") for (int q = 0; q < 4; ++q) { sa0 += S0[q] * ka[q]; sb0 += S0[4 + q] * kb[q]; sa1 += S1[q] * ka[q]; sb1 += S1[4 + q] * kb[q]; }
                    sa0 = red8(sa0 + sb0); sa1 = red8(sa1 + sb1);
                    float ya0 = 0.f, yb0 = 0.f, ya1 = 0.f, yb1 = 0.f;
                    _Pragma("unroll") for (int q = 0; q < 4; ++q) {
                        S0[q] = S0[q] * wa[q] + (v0 * pa[q] - sa0 * ba[q]); S0[4 + q] = S0[4 + q] * wb[q] + (v0 * pb[q] - sa0 * bb[q]);
                        S1[q] = S1[q] * wa[q] + (v1 * pa[q] - sa1 * ba[q]); S1[4 + q] = S1[4 + q] * wb[q] + (v1 * pb[q] - sa1 * bb[q]);
                        ya0 += S0[q] * ra[q]; yb0 += S0[4 + q] * rb[q]; ya1 += S1[q] * ra[q]; yb1 += S1[4 + q] * rb[q]; }
                    const float y0 = red8(ya0 + yb0), y1 = red8(ya1 + yb1);
                    if (cc == 0) { yb[s * 64 + i0] = y0; yb[s * 64 + i0 + 1] = y1; }
                }
            }
        } else {
            if (i > 0) finish(i - 1);
            if (i + 1 < 64) stage(i + 1);
        }
        __syncthreads();
    }
}

DI void phase_cmp2(const Ctx& c, int l) {
    const h16* HID = c.W<h16>(WS_HID); const float* w2 = c.inl(I_NW2, l, 2 * 256 * 64); const float* nkg = c.inl(I_NKG, l, 64);
    const int lane = c.lane; const bool hi = lane >= 32; const float inv = powf(10000.f, -(float)(lane & 31) * (1.f / 32.f));
    for (int it = c.gw; it < 2 * 1024; it += c.ngw) { const int j = it >> 10, rrow = it & 1023, b = rrow >> 7, n = rrow & 127;
        float acc = 0.f;
        if (n < 127) { const h16* hr = HID + ((size_t)j * 1024 + rrow) * 256; const float* wj = w2 + (size_t)j * 256 * 64;
            for (int k = 0; k < 256; k += 8) { const half8 hv = *(const half8*)(hr + k); _Pragma("unroll") for (int q = 0; q < 8; ++q) acc += (float)hv[q] * wj[(k + q) * 64 + lane]; } }
        if (j == 0) { const float ss = wave_sum(acc * acc); float y = acc * rsqf_(ss * (1.f / 64.f) + 1e-6f) * nkg[lane];
            const float ang = (float)(16 * n + 31) * inv; const float cs = cosf(ang), sn = sinf(ang); const float o = __shfl_xor(y, 32); y = hi ? y * cs + o * sn : y * cs - o * sn;
            c.W<h16>(WS_KCMP)[((size_t)b * 128 + n) * 64 + lane] = (h16)(n < 127 ? y : 0.f); }
        else c.W<h16>(WS_VCMPT)[((size_t)b * 64 + lane) * 128 + n] = (h16)acc; }
}

__global__ void __launch_bounds__(NTHREADS) fwd_kernel(Params p) {
    extern __shared__ __attribute__((aligned(16))) char lds[];
    cg::grid_group grid = cg::this_grid();
    Ctx c; c.out = p.out; c.ws = p.ws; c.lds = lds; c.ctl = (unsigned*)(p.ws + WS_CTL);
    c.wave = __builtin_amdgcn_readfirstlane(threadIdx.x >> 6); c.lane = lane_id(); c.tid = c.wave * 64 + c.lane; c.gw = blockIdx.x * 8 + c.wave; c.ngw = gridDim.x * 8;
    if (c.tid < 28) ((const float**)(p.ws + WS_PTRS))[c.tid] = p.in[c.tid];
    unsigned* xbar = c.ctl + 4096;
    if (c.tid == 0) { s_xb[0] = 0u; s_xb[1] = 0u; (void)xb_add(&xbar[XB_XCNT(xb_xcc_id())], 1u); }
    __threadfence(); __syncthreads();
#define GSYNC() do { xcd_barrier(c.ctl + 4096, c.tid); PH(); } while (0)
    h16* ACT = c.W<h16>(WS_ACT); h16* Z = c.W<h16>(WS_Z);

#define PH() do { c.ws = launder_ptr(c.ws); c.out = launder_ptr(c.out); c.lane = lane_id(); asm volatile("" : "+v"(c.lane)); c.tid = c.wave * 64 + c.lane; c.gw = blockIdx.x * 8 + c.wave; } while (0)
    phase_mod(c);
#pragma unroll 1
    for (int l = 0; l < DEPTH; ++l) {
        const float* mod_l = c.W<float>(WS_MOD) + (size_t)l * 8 * 6144;
        PH(); convert_weights(c, l);
        PH(); phase_cbias(c, l);
        if (l == 0) grid.sync();
        PH();
        phase_norm(c, l == 0 ? c.inp(I_X) : c.out, c.inl(I_N1G, l, D), mod_l, 0, 1024);
        GSYNC();
        phase_gemm(c, ACT, D, c.W<h16>(WS_WIN), D, D, 64, 13, EpiZ{Z, ZC});
        GSYNC();
        phase_prep(c, l);
        GSYNC();
        {
            unsigned* ctr = c.ctl + 16 * (2 * l);
            for (;;) { const int it = next_item(ctr, c.tid); if (it >= 8 + 384 + 1024) break; PH();
                if (it < 8) { const int j = it >> 2, pm = it & 3;
                    gemm_unit(c.tid, c.W<h16>(j ? WS_VC : WS_KC), 1024, c.W<h16>(WS_W1) + (size_t)j * 256 * 2048, 2048, 2048, pm * 256, 0, (h16*)lds, EpiCmp{c.W<h16>(WS_HID) + (size_t)j * 1024 * 256, c.W<float>(WS_CBIAS) + j * 256}); }
                else if (it < 392) { const int u = it - 8, pm = u / 6, pn = u % 6;
                    gemm_unit(c.tid, c.W<h16>(WS_L16), 256, c.W<h16>(WS_WL), 256, 256, pm * 256, pn * 256, (h16*)lds, EpiLora{c.W<h16>(WS_DEC), c.W<h16>(WS_A), c.W<h16>(WS_G), c.inl(I_W0, l, 512), c.inl(I_A0, l, 512)}); }
                else dsa_select_item(c, 1023 - (it - 392)); }
        }
        GSYNC();
        phase_cmp2(c, l);
        GSYNC();
        {
            unsigned* ctr = c.ctl + 16 * (2 * l + 1);
            for (;;) { const int it = next_item(ctr, c.tid); if (it >= 64 + 512) break; PH();
                if (it < 64) rwkv_item(c, l, it);
                else { const int a = it - 64; const int kind = a >> 8, idx = 255 - (a & 255); const int b = idx & 7, qb = idx >> 3; const int t0 = qb * 64 + c.wave * 8;
                    if (kind == 0) nsa_attn_wave(c, b, t0); else dsa_attn_wave(c, b, t0); } }
        }
        GSYNC();
        phase_gemm(c, ACT, D, c.W<h16>(WS_WOUT), D, D, 64, 4, EpiRes{l == 0 ? c.inp(I_X) : c.out, c.out, mod_l + 2048});
        GSYNC();
        phase_norm(c, c.out, c.inl(I_N2G, l, D), mod_l, 3072, 4096);
        GSYNC();
        phase_gemm(c, ACT, D, c.W<h16>(WS_WI), D, D, 64, 22, EpiSwiglu{Z});
        GSYNC();
        phase_gemm(c, Z, FF, c.W<h16>(WS_WO), FF, FF, 64, 4, EpiRes{c.out, c.out, mod_l + 5120});
        GSYNC();
    }
}

extern "C" void kernel_launch(void* const* d_in, const int* in_sizes, int n_in, void* d_out, int out_size, void* d_ws, size_t ws_size, hipStream_t stream) {
    static int grid_blocks = 0;
    if (grid_blocks == 0) {
        if (n_in != 28 || ws_size < WS_END) { fprintf(stderr, "kernel_launch: unexpected n_in %d / ws %zu\n", n_in, ws_size); grid_blocks = -1; return; }
        int dev = 0, cus = 0, per_cu = 0;
        hipGetDevice(&dev); hipDeviceGetAttribute(&cus, hipDeviceAttributeMultiprocessorCount, dev);
        hipFuncSetAttribute((const void*)fwd_kernel, hipFuncAttributeMaxDynamicSharedMemorySize, LDS_BYTES);
        hipOccupancyMaxActiveBlocksPerMultiprocessor(&per_cu, (const void*)fwd_kernel, NTHREADS, LDS_BYTES);
        if (per_cu < 1) { fprintf(stderr, "kernel_launch: occupancy query says %d blocks/CU\n", per_cu); per_cu = 1; }
        grid_blocks = cus * 1;
    }
    if (grid_blocks < 0) return;
    hipMemsetAsync((char*)d_ws + WS_CTL, 0, 64 * 1024, stream);
    Params p{};
    for (int i = 0; i < 28; ++i) p.in[i] = (const float*)d_in[i];
    p.out = (float*)d_out; p.ws = (unsigned char*)d_ws;
    void* args[] = {&p};
    hipError_t e = hipLaunchCooperativeKernel((const void*)fwd_kernel, dim3(grid_blocks), dim3(NTHREADS), args, LDS_BYTES, stream);
    if (e != hipSuccess) fprintf(stderr, "cooperative launch failed: %s (grid %d)\n", hipGetErrorString(e), grid_blocks);
}
```

```cpp
#include <hip/hip_runtime.h>
#include <hip/hip_cooperative_groups.h>
#include <cstdio>
#include <cstdint>
namespace cg = cooperative_groups;

typedef _Float16 h16;
typedef _Float16 half8 __attribute__((ext_vector_type(8)));
typedef _Float16 half4 __attribute__((ext_vector_type(4)));
typedef float f32x4 __attribute__((ext_vector_type(4)));
typedef float f32x16 __attribute__((ext_vector_type(16)));
#define LAS __attribute__((address_space(3)))
#define DI __device__ __forceinline__

constexpr int D = 1024, NB = 8, T = 2048, M = NB * T, FF = 2816, DEPTH = 2;
constexpr int ZC = 3328;
constexpr int C_QA = 0, C_KA = 256, C_VA = 320, C_IQ = 384, C_IK = 640, C_IW = 704;
constexpr int C_R = 768, C_K = 1280, C_V = 1792, C_WD = 2304;
constexpr int C_QC = 2560, C_KC = 2816, C_VC = 2880, C_KS = 2944, C_VS = 3008, C_KW = 3072, C_VW = 3136, C_GC = 3200;
constexpr int NTHREADS = 512;
constexpr int LDS_BYTES = 139264;

constexpr size_t MiB = 1u << 20;
constexpr size_t WS_CTL = 0;
constexpr size_t WS_PTRS = 60 * 1024;
constexpr size_t WS_MOD = 64 * 1024;
constexpr size_t WS_CBIAS = 512 * 1024;
constexpr size_t WS_KCMP = 1 * MiB;
constexpr size_t WS_VCMPT = 1 * MiB + 128 * 1024;
constexpr size_t WS_HID = 2 * MiB;
constexpr size_t WS_KA = 4 * MiB, WS_IK = 6 * MiB, WS_KS = 8 * MiB, WS_KW = 10 * MiB;
constexpr size_t WS_VAT = 12 * MiB, WS_VST = 14 * MiB, WS_VWT = 16 * MiB;
constexpr size_t WS_DMASK = 18 * MiB;
constexpr size_t WS_WIN = 22 * MiB;
constexpr size_t WS_WOUT = WS_WIN + 6656 * 1024;
constexpr size_t WS_WI = WS_WOUT + 2 * MiB;
constexpr size_t WS_WO = WS_WI + 11 * MiB;
constexpr size_t WS_W1 = WS_WO + 5632 * 1024;
constexpr size_t WS_WL = WS_W1 + 2 * MiB;
constexpr size_t WS_ACT = 50 * MiB;
constexpr size_t WS_L16 = WS_ACT, WS_KC = WS_ACT + 8 * MiB, WS_VC = WS_ACT + 12 * MiB;
constexpr size_t WS_DEC = 82 * MiB, WS_A = 98 * MiB, WS_G = 114 * MiB;
constexpr size_t WS_Z = 130 * MiB;
constexpr size_t WS_END = 234 * MiB;
static_assert(WS_WL + 768 * 1024 <= WS_ACT, "weights fit");

struct Params { const float* in[28]; float* out; unsigned char* ws; };
enum { I_X = 0, I_C, I_ADAW, I_ADAB, I_N1G, I_WIN, I_DQG, I_DKG, I_MU, I_W0, I_W2, I_A0, I_A2, I_G2, I_KK, I_KA, I_RK, I_LNW, I_LNB,
       I_NQG, I_NKG, I_PE, I_NW1, I_NW2, I_WOUT, I_N2G, I_FWI, I_FWO };

template <int CTRL> DI float dpp_f(float x) { return __builtin_bit_cast(float, __builtin_amdgcn_update_dpp(0, __builtin_bit_cast(int, x), CTRL, 0xF, 0xF, true)); }
DI float quad_sum(float x) { x += dpp_f<0xB1>(x); x += dpp_f<0x4E>(x); return x; }
DI float red8(float x) { x += dpp_f<0xB1>(x); x += dpp_f<0x4E>(x); x += dpp_f<0x141>(x); return x; }
DI float red16(float x) { x += __shfl_xor(x, 1); x += __shfl_xor(x, 2); x += __shfl_xor(x, 4); x += __shfl_xor(x, 8); return x; }
DI float wave_sum(float x) { for (int o = 1; o < 64; o <<= 1) x += __shfl_xor(x, o); return x; }
DI float rcpf_(float x) { return __builtin_amdgcn_rcpf(x); }
DI float rsqf_(float x) { return __builtin_amdgcn_rsqf(x); }
DI float sigmoidf_(float x) { return rcpf_(1.f + __expf(-x)); }
DI int crow(int i, int h) { return (i & 3) + 8 * (i >> 2) + 4 * h; }
#define WSYNC() asm volatile("s_waitcnt lgkmcnt(0)" ::: "memory")
#define MFMA32(a, b, c) __builtin_amdgcn_mfma_f32_32x32x16_f16((a), (b), (c), 0, 0, 0)

template <class Tp> DI Tp* launder_ptr(Tp* p) {
    unsigned lo = (unsigned)(uintptr_t)p, hi = (unsigned)((uintptr_t)p >> 32); asm volatile("" : "+v"(lo), "+v"(hi));
    lo = __builtin_amdgcn_readfirstlane(lo); hi = __builtin_amdgcn_readfirstlane(hi); return (Tp*)(((uintptr_t)hi << 32) | lo); }
DI int lane_id() { return (int)__builtin_amdgcn_mbcnt_hi(~0u, __builtin_amdgcn_mbcnt_lo(~0u, 0u)); }
__shared__ int s_item;
DI int next_item(unsigned* ctr, int tid) {
    __syncthreads();
    if (tid == 0) s_item = (int)atomicAdd(ctr, 1u);
    __syncthreads();
    return s_item;
}


#define XB_TMO      128
#define XB_XCNT(j)  (256  + 64 * (j))
#define XB_XSUB(j)  (1280 + 64 * (j))
#define XB_XGEN(j)  (2304 + 64 * (j))
#define XB_TOP      3328
#define XB_TOPGEN   3392
#define XB_SPIN_CAP (1u << 22)
DI unsigned xb_ld(unsigned* p) { return __hip_atomic_load(p, __ATOMIC_RELAXED, __HIP_MEMORY_SCOPE_AGENT); }
DI unsigned xb_add(unsigned* p, unsigned v) { return __hip_atomic_fetch_add(p, v, __ATOMIC_RELAXED, __HIP_MEMORY_SCOPE_AGENT); }
DI unsigned xb_xcc_id() { return (unsigned)__builtin_amdgcn_s_getreg((3 << 11) | 20) & 0xFu; }
#define XB_SPIN(cond, bar) do { unsigned _sp = 0; while (cond) { __builtin_amdgcn_s_sleep(1); \
    if ((++_sp & 255u) == 0u) { if (xb_ld(&(bar)[XB_TMO])) break; if (_sp > XB_SPIN_CAP) { atomicAdd(&(bar)[XB_TMO], 1u); break; } } } } while (0)
__shared__ unsigned s_xb[2];
DI void xcd_barrier_complete(unsigned* bar, unsigned x, unsigned& nloc, unsigned& nx) {
    const unsigned G = gridDim.x; unsigned sum, cnt, mine, sp = 0u;
    for (;;) { sum = 0u; cnt = 0u; mine = 0u;
        _Pragma("unroll") for (unsigned j = 0; j < 16; ++j) { const unsigned c = xb_ld(&bar[XB_XCNT(j)]); sum += c; cnt += (c > 0u) ? 1u : 0u; mine = (j == x) ? c : mine; }
        if (sum == G) break;
        __builtin_amdgcn_s_sleep(1);
        if ((++sp & 255u) == 0u) { if (xb_ld(&bar[XB_TMO])) break; if (sp > XB_SPIN_CAP) { atomicAdd(&bar[XB_TMO], 1u); break; } } }
    nloc = mine > 0u ? mine : 1u; nx = cnt > 0u ? cnt : 1u;
}
DI void xcd_barrier(unsigned* bar, int tid) {
    asm volatile("s_waitcnt vmcnt(0)" ::: "memory");
    __syncthreads();
    if (tid == 0) {
        __builtin_amdgcn_s_waitcnt(0);
        const unsigned x = xb_xcc_id();
        unsigned nloc = s_xb[0], nx = s_xb[1];
        if (nloc == 0u) { xcd_barrier_complete(bar, x, nloc, nx); s_xb[0] = nloc; s_xb[1] = nx; }
        const unsigned old = xb_add(&bar[XB_XSUB(x)], 1u);
        const unsigned gen = old / nloc;
        if (old + 1u == (gen + 1u) * nloc) {
            __builtin_amdgcn_fence(__ATOMIC_RELEASE, "agent");
            asm volatile("s_waitcnt vmcnt(0)" ::: "memory");
            const unsigned og = xb_add(&bar[XB_TOP], 1u);
            const unsigned tg = og / nx;
            if (og + 1u == (tg + 1u) * nx) xb_add(&bar[XB_TOPGEN], 1u);
            else XB_SPIN(xb_ld(&bar[XB_TOPGEN]) == tg, bar);
            __builtin_amdgcn_fence(__ATOMIC_ACQUIRE, "agent");
            xb_add(&bar[XB_XGEN(x)], 1u);
            asm volatile("s_waitcnt vmcnt(0)" ::: "memory");
        } else {
            XB_SPIN(xb_ld(&bar[XB_XGEN(x)]) == gen, bar);
            __builtin_amdgcn_fence(__ATOMIC_ACQUIRE, "agent");
            asm volatile("s_waitcnt vmcnt(0)" ::: "memory");
        }
    }
    __syncthreads();
}

constexpr int BK = 64, HALF = 128, HT = HALF * BK;
DI void stage_rc(int b, int& R, int& C) { int st = b / 1024, sb = b % 1024, swz = sb ^ (((sb >> 9) & 1) << 5); R = (st >> 1) * 16 + swz / 64; C = (st & 1) * 32 + (swz % 64) / 2; }

template <class Epi>
DI void gemm_unit(int tid_in, const h16* __restrict__ A, int lda, const h16* __restrict__ Bt, int ldb, int K, int brow, int bcol, h16* shm, const Epi& epi) {
#define SA(b, h) (shm + ((b) * 2 + (h)) * HT)
#define SB(b, h) (shm + (4 + (b) * 2 + (h)) * HT)
#define STAGE_A(P, br, kt) do { const char* _g = (const char*)(A + ((long)(br) * lda + (long)(kt) * BK)); \
    __builtin_amdgcn_global_load_lds((const unsigned*)(_g + oa0), (LAS unsigned*)((char*)(P) + tidx * 16), 16, 0, 0); \
    __builtin_amdgcn_global_load_lds((const unsigned*)(_g + (size_t)lda * 128 + oa0), (LAS unsigned*)((char*)(P) + tidx * 16 + 8192), 16, 0, 0); } while (0)
#define STAGE_B(P, br, kt) do { const char* _g = (const char*)(Bt + ((long)(br) * ldb + (long)(kt) * BK)); \
    __builtin_amdgcn_global_load_lds((const unsigned*)(_g + ob0), (LAS unsigned*)((char*)(P) + tidx * 16), 16, 0, 0); \
    __builtin_amdgcn_global_load_lds((const unsigned*)(_g + (size_t)ldb * 128 + ob0), (LAS unsigned*)((char*)(P) + tidx * 16 + 8192), 16, 0, 0); } while (0)
#define LDA(dst, b, h) _Pragma("unroll") for (int m = 0; m < 4; ++m) _Pragma("unroll") for (int k = 0; k < 2; ++k) dst[m][k] = *reinterpret_cast<const half8*>((char*)SA(b, h) + la + (m * 2 + k) * 1024)
#define LDB(dst, b, h) _Pragma("unroll") for (int n = 0; n < 2; ++n) _Pragma("unroll") for (int k = 0; k < 2; ++k) dst[n][k] = *reinterpret_cast<const half8*>((char*)SB(b, h) + lb + (n * 2 + k) * 1024)
#define MMA(ai, bj, At_, Bt_) do { __builtin_amdgcn_s_setprio(1); \
    _Pragma("unroll") for (int m = 0; m < 4; ++m) _Pragma("unroll") for (int n = 0; n < 2; ++n) _Pragma("unroll") for (int k = 0; k < 2; ++k) \
        acc[ai][bj][m][n] = __builtin_amdgcn_mfma_f32_16x16x32_f16(Bt_[n][k], At_[m][k], acc[ai][bj][m][n], 0, 0, 0); \
    __builtin_amdgcn_s_setprio(0); } while (0)
#define WAIT_V(n) asm volatile("s_waitcnt vmcnt(" #n ")" ::: "memory")
#define WAIT_L(n) asm volatile("s_waitcnt lgkmcnt(" #n ")" ::: "memory")
#define BAR __builtin_amdgcn_s_barrier()
#define SCHED __builtin_amdgcn_sched_barrier(0)
    int tidx = tid_in; asm volatile("" : "+v"(tidx));
    const int wid = tidx >> 6, lane = tidx & 63, wr = wid >> 2, wc = wid & 3, fr = lane & 15, fq = lane >> 4;
    const int lpart = ((fr * 64 + fq * 16) ^ ((fr >> 3) << 5));
    const int la = wr * 8192 + lpart, lb = wc * 4096 + lpart;
    unsigned oa0, ob0;
    { int _r, _c; stage_rc(tidx * 16, _r, _c); oa0 = (unsigned)(_r * lda + _c) * 2u; ob0 = (unsigned)(_r * ldb + _c) * 2u; }
    f32x4 acc[2][2][4][2] = {};
    half8 At[4][2], B0[2][2], B1[2][2];
    const int nt = K / BK;
    STAGE_B(SB(0, 0), bcol, 0); STAGE_A(SA(0, 0), brow, 0);
    STAGE_B(SB(0, 1), bcol + HALF, 0); STAGE_A(SA(0, 1), brow + HALF, 0);
    if (wr == 1) BAR;
    WAIT_V(4); BAR;
    STAGE_B(SB(1, 0), bcol, 1); STAGE_A(SA(1, 0), brow, 1); STAGE_B(SB(1, 1), bcol + HALF, 1);
    WAIT_V(6); BAR;
    for (int t = 0; t < nt - 2; t += 2) {
        LDB(B0, 0, 0); SCHED; LDA(At, 0, 0); STAGE_A(SA(1, 1), brow + HALF, t + 1);
        WAIT_L(8); BAR; WAIT_L(0); MMA(0, 0, At, B0); BAR; SCHED;
        LDB(B1, 0, 1); STAGE_B(SB(0, 0), bcol, t + 2);
        BAR; WAIT_L(0); MMA(0, 1, At, B1); BAR;
        LDA(At, 0, 1); STAGE_A(SA(0, 0), brow, t + 2);
        BAR; WAIT_L(0); MMA(1, 0, At, B0); BAR; SCHED;
        STAGE_B(SB(0, 1), bcol + HALF, t + 2);
        WAIT_V(6); BAR; MMA(1, 1, At, B1); BAR;
        LDB(B0, 1, 0); SCHED; LDA(At, 1, 0); STAGE_A(SA(0, 1), brow + HALF, t + 2);
        WAIT_L(8); BAR; WAIT_L(0); MMA(0, 0, At, B0); BAR; SCHED;
        LDB(B1, 1, 1); STAGE_B(SB(1, 0), bcol, t + 3);
        BAR; WAIT_L(0); MMA(0, 1, At, B1); BAR;
        LDA(At, 1, 1); STAGE_A(SA(1, 0), brow, t + 3);
        BAR; WAIT_L(0); MMA(1, 0, At, B0); BAR; SCHED;
        STAGE_B(SB(1, 1), bcol + HALF, t + 3);
        WAIT_V(6); BAR; MMA(1, 1, At, B1); BAR;
    }
    { LDB(B0, 0, 0); LDA(At, 0, 0); STAGE_A(SA(1, 1), brow + HALF, nt - 1);
      BAR; WAIT_L(0); MMA(0, 0, At, B0); BAR;
      LDB(B1, 0, 1); BAR; WAIT_L(0); MMA(0, 1, At, B1); BAR;
      LDA(At, 0, 1); WAIT_V(4); BAR; WAIT_L(0); MMA(1, 0, At, B0); MMA(1, 1, At, B1); BAR; }
    { LDB(B0, 1, 0); LDA(At, 1, 0); WAIT_V(2); BAR; WAIT_L(0); MMA(0, 0, At, B0); BAR;
      LDB(B1, 1, 1); WAIT_V(0); BAR; WAIT_L(0); MMA(0, 1, At, B1); BAR;
      LDA(At, 1, 1); BAR; WAIT_L(0); MMA(1, 0, At, B0); MMA(1, 1, At, B1); BAR; }
    if (wr == 0) BAR;
    epi(acc, brow + wr * 64 + fr, bcol + wc * 32 + fq * 4);
    __syncthreads();
}
DI bool unit_order(int L, int nM, int nN, int& pm, int& pn) {
    const int nwg = nM * nN; if (L >= nwg) return false;
    int wgid = L; { const int q = nwg / 8, r = nwg % 8, xcd = wgid % 8, off = wgid / 8; wgid = (xcd < r ? xcd * (q + 1) : r * (q + 1) + (xcd - r) * q) + off; }
    const int nig = 8 * nN, gid = wgid / nig, fm = gid * 8, gsz = (nM - fm) < 8 ? (nM - fm) : 8;
    pm = fm + ((wgid % nig) % gsz); pn = (wgid % nig) / gsz; return true;
}
typedef f32x4 Acc[2][2][4][2];
#define EPI_LOOP _Pragma("unroll") for (int ai = 0; ai < 2; ++ai) _Pragma("unroll") for (int bj = 0; bj < 2; ++bj) _Pragma("unroll") for (int m = 0; m < 4; ++m) _Pragma("unroll") for (int n = 0; n < 2; ++n)
struct EpiZ { h16* z; int ld;
    DI void operator()(Acc& acc, int r0, int c0) const { EPI_LOOP { const int row = r0 + ai * 128 + m * 16, col = c0 + bj * 128 + n * 16;
        half4 v; _Pragma("unroll") for (int j = 0; j < 4; ++j) v[j] = (h16)acc[ai][bj][m][n][j]; *(half4*)(z + (size_t)row * ld + col) = v; } } };
struct EpiLora { h16 *dec, *a, *g; const float *w0, *a0;
    DI void operator()(Acc& acc, int r0, int c0) const { EPI_LOOP { const int row = r0 + ai * 128 + m * 16, col = c0 + bj * 128 + n * 16; half4 v;
        if (col < 512) { _Pragma("unroll") for (int j = 0; j < 4; ++j) { const float lw = w0[col + j] + acc[ai][bj][m][n][j]; v[j] = (h16)__expf(-0.60653066f * sigmoidf_(lw)); } *(half4*)(dec + (size_t)row * 512 + col) = v; }
        else if (col < 1024) { _Pragma("unroll") for (int j = 0; j < 4; ++j) v[j] = (h16)sigmoidf_(a0[col - 512 + j] + acc[ai][bj][m][n][j]); *(half4*)(a + (size_t)row * 512 + col - 512) = v; }
        else { _Pragma("unroll") for (int j = 0; j < 4; ++j) v[j] = (h16)acc[ai][bj][m][n][j]; *(half4*)(g + (size_t)row * 512 + col - 1024) = v; } } } };
struct EpiCmp { h16* hid; const float* bias;
    DI void operator()(Acc& acc, int r0, int c0) const { EPI_LOOP { const int row = r0 + ai * 128 + m * 16, col = c0 + bj * 128 + n * 16; half4 v;
        _Pragma("unroll") for (int j = 0; j < 4; ++j) { const float x = acc[ai][bj][m][n][j] + bias[col + j]; const float u = 0.7978845608f * (x + 0.044715f * x * x * x);
            const float th = 1.f - 2.f * rcpf_(1.f + __expf(2.f * u)); v[j] = (h16)(0.5f * x * (1.f + th)); }
        *(half4*)(hid + (size_t)row * 256 + col) = v; } } };
struct EpiRes { const float* xin; float* xout; const float* gate;
    DI void operator()(Acc& acc, int r0, int c0) const { EPI_LOOP { const int row = r0 + ai * 128 + m * 16, col = c0 + bj * 128 + n * 16;
        const f32x4 xi = *(const f32x4*)(xin + (size_t)row * D + col); const f32x4 gg = *(const f32x4*)(gate + (size_t)(row >> 11) * 6144 + col);
        f32x4 o; _Pragma("unroll") for (int j = 0; j < 4; ++j) o[j] = xi[j] + gg[j] * acc[ai][bj][m][n][j]; *(f32x4*)(xout + (size_t)row * D + col) = o; } } };
struct EpiSwiglu { h16* hid;
    DI void operator()(Acc& acc, int r0, int c0) const { _Pragma("unroll") for (int ai = 0; ai < 2; ++ai) _Pragma("unroll") for (int m = 0; m < 4; ++m) _Pragma("unroll") for (int n = 0; n < 2; ++n) {
        const int row = r0 + ai * 128 + m * 16; const int tcol = c0 & 255, pn = c0 >> 8; const int col = pn * 128 + tcol + n * 16; half4 v;
        _Pragma("unroll") for (int j = 0; j < 4; ++j) { const float gt = acc[ai][0][m][n][j], up = acc[ai][1][m][n][j]; v[j] = (h16)(gt * sigmoidf_(gt) * up); }
        *(half4*)(hid + (size_t)row * FF + col) = v; } } };

struct Ctx {
    float* out; unsigned char* ws; char* lds; unsigned* ctl;
    int tid, lane, wave, gw, ngw;
    template <class Tp> DI Tp* W(size_t off) const { return (Tp*)(ws + off); }
    DI const float* inp(int i) const { const unsigned* t = (const unsigned*)(ws + WS_PTRS) + 2 * i;
        const unsigned lo = __builtin_amdgcn_readfirstlane(t[0]), hi = __builtin_amdgcn_readfirstlane(t[1]); return (const float*)(((uintptr_t)hi << 32) | lo); }
    DI const float* inl(int i, int l, size_t per_layer) const { return inp(i) + (size_t)l * per_layer; }
};

template <class CM>
DI void tr_item(const float* __restrict__ Wsrc, int K, int Nsrc, h16* WT, int k0, int n0, float* scr, int lane, CM cm) {
    const int sc = cm(n0 + (lane & 31));
#pragma unroll 8
    for (int i = 0; i < 32; ++i) { const int kk = 2 * i + (lane >> 5); scr[kk * 33 + (lane & 31)] = sc >= 0 ? Wsrc[(size_t)(k0 + kk) * Nsrc + sc] : 0.f; }
    WSYNC();
    const int c = lane & 7;
#pragma unroll
    for (int j = 0; j < 4; ++j) { const int n = (lane >> 3) + 8 * j; const float* s = scr + (8 * c) * 33 + n; half8 o;
        _Pragma("unroll") for (int q = 0; q < 8; ++q) o[q] = (h16)s[q * 33];
        *(half8*)(WT + (size_t)(n0 + n) * K + k0 + 8 * c) = o; }
    WSYNC();
}
DI void convert_weights(const Ctx& c, int l) {
    float* scr = (float*)(c.lds + c.wave * 8448);
    constexpr int I_IN = 16 * 104, I_OUT = 16 * 32, I_FI = 16 * 176, I_FO = 44 * 32, I_W1 = 32 * 8;
    constexpr int NIT = I_IN + I_OUT + I_FI + I_FO + 2 * I_W1;
    for (int it = c.gw; it < NIT; it += c.ngw) {
        int r = it;
        if (r < I_IN) { tr_item(c.inl(I_WIN, l, (size_t)D * 3152), D, 3152, c.W<h16>(WS_WIN), (r / 104) * 64, (r % 104) * 32, scr, c.lane,
                                [](int n) { return n < 708 ? n : (n < 768 ? -1 : (n < 3212 ? n - 60 : -1)); }); continue; } r -= I_IN;
        if (r < I_OUT) { tr_item(c.inl(I_WOUT, l, (size_t)D * D), D, D, c.W<h16>(WS_WOUT), (r / 32) * 64, (r % 32) * 32, scr, c.lane, [](int n) { return n; }); continue; } r -= I_OUT;
        if (r < I_FI) { tr_item(c.inl(I_FWI, l, (size_t)D * 2 * FF), D, 2 * FF, c.W<h16>(WS_WI), (r / 176) * 64, (r % 176) * 32, scr, c.lane,
                                [](int n) { const int pn = n >> 8, q = n & 255; return q < 128 ? pn * 128 + q : FF + pn * 128 + (q - 128); }); continue; } r -= I_FI;
        if (r < I_FO) { tr_item(c.inl(I_FWO, l, (size_t)FF * D), FF, D, c.W<h16>(WS_WO), (r / 32) * 64, (r % 32) * 32, scr, c.lane, [](int n) { return n; }); continue; } r -= I_FO;
        const int j = r / I_W1; r %= I_W1;
        tr_item(c.inl(I_NW1, l, (size_t)2 * 2048 * 256) + (size_t)j * 2048 * 256, 2048, 256, c.W<h16>(WS_W1) + (size_t)j * 256 * 2048, (r / 8) * 64, (r % 8) * 32, scr, c.lane, [](int n) { return n; });
    }
    const float* w2 = c.inl(I_W2, l, 64 * 512); const float* a2 = c.inl(I_A2, l, 64 * 512); const float* g2 = c.inl(I_G2, l, 128 * 512);
    h16* wl = c.W<h16>(WS_WL);
    for (int e = blockIdx.x * NTHREADS + c.tid; e < 1536 * 256; e += gridDim.x * NTHREADS) {
        const int n = e >> 8, k = e & 255; float v = 0.f;
        if (n < 512) { if (k < 64) v = w2[k * 512 + n]; }
        else if (n < 1024) { if (k >= 64 && k < 128) v = a2[(k - 64) * 512 + n - 512]; }
        else { if (k >= 128) v = g2[(k - 128) * 512 + n - 1024]; }
        wl[e] = (h16)v;
    }
}
template <int NV>
DI void gemv_item(const Ctx& c, const float* aL, int K, const float* __restrict__ Wsrc, int N, int n0, const float* bias, float* out, int out_stride, float* red) {
    const int nl = c.tid & 31, kc = c.tid >> 5, kper = K / 16;
    float acc[NV]; for (int v = 0; v < NV; ++v) acc[v] = 0.f;
    for (int k = kc * kper; k < (kc + 1) * kper; ++k) { const float w = Wsrc[(size_t)k * N + n0 + nl]; for (int v = 0; v < NV; ++v) acc[v] += aL[v * K + k] * w; }
    for (int v = 0; v < NV; ++v) red[(kc * NV + v) * 32 + nl] = acc[v];
    __syncthreads();
    if (c.tid < 32 * NV) { const int v = c.tid >> 5; float s = bias ? bias[n0 + nl] : 0.f; _Pragma("unroll") for (int q = 0; q < 16; ++q) s += red[(q * NV + v) * 32 + nl]; out[(size_t)v * out_stride + n0 + nl] = s; }
    __syncthreads();
}
DI void phase_mod(const Ctx& c) {
    float* sil = (float*)(c.lds + 70000); float* red = (float*)(c.lds + 70000 + 32768);
    for (int e = c.tid; e < 8 * 1024; e += NTHREADS) { const float x = c.inp(I_C)[e]; sil[e] = x * sigmoidf_(x); }
    __syncthreads();
    for (int it = blockIdx.x; it < 2 * 192; it += gridDim.x) { const int l = it / 192, n0 = (it % 192) * 32;
        gemv_item<8>(c, sil, 1024, c.inl(I_ADAW, l, (size_t)1024 * 6144), 6144, n0, c.inl(I_ADAB, l, 6144), c.W<float>(WS_MOD) + (size_t)l * 8 * 6144, 6144, red); }
}
DI void phase_cbias(const Ctx& c, int l) {
    float* pe = (float*)(c.lds + 70000); float* red = (float*)(c.lds + 70000 + 32768);
    __syncthreads();
    for (int e = c.tid; e < 2 * 2048; e += NTHREADS) pe[e] = c.inl(I_PE, l, 2 * 2048)[e];
    __syncthreads();
    for (int it = (int)gridDim.x - 1 - (int)blockIdx.x; it < 16; it += gridDim.x) { const int j = it >> 3, n0 = (it & 7) * 32;
        gemv_item<1>(c, pe + j * 2048, 2048, c.inl(I_NW1, l, (size_t)2 * 2048 * 256) + (size_t)j * 2048 * 256, 256, n0, nullptr, c.W<float>(WS_CBIAS) + j * 256, 256, red); }
}
DI void phase_norm(const Ctx& c, const float* x, const float* g, const float* mod_l, int sh_off, int sc_off) {
    h16* act = c.W<h16>(WS_ACT);
    for (int m = c.gw; m < M; m += c.ngw) {
        const f32x4* xr = (const f32x4*)(x + (size_t)m * D) + c.lane; f32x4 v[4]; float s = 0.f;
        _Pragma("unroll") for (int j = 0; j < 4; ++j) { v[j] = xr[64 * j]; s += v[j].x * v[j].x + v[j].y * v[j].y + v[j].z * v[j].z + v[j].w * v[j].w; }
        const float rstd = rsqf_(wave_sum(s) * (1.f / D) + 1e-6f);
        const float* mb = mod_l + (size_t)(m >> 11) * 6144;
        _Pragma("unroll") for (int j = 0; j < 4; ++j) { const int col = 4 * c.lane + 256 * j; const f32x4 gg = *(const f32x4*)(g + col), sc = *(const f32x4*)(mb + sc_off + col), sh = *(const f32x4*)(mb + sh_off + col);
            half4 o; _Pragma("unroll") for (int q = 0; q < 4; ++q) o[q] = (h16)(v[j][q] * rstd * gg[q] * (1.f + sc[q]) + sh[q]);
            *(half4*)(act + (size_t)m * D + col) = o; }
    }
}
template <class Epi>
DI void phase_gemm(const Ctx& c, const h16* A, int lda, const h16* Bt, int ldb, int K, int nM, int nN, const Epi& epi) {
    for (int i = 0;; ++i) { int pm, pn; if (!unit_order(i * (int)gridDim.x + (int)blockIdx.x, nM, nN, pm, pn)) break;
        gemm_unit(c.tid, A, lda, Bt, ldb, K, pm * 256, pn * 256, (h16*)c.lds, epi); }
}

DI void phase_prep(const Ctx& c, int l) {
    h16* Z = c.W<h16>(WS_Z);
    const float* dqg = c.inl(I_DQG, l, 64); const float* dkg = c.inl(I_DKG, l, 64); const float* nqg = c.inl(I_NQG, l, 64); const float* nkg = c.inl(I_NKG, l, 64);
    const float* mu = c.inl(I_MU, l, 1792);
    const int lane = c.lane; const bool hi = lane >= 32;
    const float inv = powf(10000.f, -(float)(lane & 31) * (1.f / 32.f));
    const float g_dq = dqg[lane], g_dk = dkg[lane], g_nq = nqg[lane], g_nk = nkg[lane];
    for (int m = c.gw; m < M; m += c.ngw) {
        const int b = m >> 11, t = m & 2047; h16* zr = Z + (size_t)m * ZC;
        const float ang = (float)t * inv; const float cs = cosf(ang), sn = sinf(ang);
        auto rope = [&](float x) { const float o = __shfl_xor(x, 32); return hi ? x * cs + o * sn : x * cs - o * sn; };
        auto normrope = [&](float x, float g) { const float ss = wave_sum(x * x); return rope(x * rsqf_(ss * (1.f / 64.f) + 1e-6f) * g); };
        _Pragma("unroll") for (int h = 0; h < 4; ++h) { h16* p = zr + C_QA + h * 64 + lane; *p = (h16)(normrope((float)*p, g_dq) * 0.125f); }
        c.W<h16>(WS_KA)[(size_t)m * 64 + lane] = (h16)normrope((float)zr[C_KA + lane], g_dk);
        c.W<h16>(WS_VAT)[((size_t)b * 64 + lane) * T + t] = zr[C_VA + lane];
        _Pragma("unroll") for (int h = 0; h < 4; ++h) { h16* p = zr + C_IQ + h * 64 + lane; *p = (h16)rope((float)*p); }
        c.W<h16>(WS_IK)[(size_t)m * 64 + lane] = (h16)rope((float)zr[C_IK + lane]);
        _Pragma("unroll") for (int h = 0; h < 4; ++h) { h16* p = zr + C_QC + h * 64 + lane; *p = (h16)(normrope((float)*p, g_nq) * 0.125f); }
        c.W<h16>(WS_KC)[(size_t)m * 64 + lane] = zr[C_KC + lane];
        c.W<h16>(WS_VC)[(size_t)m * 64 + lane] = zr[C_VC + lane];
        c.W<h16>(WS_KS)[(size_t)m * 64 + lane] = (h16)normrope((float)zr[C_KS + lane], g_nk);
        c.W<h16>(WS_VST)[((size_t)b * 64 + lane) * T + t] = zr[C_VS + lane];
        c.W<h16>(WS_KW)[(size_t)m * 64 + lane] = (h16)normrope((float)zr[C_KW + lane], g_nk);
        c.W<h16>(WS_VWT)[((size_t)b * 64 + lane) * T + t] = zr[C_VW + lane];
        { const int c4 = lane * 4; const half4 zc = *(const half4*)(zr + C_WD + c4); half4 zp = {0, 0, 0, 0}; if (t > 0) zp = *(const half4*)(zr - ZC + C_WD + c4);
          half4 o; _Pragma("unroll") for (int q = 0; q < 4; ++q) { const float a = (float)zc[q], v = a + ((float)zp[q] - a) * mu[1536 + c4 + q];
              o[q] = (h16)(c4 < 64 ? tanhf(v) : (c4 < 128 ? v : sigmoidf_(v))); }
          *(half4*)(c.W<h16>(WS_L16) + (size_t)m * 256 + c4) = o; }
    }
}

constexpr int SCS = 2056;
DI unsigned sortable(float v) { if (v == 0.f) v = 0.f; const unsigned u = __builtin_bit_cast(unsigned, v); return (u & 0x80000000u) ? ~u : (u | 0x80000000u); }
DI void dsa_select_item(const Ctx& c, int item) {
    const int b = item >> 7, t0 = (item & 127) * 16; const int lane = c.lane, w = c.wave;
    unsigned* dmask = c.W<unsigned>(WS_DMASK);
    if (t0 < 256) {
        for (int e = c.tid; e < 16 * 64; e += NTHREADS) { const int qi = e >> 6, wd = e & 63, t = t0 + qi; const int nb = t + 1 - 32 * wd;
            dmask[(size_t)(b * T + t) * 64 + wd] = nb <= 0 ? 0u : (nb >= 32 ? 0xFFFFFFFFu : ((1u << nb) - 1u)); }
        return;
    }
    float* sc = (float*)c.lds;
    const h16* Z = c.W<h16>(WS_Z); const h16* IK = c.W<h16>(WS_IK) + (size_t)b * T * 64;
    const int r = lane & 31, hf = lane >> 5, hd = r & 3;
    half8 qf[2][4]; float iw[2];
    _Pragma("unroll") for (int cb = 0; cb < 2; ++cb) { const int mq = b * T + t0 + 8 * cb + (r >> 2); const h16* zq = Z + (size_t)mq * ZC;
        _Pragma("unroll") for (int ks = 0; ks < 4; ++ks) qf[cb][ks] = *(const half8*)(zq + C_IQ + hd * 64 + 16 * ks + 8 * hf);
        iw[cb] = (float)zq[C_IW + hd]; }
    const int ntile = (t0 + 15) / 32 + 1;
    for (int kt = w; kt < ntile; kt += 8) {
        const h16* kr = IK + (size_t)(32 * kt + r) * 64 + 8 * hf;
        f32x16 s0 = {}, s1 = {};
        _Pragma("unroll") for (int ks = 0; ks < 4; ++ks) { const half8 kf = *(const half8*)(kr + 16 * ks); s0 = MFMA32(kf, qf[0][ks], s0); s1 = MFMA32(kf, qf[1][ks], s1); }
        _Pragma("unroll") for (int i = 0; i < 16; ++i) { const int key = 32 * kt + crow(i, hf);
            const float v0 = quad_sum(iw[0] * fmaxf(s0[i], 0.f)), v1 = quad_sum(iw[1] * fmaxf(s1[i], 0.f));
            if (hd == 0) { sc[(r >> 2) * SCS + key] = v0; sc[(8 + (r >> 2)) * SCS + key] = v1; } }
    }
    __syncthreads();
    _Pragma("unroll") for (int qq = 0; qq < 2; ++qq) {
        const int qi = 2 * w + qq, t = t0 + qi; unsigned u[32];
        _Pragma("unroll") for (int i = 0; i < 32; ++i) { const int key = 64 * i + lane; u[i] = key <= t ? sortable(sc[qi * SCS + key]) : 0u; }
        unsigned thr = 0u; bool exact = false;
        for (int bit = 31; bit >= 0; --bit) { const unsigned cand = thr | (1u << bit); int cnt = 0;
            _Pragma("unroll") for (int i = 0; i < 32; ++i) cnt += __popcll(__ballot(u[i] >= cand));
            if (cnt >= 256) { thr = cand; if (cnt == 256) { exact = true; break; } } }
        int need = 0;
        if (!exact) { int cg_ = 0; _Pragma("unroll") for (int i = 0; i < 32; ++i) cg_ += __popcll(__ballot(u[i] > thr)); need = 256 - cg_; }
        unsigned long long mine = 0ull; int run = 0;
        _Pragma("unroll") for (int i = 0; i < 32; ++i) { bool sel;
            if (exact) sel = u[i] >= thr;
            else { const bool eq = (u[i] == thr); const unsigned long long be = __ballot(eq); const int pre = run + __popcll(be & ((1ull << lane) - 1ull)); sel = (u[i] > thr) || (eq && pre < need); run += __popcll(be); }
            const unsigned long long bs = __ballot(sel); if (lane == i) mine = bs; }
        if (lane < 32) *(unsigned long long*)(dmask + (size_t)(b * T + t) * 64 + 2 * lane) = mine;
    }
}

struct Flash { f32x16 o0, o1; float mx, l; DI void init() { _Pragma("unroll") for (int i = 0; i < 16; ++i) { o0[i] = 0.f; o1[i] = 0.f; } mx = -1e30f; l = 0.f; } };
template <class VF>
DI void flash_tile(Flash& f, const half8 (&qf)[4], const h16* Kb, const h16* Vt, int ldv, int key0, int lane, VF valid) {
    const int r = lane & 31, hf = lane >> 5;
    const h16* kr = Kb + (size_t)(key0 + r) * 64 + 8 * hf;
    f32x16 s = {};
    _Pragma("unroll") for (int ks = 0; ks < 4; ++ks) { const half8 kf = *(const half8*)(kr + 16 * ks); s = MFMA32(kf, qf[ks], s); }
    float tmax = -1e30f;
    _Pragma("unroll") for (int i = 0; i < 16; ++i) { s[i] = valid(i) ? s[i] : -1e30f; tmax = fmaxf(tmax, s[i]); }
    tmax = fmaxf(tmax, __shfl_xor(tmax, 32));
    const float mnew = fmaxf(f.mx, tmax), alpha = __expf(f.mx - mnew);
    float psum = 0.f;
    _Pragma("unroll") for (int i = 0; i < 16; ++i) { const float p = s[i] > -1e29f ? __expf(s[i] - mnew) : 0.f; s[i] = p; psum += p; }
    f.l = f.l * alpha + psum; f.mx = mnew;
    _Pragma("unroll") for (int i = 0; i < 16; ++i) { f.o0[i] *= alpha; f.o1[i] *= alpha; }
    _Pragma("unroll") for (int st = 0; st < 2; ++st) { half8 pf; _Pragma("unroll") for (int j = 0; j < 8; ++j) pf[j] = (h16)s[8 * st + j];
        const h16* vp0 = Vt + (size_t)r * ldv + key0 + 16 * st + 4 * hf; const h16* vp1 = vp0 + (size_t)32 * ldv;
        const half4 a0 = *(const half4*)vp0, b0 = *(const half4*)(vp0 + 8), a1 = *(const half4*)vp1, b1 = *(const half4*)(vp1 + 8);
        const half8 v0 = __builtin_shufflevector(a0, b0, 0, 1, 2, 3, 4, 5, 6, 7), v1 = __builtin_shufflevector(a1, b1, 0, 1, 2, 3, 4, 5, 6, 7);
        f.o0 = MFMA32(v0, pf, f.o0); f.o1 = MFMA32(v1, pf, f.o1); }
}
DI void store_o(h16* dst  , const f32x16& o0, const f32x16& o1, int hf) {
    _Pragma("unroll") for (int g = 0; g < 4; ++g) { half4 a, b; _Pragma("unroll") for (int j = 0; j < 4; ++j) { a[j] = (h16)o0[4 * g + j]; b[j] = (h16)o1[4 * g + j]; }
        *(half4*)(dst + 8 * g + 4 * hf) = a; *(half4*)(dst + 32 + 8 * g + 4 * hf) = b; }
}
DI void dsa_attn_wave(const Ctx& c, int b, int t0) {
    const int lane = c.lane, r = lane & 31, hf = lane >> 5, hd = r & 3, t = t0 + (r >> 2), m = b * T + t;
    const h16* zq = c.W<h16>(WS_Z) + (size_t)m * ZC + C_QA + hd * 64 + 8 * hf;
    half8 qf[4]; _Pragma("unroll") for (int ks = 0; ks < 4; ++ks) qf[ks] = *(const half8*)(zq + 16 * ks);
    const h16* Kb = c.W<h16>(WS_KA) + (size_t)b * T * 64; const h16* Vt = c.W<h16>(WS_VAT) + (size_t)b * 64 * T;
    const unsigned* mrow = c.W<unsigned>(WS_DMASK) + (size_t)m * 64;
    Flash f; f.init();
    const int ntile = (t0 + 7) / 32 + 1;
    for (int kt = 0; kt < ntile; ++kt) { const unsigned word = mrow[kt]; if (__ballot(word != 0u) == 0ull) continue;
        flash_tile(f, qf, Kb, Vt, T, 32 * kt, lane, [&](int i) { return ((word >> crow(i, hf)) & 1u) != 0u; }); }
    const float lt = f.l + __shfl_xor(f.l, 32), inv = rcpf_(lt);
    _Pragma("unroll") for (int i = 0; i < 16; ++i) { f.o0[i] *= inv; f.o1[i] *= inv; }
    store_o(c.W<h16>(WS_ACT) + (size_t)m * D + hd * 64, f.o0, f.o1, hf);
}
DI void nsa_attn_wave(const Ctx& c, int b, int t0) {
    const int lane = c.lane, w = c.wave, r = lane & 31, hf = lane >> 5, hd = r & 3, qi = r >> 2, t = t0 + qi, m = b * T + t;
    const h16* zrow = c.W<h16>(WS_Z) + (size_t)m * ZC;
    half8 qf[4]; _Pragma("unroll") for (int ks = 0; ks < 4; ++ks) qf[ks] = *(const half8*)(zrow + C_QC + hd * 64 + 8 * hf + 16 * ks);
    const float g0 = sigmoidf_((float)zrow[C_GC + hd * 3 + 0]), g1 = sigmoidf_((float)zrow[C_GC + hd * 3 + 1]), g2 = sigmoidf_((float)zrow[C_GC + hd * 3 + 2]);
    float* GS = (float*)(c.lds + w * 4096); float* LA = GS + 256; float* IMPF = GS + 512; unsigned* SELM = (unsigned*)(GS + 768);
    f32x16 a0, a1;
    {
        const h16* Kc = c.W<h16>(WS_KCMP) + (size_t)b * 128 * 64; const h16* Vc = c.W<h16>(WS_VCMPT) + (size_t)b * 64 * 128;
        const int nmax = t >= 31 ? ((t - 31) >> 4) : -1;
        f32x16 s[4]; float mxv = -1e30f;
        _Pragma("unroll") for (int tl = 0; tl < 4; ++tl) { const h16* kr = Kc + (size_t)(32 * tl + r) * 64 + 8 * hf; f32x16 a = {};
            _Pragma("unroll") for (int ks = 0; ks < 4; ++ks) { const half8 kf = *(const half8*)(kr + 16 * ks); a = MFMA32(kf, qf[ks], a); }
            _Pragma("unroll") for (int i = 0; i < 16; ++i) { const int n = 32 * tl + crow(i, hf); a[i] = n <= nmax ? a[i] : -1e30f; mxv = fmaxf(mxv, a[i]); }
            s[tl] = a; }
        mxv = fmaxf(mxv, __shfl_xor(mxv, 32));
        float sum = 0.f;
        _Pragma("unroll") for (int tl = 0; tl < 4; ++tl) _Pragma("unroll") for (int i = 0; i < 16; ++i) { const float p = s[tl][i] > -1e29f ? __expf(s[tl][i] - mxv) : 0.f; s[tl][i] = p; sum += p; }
        sum += __shfl_xor(sum, 32);
        const float inv = sum > 0.f ? rcpf_(sum) : 0.f;
        f32x16 o0 = {}, o1 = {};
        _Pragma("unroll") for (int tl = 0; tl < 4; ++tl) { _Pragma("unroll") for (int i = 0; i < 16; ++i) s[tl][i] *= inv;
            _Pragma("unroll") for (int st = 0; st < 2; ++st) { half8 pf; _Pragma("unroll") for (int j = 0; j < 8; ++j) pf[j] = (h16)s[tl][8 * st + j];
                const h16* vp0 = Vc + (size_t)r * 128 + 32 * tl + 16 * st + 4 * hf; const h16* vp1 = vp0 + 32 * 128;
                const half4 x0 = *(const half4*)vp0, y0 = *(const half4*)(vp0 + 8), x1 = *(const half4*)vp1, y1 = *(const half4*)(vp1 + 8);
                o0 = MFMA32(__builtin_shufflevector(x0, y0, 0, 1, 2, 3, 4, 5, 6, 7), pf, o0); o1 = MFMA32(__builtin_shufflevector(x1, y1, 0, 1, 2, 3, 4, 5, 6, 7), pf, o1); } }
        _Pragma("unroll") for (int i = 0; i < 16; ++i) { a0[i] = g0 * o0[i]; a1[i] = g0 * o1[i]; }
        _Pragma("unroll") for (int tl = 0; tl < 4; ++tl) _Pragma("unroll") for (int g = 0; g < 4; ++g) { const int G = 8 * tl + 2 * g + hf;
            const float gs = quad_sum((s[tl][4 * g] + s[tl][4 * g + 1]) + (s[tl][4 * g + 2] + s[tl][4 * g + 3])); const float la = quad_sum(s[tl][4 * g + 3]);
            if (hd == 0) { GS[qi * 32 + G] = gs; LA[qi * 32 + G] = la; } }
        WSYNC();
        _Pragma("unroll") for (int it = 0; it < 4; ++it) { const int q = (lane >> 5) + 2 * it, j = lane & 31, tq = t0 + q, cur = tq >> 6;
            const float imp = GS[q * 32 + j] + (j > 0 ? LA[q * 32 + j - 1] : 0.f);
            const bool adm = (j * 64 <= tq), forced = (j == 0) || (j == cur) || (j == cur - 1);
            IMPF[q * 32 + j] = adm ? (forced ? __builtin_inff() : imp) : -__builtin_inff(); }
        WSYNC();
        _Pragma("unroll") for (int it = 0; it < 4; ++it) { const int q = (lane >> 5) + 2 * it, j = lane & 31; const float mv = IMPF[q * 32 + j]; int rank = 0;
            _Pragma("unroll") for (int jj = 0; jj < 32; ++jj) { const float ov = IMPF[q * 32 + jj]; rank += (ov > mv || (ov == mv && jj < j)) ? 1 : 0; }
            const unsigned long long bs = __ballot(rank < 16);
            if (lane == 0) { SELM[2 * it] = (unsigned)bs; SELM[2 * it + 1] = (unsigned)(bs >> 32); } }
        WSYNC();
    }
    const unsigned selmask = SELM[qi];
    WSYNC();
    {
        const h16* Kb = c.W<h16>(WS_KS) + (size_t)b * T * 64; const h16* Vt = c.W<h16>(WS_VST) + (size_t)b * 64 * T;
        Flash f; f.init();
        const int ntile = (t0 + 7) / 32 + 1;
        for (int kt = 0; kt < ntile; ++kt) { const bool bit = ((selmask >> (kt >> 1)) & 1u) != 0u; if (__ballot(bit) == 0ull) continue;
            const int key0 = 32 * kt; flash_tile(f, qf, Kb, Vt, T, key0, lane, [&](int i) { return bit && (key0 + crow(i, hf) <= t); }); }
        const float lt = f.l + __shfl_xor(f.l, 32), sc = g1 * rcpf_(lt);
        _Pragma("unroll") for (int i = 0; i < 16; ++i) { a0[i] += sc * f.o0[i]; a1[i] += sc * f.o1[i]; }
    }
    {
        const h16* Kb = c.W<h16>(WS_KW) + (size_t)b * T * 64; const h16* Vt = c.W<h16>(WS_VWT) + (size_t)b * 64 * T;
        Flash f; f.init();
        const int lo = (t0 - 511 > 0 ? t0 - 511 : 0) >> 5, hiT = (t0 + 7) >> 5;
        for (int kt = lo; kt <= hiT; ++kt) { const int key0 = 32 * kt;
            flash_tile(f, qf, Kb, Vt, T, key0, lane, [&](int i) { const int key = key0 + crow(i, hf); return key <= t && key > t - 512; }); }
        const float lt = f.l + __shfl_xor(f.l, 32), sc = g2 * rcpf_(lt);
        _Pragma("unroll") for (int i = 0; i < 16; ++i) { a0[i] += sc * f.o0[i]; a1[i] += sc * f.o1[i]; }
    }
    store_o(c.W<h16>(WS_ACT) + (size_t)m * D + 768 + hd * 64, a0, a1, hf);
}

DI void rwkv_item(const Ctx& c, int l, int item) {
    const int b = item >> 3, h = item & 7; const int lane = c.lane, w = c.wave;
    float* base = (float*)c.lds;
    const h16* Z = c.W<h16>(WS_Z); const h16* DEC = c.W<h16>(WS_DEC); const h16* AA = c.W<h16>(WS_A); const h16* GG = c.W<h16>(WS_G); h16* MIX = c.W<h16>(WS_ACT);
    const float* mu = c.inl(I_MU, l, 1792); const float* k_k = c.inl(I_KK, l, 512); const float* k_a = c.inl(I_KA, l, 512); const float* r_k = c.inl(I_RK, l, 512);
    const float* ln_w = c.inl(I_LNW, l, 512); const float* ln_b = c.inl(I_LNB, l, 512);
    const int t2 = (w & 3) * 64 + lane; const int s_ = t2 >> 3, ch = (t2 & 7) * 8, col = h * 64 + ch;
    const int rl = lane >> 3, cc = lane & 7, i0 = 16 * (w & 3) + 2 * rl, j0 = 8 * cc;
    typedef float f2 __attribute__((ext_vector_type(2)));
    f2 S0[4], S1[4];
    _Pragma("unroll") for (int q = 0; q < 4; ++q) { S0[q] = (f2){0.f, 0.f}; S1[q] = (f2){0.f, 0.f}; }
    auto stage = [&](int chunk) {
        float* bf = base + (chunk & 1) * 6 * 2048; const int tt = chunk * 32 + s_; const int m = b * T + tt;
        const h16* zr = Z + (size_t)m * ZC;
        const half8 r8 = *(const half8*)(zr + C_R + col), k8 = *(const half8*)(zr + C_K + col), v8 = *(const half8*)(zr + C_V + col);
        half8 rp = {0, 0, 0, 0, 0, 0, 0, 0}, kp_ = rp, vp = rp;
        if (tt > 0) { rp = *(const half8*)(zr - ZC + C_R + col); kp_ = *(const half8*)(zr - ZC + C_K + col); vp = *(const half8*)(zr - ZC + C_V + col); }
        const half8 d8 = *(const half8*)(DEC + (size_t)m * 512 + col), a8 = *(const half8*)(AA + (size_t)m * 512 + col);
        float rr[8], kx[8], vv[8], kr[8]; float ss = 0.f;
        _Pragma("unroll") for (int q = 0; q < 8; ++q) { const float r0 = (float)r8[q], k0 = (float)k8[q], v0 = (float)v8[q];
            rr[q] = r0 + ((float)rp[q] - r0) * mu[col + q]; kx[q] = k0 + ((float)kp_[q] - k0) * mu[512 + col + q]; vv[q] = v0 + ((float)vp[q] - v0) * mu[1024 + col + q];
            kr[q] = kx[q] * k_k[col + q]; ss += kr[q] * kr[q]; }
        ss = red8(ss); const float inrm = rcpf_(fmaxf(__builtin_amdgcn_sqrtf(ss), 1e-12f));
        _Pragma("unroll") for (int hq = 0; hq < 2; ++hq) { f32x4 o_kk, o_w, o_kp, o_bb, o_r, o_v;
            _Pragma("unroll") for (int q = 0; q < 4; ++q) { const int e = 4 * hq + q; const float a = (float)a8[e]; const float kk = kr[e] * inrm;
                o_kk[q] = kk; o_w[q] = (float)d8[e]; o_kp[q] = kx[e] * (1.f + (a - 1.f) * k_a[col + e]); o_bb[q] = kk * a; o_r[q] = rr[e]; o_v[q] = vv[e]; }
            const int o = s_ * 64 + ch + 4 * hq;
            *(f32x4*)(bf + o) = o_kk; *(f32x4*)(bf + 2048 + o) = o_w; *(f32x4*)(bf + 4096 + o) = o_kp; *(f32x4*)(bf + 6144 + o) = o_bb; *(f32x4*)(bf + 8192 + o) = o_r; *(f32x4*)(bf + 10240 + o) = o_v; }
    };
    auto finish = [&](int chunk) {
        const float* bf = base + (chunk & 1) * 6 * 2048; const float* yb = base + 12 * 2048 + (chunk & 1) * 2048; const int m = b * T + chunk * 32 + s_;
        float y[8], rv[8], pv[8], vv[8]; float sum = 0.f, bs = 0.f;
        _Pragma("unroll") for (int hq = 0; hq < 2; ++hq) { const int o = s_ * 64 + ch + 4 * hq; const f32x4 y4 = *(const f32x4*)(yb + o), r4 = *(const f32x4*)(bf + 8192 + o), p4 = *(const f32x4*)(bf + 4096 + o), v4 = *(const f32x4*)(bf + 10240 + o);
            _Pragma("unroll") for (int q = 0; q < 4; ++q) { y[4 * hq + q] = y4[q]; rv[4 * hq + q] = r4[q]; pv[4 * hq + q] = p4[q]; vv[4 * hq + q] = v4[q]; } }
        _Pragma("unroll") for (int q = 0; q < 8; ++q) { sum += y[q]; bs += rv[q] * pv[q] * r_k[col + q]; }
        const float mean = red8(sum) * (1.f / 64.f); bs = red8(bs);
        float vs = 0.f; _Pragma("unroll") for (int q = 0; q < 8; ++q) { const float d = y[q] - mean; vs += d * d; }
        const float rstd = rsqf_(red8(vs) * (1.f / 64.f) + 64e-5f);
        const half8 g8 = *(const half8*)(GG + (size_t)m * 512 + col); half8 o;
        _Pragma("unroll") for (int q = 0; q < 8; ++q) o[q] = (h16)((((y[q] - mean) * rstd * ln_w[col + q] + ln_b[col + q]) + bs * vv[q]) * (float)g8[q]);
        *(half8*)(MIX + (size_t)m * D + 256 + col) = o;
    };
    __syncthreads();
    if (w >= 4) stage(0);
    __syncthreads();
    for (int i = 0; i <= 64; ++i) {
        if (w < 4) {
            if (i < 64) {
                const float* bf = base + (i & 1) * 6 * 2048; float* yb = base + 12 * 2048 + (i & 1) * 2048;
#pragma unroll 2
                for (int s = 0; s < 32; ++s) {
                    const float* p = bf + s * 64 + j0;
                    f2 kk[4], ww[4], pp[4], bq[4], rq[4];
                    { const f32x4 a = *(const f32x4*)(p), b_ = *(const f32x4*)(p + 4); kk[0] = a.xy; kk[1] = a.zw; kk[2] = b_.xy; kk[3] = b_.zw; }
                    { const f32x4 a = *(const f32x4*)(p + 2048), b_ = *(const f32x4*)(p + 2048 + 4); ww[0] = a.xy; ww[1] = a.zw; ww[2] = b_.xy; ww[3] = b_.zw; }
                    { const f32x4 a = *(const f32x4*)(p + 4096), b_ = *(const f32x4*)(p + 4096 + 4); pp[0] = a.xy; pp[1] = a.zw; pp[2] = b_.xy; pp[3] = b_.zw; }
                    { const f32x4 a = *(const f32x4*)(p + 6144), b_ = *(const f32x4*)(p + 6144 + 4); bq[0] = a.xy; bq[1] = a.zw; bq[2] = b_.xy; bq[3] = b_.zw; }
                    { const f32x4 a = *(const f32x4*)(p + 8192), b_ = *(const f32x4*)(p + 8192 + 4); rq[0] = a.xy; rq[1] = a.zw; rq[2] = b_.xy; rq[3] = b_.zw; }
                    const f2 vv = *(const f2*)(bf + 10240 + s * 64 + i0);
                    f2 d0 = S0[0] * kk[0], d1 = S1[0] * kk[0];
                    _Pragma("unroll") for (int q = 1; q < 4; ++q) { d0 = S0[q] * kk[q] + d0; d1 = S1[q] * kk[q] + d1; }
                    const float sa0 = red8(d0.x + d0.y), sa1 = red8(d1.x + d1.y);
                    const f2 v0 = {vv.x, vv.x}, v1 = {vv.y, vv.y}, n0 = {-sa0, -sa0}, n1 = {-sa1, -sa1};
                    f2 e0, e1;
                    _Pragma("unroll") for (int q = 0; q < 4; ++q) {
                        S0[q] = S0[q] * ww[q] + (n0 * bq[q] + v0 * pp[q]); S1[q] = S1[q] * ww[q] + (n1 * bq[q] + v1 * pp[q]);
                        if (q == 0) { e0 = S0[0] * rq[0]; e1 = S1[0] * rq[0]; } else { e0 = S0[q] * rq[q] + e0; e1 = S1[q] * rq[q] + e1; } }
                    const float y0 = red8(e0.x + e0.y), y1 = red8(e1.x + e1.y);
                    if (cc == 0) { yb[s * 64 + i0] = y0; yb[s * 64 + i0 + 1] = y1; }
                }
            }
        } else {
            if (i > 0) finish(i - 1);
            if (i + 1 < 64) stage(i + 1);
        }
        __syncthreads();
    }
}

DI void phase_cmp2(const Ctx& c, int l) {
    const h16* HID = c.W<h16>(WS_HID); const float* w2 = c.inl(I_NW2, l, 2 * 256 * 64); const float* nkg = c.inl(I_NKG, l, 64);
    const int lane = c.lane; const bool hi = lane >= 32; const float inv = powf(10000.f, -(float)(lane & 31) * (1.f / 32.f));
    for (int it = c.gw; it < 2 * 1024; it += c.ngw) { const int j = it >> 10, rrow = it & 1023, b = rrow >> 7, n = rrow & 127;
        float acc = 0.f;
        if (n < 127) { const h16* hr = HID + ((size_t)j * 1024 + rrow) * 256; const float* wj = w2 + (size_t)j * 256 * 64;
            for (int k = 0; k < 256; k += 8) { const half8 hv = *(const half8*)(hr + k); _Pragma("unroll") for (int q = 0; q < 8; ++q) acc += (float)hv[q] * wj[(k + q) * 64 + lane]; } }
        if (j == 0) { const float ss = wave_sum(acc * acc); float y = acc * rsqf_(ss * (1.f / 64.f) + 1e-6f) * nkg[lane];
            const float ang = (float)(16 * n + 31) * inv; const float cs = cosf(ang), sn = sinf(ang); const float o = __shfl_xor(y, 32); y = hi ? y * cs + o * sn : y * cs - o * sn;
            c.W<h16>(WS_KCMP)[((size_t)b * 128 + n) * 64 + lane] = (h16)(n < 127 ? y : 0.f); }
        else c.W<h16>(WS_VCMPT)[((size_t)b * 64 + lane) * 128 + n] = (h16)acc; }
}

__global__ void __launch_bounds__(NTHREADS) fwd_kernel(Params p) {
    extern __shared__ __attribute__((aligned(16))) char lds[];
    cg::grid_group grid = cg::this_grid();
    Ctx c; c.out = p.out; c.ws = p.ws; c.lds = lds; c.ctl = (unsigned*)(p.ws + WS_CTL);
    c.wave = __builtin_amdgcn_readfirstlane(threadIdx.x >> 6); c.lane = lane_id(); c.tid = c.wave * 64 + c.lane; c.gw = blockIdx.x * 8 + c.wave; c.ngw = gridDim.x * 8;
    if (c.tid < 28) ((const float**)(p.ws + WS_PTRS))[c.tid] = p.in[c.tid];
    unsigned* xbar = c.ctl + 4096;
    if (c.tid == 0) { s_xb[0] = 0u; s_xb[1] = 0u; (void)xb_add(&xbar[XB_XCNT(xb_xcc_id())], 1u); }
    __threadfence(); __syncthreads();
#define GSYNC() do { xcd_barrier(c.ctl + 4096, c.tid); PH(); } while (0)
    h16* ACT = c.W<h16>(WS_ACT); h16* Z = c.W<h16>(WS_Z);

#define PH() do { c.ws = launder_ptr(c.ws); c.out = launder_ptr(c.out); c.lane = lane_id(); asm volatile("" : "+v"(c.lane)); c.tid = c.wave * 64 + c.lane; c.gw = blockIdx.x * 8 + c.wave; } while (0)
    phase_mod(c);
#pragma unroll 1
    for (int l = 0; l < DEPTH; ++l) {
        const float* mod_l = c.W<float>(WS_MOD) + (size_t)l * 8 * 6144;
        PH(); convert_weights(c, l);
        PH(); phase_cbias(c, l);
        if (l == 0) grid.sync();
        PH();
        phase_norm(c, l == 0 ? c.inp(I_X) : c.out, c.inl(I_N1G, l, D), mod_l, 0, 1024);
        GSYNC();
        phase_gemm(c, ACT, D, c.W<h16>(WS_WIN), D, D, 64, 13, EpiZ{Z, ZC});
        GSYNC();
        phase_prep(c, l);
        GSYNC();
        {
            unsigned* ctr = c.ctl + 16 * (2 * l);
            for (;;) { const int it = next_item(ctr, c.tid); if (it >= 8 + 384 + 1024) break; PH();
                if (it < 8) { const int j = it >> 2, pm = it & 3;
                    gemm_unit(c.tid, c.W<h16>(j ? WS_VC : WS_KC), 1024, c.W<h16>(WS_W1) + (size_t)j * 256 * 2048, 2048, 2048, pm * 256, 0, (h16*)lds, EpiCmp{c.W<h16>(WS_HID) + (size_t)j * 1024 * 256, c.W<float>(WS_CBIAS) + j * 256}); }
                else if (it < 392) { const int u = it - 8, pm = u / 6, pn = u % 6;
                    gemm_unit(c.tid, c.W<h16>(WS_L16), 256, c.W<h16>(WS_WL), 256, 256, pm * 256, pn * 256, (h16*)lds, EpiLora{c.W<h16>(WS_DEC), c.W<h16>(WS_A), c.W<h16>(WS_G), c.inl(I_W0, l, 512), c.inl(I_A0, l, 512)}); }
                else dsa_select_item(c, 1023 - (it - 392)); }
        }
        GSYNC();
        phase_cmp2(c, l);
        GSYNC();
        {
            unsigned* ctr = c.ctl + 16 * (2 * l + 1);
            for (;;) { const int it = next_item(ctr, c.tid); if (it >= 64 + 512) break; PH();
                if (it < 64) rwkv_item(c, l, it);
                else { const int a = it - 64; const int kind = a >> 8, idx = 255 - (a & 255); const int b = idx & 7, qb = idx >> 3; const int t0 = qb * 64 + c.wave * 8;
                    if (kind == 0) nsa_attn_wave(c, b, t0); else dsa_attn_wave(c, b, t0); } }
        }
        GSYNC();
        phase_gemm(c, ACT, D, c.W<h16>(WS_WOUT), D, D, 64, 4, EpiRes{l == 0 ? c.inp(I_X) : c.out, c.out, mod_l + 2048});
        GSYNC();
        phase_norm(c, c.out, c.inl(I_N2G, l, D), mod_l, 3072, 4096);
        GSYNC();
        phase_gemm(c, ACT, D, c.W<h16>(WS_WI), D, D, 64, 22, EpiSwiglu{Z});
        GSYNC();
        phase_gemm(c, Z, FF, c.W<h16>(WS_WO), FF, FF, 64, 4, EpiRes{c.out, c.out, mod_l + 5120});
        GSYNC();
    }
}

extern "C" void kernel_launch(void* const* d_in, const int* in_sizes, int n_in, void* d_out, int out_size, void* d_ws, size_t ws_size, hipStream_t stream) {
    static int grid_blocks = 0;
    if (grid_blocks == 0) {
        if (n_in != 28 || ws_size < WS_END) { fprintf(stderr, "kernel_launch: unexpected n_in %d / ws %zu\n", n_in, ws_size); grid_blocks = -1; return; }
        int dev = 0, cus = 0, per_cu = 0;
        hipGetDevice(&dev); hipDeviceGetAttribute(&cus, hipDeviceAttributeMultiprocessorCount, dev);
        hipFuncSetAttribute((const void*)fwd_kernel, hipFuncAttributeMaxDynamicSharedMemorySize, LDS_BYTES);
        hipOccupancyMaxActiveBlocksPerMultiprocessor(&per_cu, (const void*)fwd_kernel, NTHREADS, LDS_BYTES);
        if (per_cu < 1) { fprintf(stderr, "kernel_launch: occupancy query says %d blocks/CU\n", per_cu); per_cu = 1; }
        grid_blocks = cus * 1;
    }
    if (grid_blocks < 0) return;
    hipMemsetAsync((char*)d_ws + WS_CTL, 0, 64 * 1024, stream);
    Params p{};
    for (int i = 0; i < 28; ++i) p.in[i] = (const float*)d_in[i];
    p.out = (float*)d_out; p.ws = (unsigned char*)d_ws;
    void* args[] = {&p};
    hipError_t e = hipLaunchCooperativeKernel((const void*)fwd_kernel, dim3(grid_blocks), dim3(NTHREADS), args, LDS_BYTES, stream);
    if (e != hipSuccess) fprintf(stderr, "cooperative launch failed: %s (grid %d)\n", hipGetErrorString(e), grid_blocks);
}
```

```cpp
#include <hip/hip_runtime.h>
#include <hip/hip_cooperative_groups.h>
#include <cstdio>
#include <cstdint>
namespace cg = cooperative_groups;

typedef _Float16 h16;
typedef _Float16 half8 __attribute__((ext_vector_type(8)));
typedef _Float16 half4 __attribute__((ext_vector_type(4)));
typedef float f32x4 __attribute__((ext_vector_type(4)));
typedef float f32x16 __attribute__((ext_vector_type(16)));
#define LAS __attribute__((address_space(3)))
#define DI __device__ __forceinline__

constexpr int D = 1024, NB = 8, T = 2048, M = NB * T, FF = 2816, DEPTH = 2;
constexpr int ZC = 3328;
constexpr int C_QA = 0, C_KA = 256, C_VA = 320, C_IQ = 384, C_IK = 640, C_IW = 704;
constexpr int C_R = 768, C_K = 1280, C_V = 1792, C_WD = 2304;
constexpr int C_QC = 2560, C_KC = 2816, C_VC = 2880, C_KS = 2944, C_VS = 3008, C_KW = 3072, C_VW = 3136, C_GC = 3200;
constexpr int NTHREADS = 512;
constexpr int LDS_BYTES = 143360;

constexpr size_t MiB = 1u << 20;
constexpr size_t WS_CTL = 0;
constexpr size_t WS_PTRS = 60 * 1024;
constexpr size_t WS_MOD = 64 * 1024;
constexpr size_t WS_CBIAS = 512 * 1024;
constexpr size_t WS_KCMP = 1 * MiB;
constexpr size_t WS_VCMPT = 1 * MiB + 128 * 1024;
constexpr size_t WS_HID = 2 * MiB;
constexpr size_t WS_KA = 4 * MiB, WS_IK = 6 * MiB, WS_KS = 8 * MiB, WS_KW = 10 * MiB;
constexpr size_t WS_VAT = 12 * MiB, WS_VST = 14 * MiB, WS_VWT = 16 * MiB;
constexpr size_t WS_DMASK = 18 * MiB;
constexpr size_t WS_WIN = 22 * MiB;
constexpr size_t WS_WOUT = WS_WIN + 6656 * 1024;
constexpr size_t WS_WI = WS_WOUT + 2 * MiB;
constexpr size_t WS_WO = WS_WI + 11 * MiB;
constexpr size_t WS_W1 = WS_WO + 5632 * 1024;
constexpr size_t WS_WL = WS_W1 + 2 * MiB;
constexpr size_t WS_ACT = 50 * MiB;
constexpr size_t WS_L16 = WS_ACT, WS_KC = WS_ACT + 8 * MiB, WS_VC = WS_ACT + 12 * MiB;
constexpr size_t WS_DEC = 82 * MiB, WS_A = 98 * MiB, WS_G = 114 * MiB;
constexpr size_t WS_Z = 130 * MiB;
constexpr size_t WS_END = 234 * MiB;
static_assert(WS_WL + 768 * 1024 <= WS_ACT, "weights fit");

struct Params { const float* in[28]; float* out; unsigned char* ws; };
enum { I_X = 0, I_C, I_ADAW, I_ADAB, I_N1G, I_WIN, I_DQG, I_DKG, I_MU, I_W0, I_W2, I_A0, I_A2, I_G2, I_KK, I_KA, I_RK, I_LNW, I_LNB,
       I_NQG, I_NKG, I_PE, I_NW1, I_NW2, I_WOUT, I_N2G, I_FWI, I_FWO };

DI int lane_id_fresh() { int l = (int)__builtin_amdgcn_mbcnt_hi(~0u, __builtin_amdgcn_mbcnt_lo(~0u, 0u)); asm volatile("" : "+v"(l)); return l; }
DI float shx(float x, int m) { return __builtin_bit_cast(float, __builtin_amdgcn_ds_bpermute((lane_id_fresh() ^ m) << 2, __builtin_bit_cast(int, x))); }
DI int shx(int x, int m) { return __builtin_amdgcn_ds_bpermute((lane_id_fresh() ^ m) << 2, x); }
template <int CTRL> DI float dpp_f(float x) { return __builtin_bit_cast(float, __builtin_amdgcn_update_dpp(0, __builtin_bit_cast(int, x), CTRL, 0xF, 0xF, true)); }
DI float quad_sum(float x) { x += dpp_f<0xB1>(x); x += dpp_f<0x4E>(x); return x; }
DI float red8(float x) { x += dpp_f<0xB1>(x); x += dpp_f<0x4E>(x); x += dpp_f<0x141>(x); return x; }
DI float red16(float x) { x += shx(x, 1); x += shx(x, 2); x += shx(x, 4); x += shx(x, 8); return x; }
DI float wave_sum(float x) { for (int o = 1; o < 64; o <<= 1) x += shx(x, o); return x; }
DI float rcpf_(float x) { return __builtin_amdgcn_rcpf(x); }
DI float rsqf_(float x) { return __builtin_amdgcn_rsqf(x); }
DI float wave_sum_dpp(float x) {
    x += dpp_f<0xB1>(x); x += dpp_f<0x4E>(x); x += dpp_f<0x141>(x); x += dpp_f<0x140>(x);
    return (__builtin_bit_cast(float, __builtin_amdgcn_readlane(__builtin_bit_cast(int, x), 0)) + __builtin_bit_cast(float, __builtin_amdgcn_readlane(__builtin_bit_cast(int, x), 16))) +
           (__builtin_bit_cast(float, __builtin_amdgcn_readlane(__builtin_bit_cast(int, x), 32)) + __builtin_bit_cast(float, __builtin_amdgcn_readlane(__builtin_bit_cast(int, x), 48)));
}
DI float sigmoidf_(float x) { return rcpf_(1.f + __expf(-x)); }
DI int crow(int i, int h) { return (i & 3) + 8 * (i >> 2) + 4 * h; }
#define WSYNC() asm volatile("s_waitcnt lgkmcnt(0)" ::: "memory")
#define MFMA32(a, b, c) __builtin_amdgcn_mfma_f32_32x32x16_f16((a), (b), (c), 0, 0, 0)

template <class Tp> DI Tp* launder_ptr(Tp* p) {
    unsigned lo = (unsigned)(uintptr_t)p, hi = (unsigned)((uintptr_t)p >> 32); asm volatile("" : "+v"(lo), "+v"(hi));
    lo = __builtin_amdgcn_readfirstlane(lo); hi = __builtin_amdgcn_readfirstlane(hi); return (Tp*)(__attribute__((address_space(1))) Tp*)(((uintptr_t)hi << 32) | lo); }
DI int lane_id() { return (int)__builtin_amdgcn_mbcnt_hi(~0u, __builtin_amdgcn_mbcnt_lo(~0u, 0u)); }
__shared__ int s_item;
DI int next_item(unsigned* ctr, int tid) {
    __syncthreads();
    if (tid == 0) s_item = (int)atomicAdd(ctr, 1u);
    __syncthreads();
    return s_item;
}


#define XB_TMO      128
#define XB_XCNT(j)  (256  + 64 * (j))
#define XB_XSUB(j)  (1280 + 64 * (j))
#define XB_XGEN(j)  (2304 + 64 * (j))
#define XB_TOP      3328
#define XB_TOPGEN   3392
#define XB_SPIN_CAP (1u << 22)
DI unsigned xb_ld(unsigned* p) { return __hip_atomic_load(p, __ATOMIC_RELAXED, __HIP_MEMORY_SCOPE_AGENT); }
DI unsigned xb_add(unsigned* p, unsigned v) { return __hip_atomic_fetch_add(p, v, __ATOMIC_RELAXED, __HIP_MEMORY_SCOPE_AGENT); }
DI unsigned xb_xcc_id() { return (unsigned)__builtin_amdgcn_s_getreg((3 << 11) | 20) & 0xFu; }
#define XB_SPIN(cond, bar) do { unsigned _sp = 0; while (cond) { __builtin_amdgcn_s_sleep(1); \
    if ((++_sp & 255u) == 0u) { if (xb_ld(&(bar)[XB_TMO])) break; if (_sp > XB_SPIN_CAP) { atomicAdd(&(bar)[XB_TMO], 1u); break; } } } } while (0)
__shared__ unsigned s_xb[2];
DI void xcd_barrier_complete(unsigned* bar, unsigned x, unsigned& nloc, unsigned& nx) {
    const unsigned G = gridDim.x; unsigned sum, cnt, mine, sp = 0u;
    for (;;) { sum = 0u; cnt = 0u; mine = 0u;
        _Pragma("unroll") for (unsigned j = 0; j < 16; ++j) { const unsigned c = xb_ld(&bar[XB_XCNT(j)]); sum += c; cnt += (c > 0u) ? 1u : 0u; mine = (j == x) ? c : mine; }
        if (sum == G) break;
        __builtin_amdgcn_s_sleep(1);
        if ((++sp & 255u) == 0u) { if (xb_ld(&bar[XB_TMO])) break; if (sp > XB_SPIN_CAP) { atomicAdd(&bar[XB_TMO], 1u); break; } } }
    nloc = mine > 0u ? mine : 1u; nx = cnt > 0u ? cnt : 1u;
}
DI void xcd_barrier(unsigned* bar, int tid) {
    asm volatile("s_waitcnt vmcnt(0)" ::: "memory");
    __syncthreads();
    if (tid == 0) {
        __builtin_amdgcn_s_waitcnt(0);
        const unsigned x = xb_xcc_id();
        unsigned nloc = s_xb[0], nx = s_xb[1];
        if (nloc == 0u) { xcd_barrier_complete(bar, x, nloc, nx); s_xb[0] = nloc; s_xb[1] = nx; }
        const unsigned old = xb_add(&bar[XB_XSUB(x)], 1u);
        const unsigned gen = old / nloc;
        if (old + 1u == (gen + 1u) * nloc) {
            __builtin_amdgcn_fence(__ATOMIC_RELEASE, "agent");
            asm volatile("s_waitcnt vmcnt(0)" ::: "memory");
            const unsigned og = xb_add(&bar[XB_TOP], 1u);
            const unsigned tg = og / nx;
            if (og + 1u == (tg + 1u) * nx) xb_add(&bar[XB_TOPGEN], 1u);
            else XB_SPIN(xb_ld(&bar[XB_TOPGEN]) == tg, bar);
            __builtin_amdgcn_fence(__ATOMIC_ACQUIRE, "agent");
            xb_add(&bar[XB_XGEN(x)], 1u);
            asm volatile("s_waitcnt vmcnt(0)" ::: "memory");
        } else {
            XB_SPIN(xb_ld(&bar[XB_XGEN(x)]) == gen, bar);
            __builtin_amdgcn_fence(__ATOMIC_ACQUIRE, "agent");
            asm volatile("s_waitcnt vmcnt(0)" ::: "memory");
        }
    }
    __syncthreads();
}

constexpr int BK = 64, HALF = 128, HT = HALF * BK;
DI void stage_rc(int b, int& R, int& C) { int st = b / 1024, sb = b % 1024, swz = sb ^ (((sb >> 9) & 1) << 5); R = (st >> 1) * 16 + swz / 64; C = (st & 1) * 32 + (swz % 64) / 2; }

template <class Epi>
DI void gemm_unit(int tid_in, const h16* __restrict__ A, int lda, const h16* __restrict__ Bt, int ldb, int K, int brow, int bcol, h16* shm, const Epi& epi, bool pre_issued = false, bool has_next = false, int nbrow = 0, int nbcol = 0, bool half_m = false) {
#define SA(b, h) (shm + ((b) * 2 + (h)) * HT)
#define SB(b, h) (shm + (4 + (b) * 2 + (h)) * HT)
#define STAGE_A(P, br, kt) do { const char* _g = (const char*)(A + ((long)(br) * lda + (long)(kt) * BK)); \
    __builtin_amdgcn_global_load_lds((const unsigned*)(_g + oa0), (LAS unsigned*)((char*)(P) + tidx * 16), 16, 0, 0); \
    __builtin_amdgcn_global_load_lds((const unsigned*)(_g + (size_t)lda * 128 + oa0), (LAS unsigned*)((char*)(P) + tidx * 16 + 8192), 16, 0, 0); } while (0)
#define STAGE_B(P, br, kt) do { const char* _g = (const char*)(Bt + ((long)(br) * ldb + (long)(kt) * BK)); \
    __builtin_amdgcn_global_load_lds((const unsigned*)(_g + ob0), (LAS unsigned*)((char*)(P) + tidx * 16), 16, 0, 0); \
    __builtin_amdgcn_global_load_lds((const unsigned*)(_g + (size_t)ldb * 128 + ob0), (LAS unsigned*)((char*)(P) + tidx * 16 + 8192), 16, 0, 0); } while (0)
#define LDA(dst, b, h) _Pragma("unroll") for (int m = 0; m < 4; ++m) _Pragma("unroll") for (int k = 0; k < 2; ++k) dst[m][k] = *reinterpret_cast<const half8*>((char*)SA(b, h) + la + (m * 2 + k) * 1024)
#define LDB(dst, b, h) _Pragma("unroll") for (int n = 0; n < 2; ++n) _Pragma("unroll") for (int k = 0; k < 2; ++k) dst[n][k] = *reinterpret_cast<const half8*>((char*)SB(b, h) + lb + (n * 2 + k) * 1024)
#define MMA(ai, bj, At_, Bt_) do { __builtin_amdgcn_s_setprio(1); \
    _Pragma("unroll") for (int m = 0; m < 4; ++m) _Pragma("unroll") for (int n = 0; n < 2; ++n) _Pragma("unroll") for (int k = 0; k < 2; ++k) \
        acc[ai][bj][m][n] = __builtin_amdgcn_mfma_f32_16x16x32_f16(Bt_[n][k], At_[m][k], acc[ai][bj][m][n], 0, 0, 0); \
    __builtin_amdgcn_s_setprio(0); } while (0)
#define MMAH(ai, bj, At_, Bt_) do { if (!half_m) MMA(ai, bj, At_, Bt_); } while (0)
#define WAIT_V(n) asm volatile("s_waitcnt vmcnt(" #n ")" ::: "memory")
#define WAIT_L(n) asm volatile("s_waitcnt lgkmcnt(" #n ")" ::: "memory")
#define BAR __builtin_amdgcn_s_barrier()
#define SCHED __builtin_amdgcn_sched_barrier(0)
    int tidx = tid_in; asm volatile("" : "+v"(tidx));
    const int wid = tidx >> 6, lane = tidx & 63, wr = wid >> 2, wc = wid & 3, fr = lane & 15, fq = lane >> 4;
    const int lpart = ((fr * 64 + fq * 16) ^ ((fr >> 3) << 5));
    const int la = wr * 8192 + lpart, lb = wc * 4096 + lpart;
    unsigned oa0, ob0;
    { int _r, _c; stage_rc(tidx * 16, _r, _c); oa0 = (unsigned)(_r * lda + _c) * 2u; ob0 = (unsigned)(_r * ldb + _c) * 2u; }
    f32x4 acc[2][2][4][2] = {};
    half8 At[4][2], B0[2][2], B1[2][2];
    const int nt = K / BK;
    if (!pre_issued) {
        STAGE_B(SB(0, 0), bcol, 0); STAGE_A(SA(0, 0), brow, 0);
        STAGE_B(SB(0, 1), bcol + HALF, 0); STAGE_A(SA(0, 1), brow + HALF, 0); }
    if (wr == 1) BAR;
    WAIT_V(4); BAR;
    STAGE_B(SB(1, 0), bcol, 1); STAGE_A(SA(1, 0), brow, 1); STAGE_B(SB(1, 1), bcol + HALF, 1);
    WAIT_V(6); BAR;
    for (int t = 0; t < nt - 2; t += 2) {
        LDB(B0, 0, 0); SCHED; LDA(At, 0, 0); STAGE_A(SA(1, 1), brow + HALF, t + 1);
        WAIT_L(8); BAR; WAIT_L(0); MMA(0, 0, At, B0); BAR; SCHED;
        LDB(B1, 0, 1); STAGE_B(SB(0, 0), bcol, t + 2);
        BAR; WAIT_L(0); MMA(0, 1, At, B1); BAR;
        LDA(At, 0, 1); STAGE_A(SA(0, 0), brow, t + 2);
        BAR; WAIT_L(0); MMAH(1, 0, At, B0); BAR; SCHED;
        STAGE_B(SB(0, 1), bcol + HALF, t + 2);
        WAIT_V(6); BAR; MMAH(1, 1, At, B1); BAR;
        LDB(B0, 1, 0); SCHED; LDA(At, 1, 0); STAGE_A(SA(0, 1), brow + HALF, t + 2);
        WAIT_L(8); BAR; WAIT_L(0); MMA(0, 0, At, B0); BAR; SCHED;
        LDB(B1, 1, 1); STAGE_B(SB(1, 0), bcol, t + 3);
        BAR; WAIT_L(0); MMA(0, 1, At, B1); BAR;
        LDA(At, 1, 1); STAGE_A(SA(1, 0), brow, t + 3);
        BAR; WAIT_L(0); MMAH(1, 0, At, B0); BAR; SCHED;
        STAGE_B(SB(1, 1), bcol + HALF, t + 3);
        WAIT_V(6); BAR; MMAH(1, 1, At, B1); BAR;
    }
    { LDB(B0, 0, 0); LDA(At, 0, 0); STAGE_A(SA(1, 1), brow + HALF, nt - 1);
      BAR; WAIT_L(0); MMA(0, 0, At, B0); BAR;
      LDB(B1, 0, 1); BAR; WAIT_L(0); MMA(0, 1, At, B1); BAR;
      LDA(At, 0, 1); WAIT_V(4); BAR; WAIT_L(0); MMAH(1, 0, At, B0); MMAH(1, 1, At, B1); BAR; }
    { LDB(B0, 1, 0); LDA(At, 1, 0); WAIT_V(2); BAR; WAIT_L(0); MMA(0, 0, At, B0); BAR;
      LDB(B1, 1, 1); WAIT_V(0); BAR; WAIT_L(0); MMA(0, 1, At, B1); BAR;
      LDA(At, 1, 1); BAR; WAIT_L(0); MMAH(1, 0, At, B0); MMAH(1, 1, At, B1); BAR; }
    if (wr == 0) BAR;
    if (has_next) { STAGE_B(SB(0, 0), nbcol, 0); STAGE_A(SA(0, 0), nbrow, 0); STAGE_B(SB(0, 1), nbcol + HALF, 0); STAGE_A(SA(0, 1), nbrow + HALF, 0); }
    epi(acc, brow + wr * 64 + fr, bcol + wc * 32 + fq * 4, half_m ? 1 : 2);
    __syncthreads();
}
DI bool unit_order(int L, int nM, int nN, int& pm, int& pn) {
    const int nwg = nM * nN; if (L >= nwg) return false;
    int wgid = L; { const int q = nwg / 8, r = nwg % 8, xcd = wgid % 8, off = wgid / 8; wgid = (xcd < r ? xcd * (q + 1) : r * (q + 1) + (xcd - r) * q) + off; }
    const int nig = 8 * nN, gid = wgid / nig, fm = gid * 8, gsz = (nM - fm) < 8 ? (nM - fm) : 8;
    pm = fm + ((wgid % nig) % gsz); pn = (wgid % nig) / gsz; return true;
}
typedef f32x4 Acc[2][2][4][2];
#define EPI_LOOP _Pragma("unroll") for (int ai = 0; ai < 2; ++ai) if (ai < nai) _Pragma("unroll") for (int bj = 0; bj < 2; ++bj) _Pragma("unroll") for (int m = 0; m < 4; ++m) _Pragma("unroll") for (int n = 0; n < 2; ++n)
struct EpiZ { h16* z; int ld;
    DI void operator()(Acc& acc, int r0, int c0, int nai) const { EPI_LOOP { const int row = r0 + ai * 128 + m * 16, col = c0 + bj * 128 + n * 16;
        half4 v; _Pragma("unroll") for (int j = 0; j < 4; ++j) v[j] = (h16)acc[ai][bj][m][n][j]; *(half4*)(z + (size_t)row * ld + col) = v; } } };
struct EpiLora { h16 *dec, *a, *g; const float *w0, *a0;
    DI void operator()(Acc& acc, int r0, int c0, int nai) const { EPI_LOOP { const int row = r0 + ai * 128 + m * 16, col = c0 + bj * 128 + n * 16; half4 v;
        if (col < 512) { _Pragma("unroll") for (int j = 0; j < 4; ++j) { const float lw = w0[col + j] + acc[ai][bj][m][n][j]; v[j] = (h16)__expf(-0.60653066f * sigmoidf_(lw)); } *(half4*)(dec + (size_t)row * 512 + col) = v; }
        else if (col < 1024) { _Pragma("unroll") for (int j = 0; j < 4; ++j) v[j] = (h16)sigmoidf_(a0[col - 512 + j] + acc[ai][bj][m][n][j]); *(half4*)(a + (size_t)row * 512 + col - 512) = v; }
        else { _Pragma("unroll") for (int j = 0; j < 4; ++j) v[j] = (h16)acc[ai][bj][m][n][j]; *(half4*)(g + (size_t)row * 512 + col - 1024) = v; } } } };
struct EpiCmp { h16* hid; const float* bias;
    DI void operator()(Acc& acc, int r0, int c0, int nai) const { EPI_LOOP { const int row = r0 + ai * 128 + m * 16, col = c0 + bj * 128 + n * 16; half4 v;
        _Pragma("unroll") for (int j = 0; j < 4; ++j) { const float x = acc[ai][bj][m][n][j] + bias[col + j]; const float u = 0.7978845608f * (x + 0.044715f * x * x * x);
            const float th = 1.f - 2.f * rcpf_(1.f + __expf(2.f * u)); v[j] = (h16)(0.5f * x * (1.f + th)); }
        *(half4*)(hid + (size_t)row * 256 + col) = v; } } };
struct EpiRes { const float* xin; float* xout; const float* gate;
    DI void operator()(Acc& acc, int r0, int c0, int nai) const { EPI_LOOP { const int row = r0 + ai * 128 + m * 16, col = c0 + bj * 128 + n * 16;
        const f32x4 xi = *(const f32x4*)(xin + (size_t)row * D + col); const f32x4 gg = *(const f32x4*)(gate + (size_t)(row >> 11) * 6144 + col);
        f32x4 o; _Pragma("unroll") for (int j = 0; j < 4; ++j) o[j] = xi[j] + gg[j] * acc[ai][bj][m][n][j]; *(f32x4*)(xout + (size_t)row * D + col) = o; } } };
struct EpiSwiglu { h16* hid;
    DI void operator()(Acc& acc, int r0, int c0, int nai) const { _Pragma("unroll") for (int ai = 0; ai < 2; ++ai) if (ai < nai) _Pragma("unroll") for (int m = 0; m < 4; ++m) _Pragma("unroll") for (int n = 0; n < 2; ++n) {
        const int row = r0 + ai * 128 + m * 16; const int tcol = c0 & 255, pn = c0 >> 8; const int col = pn * 128 + tcol + n * 16; half4 v;
        _Pragma("unroll") for (int j = 0; j < 4; ++j) { const float gt = acc[ai][0][m][n][j], up = acc[ai][1][m][n][j]; v[j] = (h16)(gt * sigmoidf_(gt) * up); }
        *(half4*)(hid + (size_t)row * FF + col) = v; } } };

struct Ctx {
    float* out; unsigned char* ws; char* lds; unsigned* ctl;
    int tid, lane, wave, gw, ngw;
    template <class Tp> DI Tp* W(size_t off) const { return (Tp*)(ws + off); }
    DI const float* inp(int i) const { const unsigned* t = (const unsigned*)(ws + WS_PTRS) + 2 * i;
        const unsigned lo = __builtin_amdgcn_readfirstlane(t[0]), hi = __builtin_amdgcn_readfirstlane(t[1]); return (const float*)(const __attribute__((address_space(1))) float*)(((uintptr_t)hi << 32) | lo); }
    DI const float* inl(int i, int l, size_t per_layer) const { return inp(i) + (size_t)l * per_layer; }
};

template <class CM>
DI void tr_item(const float* __restrict__ Wsrc, int K, int Nsrc, h16* WT, int k0, int n0, float* scr, int lane, CM cm) {
    const int kk = lane >> 3, n4 = (lane & 7) * 4; const int sc = cm(n0 + n4);
    f32x4 v[8];
#pragma unroll
    for (int i = 0; i < 8; ++i) { v[i] = (f32x4){0.f, 0.f, 0.f, 0.f}; if (sc >= 0) v[i] = *(const f32x4*)(Wsrc + (size_t)(k0 + kk + 8 * i) * Nsrc + sc); }
#pragma unroll
    for (int i = 0; i < 8; ++i) { float* d = scr + (kk + 8 * i) * 33 + n4; d[0] = v[i].x; d[1] = v[i].y; d[2] = v[i].z; d[3] = v[i].w; }
    WSYNC();
    const int c = lane & 7;
#pragma unroll
    for (int j = 0; j < 4; ++j) { const int n = (lane >> 3) + 8 * j; const float* s = scr + (8 * c) * 33 + n; half8 o;
        _Pragma("unroll") for (int q = 0; q < 8; ++q) o[q] = (h16)s[q * 33];
        *(half8*)(WT + (size_t)(n0 + n) * K + k0 + 8 * c) = o; }
    WSYNC();
}
DI void convert_weights(const Ctx& c, int l) {
    float* scr = (float*)(c.lds + c.wave * 8448);
    constexpr int I_IN = 16 * 104, I_OUT = 16 * 32, I_FI = 16 * 176, I_FO = 44 * 32, I_W1 = 32 * 8;
    constexpr int NIT = I_IN + I_OUT + I_FI + I_FO + 2 * I_W1;
    for (int it = c.gw; it < NIT; it += c.ngw) {
        int r = it;
        if (r < I_IN) { tr_item(c.inl(I_WIN, l, (size_t)D * 3152), D, 3152, c.W<h16>(WS_WIN), (r / 104) * 64, (r % 104) * 32, scr, c.lane,
                                [](int n) { return n < 708 ? n : (n < 768 ? -1 : (n < 3212 ? n - 60 : -1)); }); continue; } r -= I_IN;
        if (r < I_OUT) { tr_item(c.inl(I_WOUT, l, (size_t)D * D), D, D, c.W<h16>(WS_WOUT), (r / 32) * 64, (r % 32) * 32, scr, c.lane, [](int n) { return n; }); continue; } r -= I_OUT;
        if (r < I_FI) { tr_item(c.inl(I_FWI, l, (size_t)D * 2 * FF), D, 2 * FF, c.W<h16>(WS_WI), (r / 176) * 64, (r % 176) * 32, scr, c.lane,
                                [](int n) { const int pn = n >> 8, q = n & 255; return q < 128 ? pn * 128 + q : FF + pn * 128 + (q - 128); }); continue; } r -= I_FI;
        if (r < I_FO) { tr_item(c.inl(I_FWO, l, (size_t)FF * D), FF, D, c.W<h16>(WS_WO), (r / 32) * 64, (r % 32) * 32, scr, c.lane, [](int n) { return n; }); continue; } r -= I_FO;
        const int j = r / I_W1; r %= I_W1;
        tr_item(c.inl(I_NW1, l, (size_t)2 * 2048 * 256) + (size_t)j * 2048 * 256, 2048, 256, c.W<h16>(WS_W1) + (size_t)j * 256 * 2048, (r / 8) * 64, (r % 8) * 32, scr, c.lane, [](int n) { return n; });
    }
    const float* w2 = c.inl(I_W2, l, 64 * 512); const float* a2 = c.inl(I_A2, l, 64 * 512); const float* g2 = c.inl(I_G2, l, 128 * 512);
    h16* wl = c.W<h16>(WS_WL);
    for (int e = blockIdx.x * NTHREADS + c.tid; e < 1536 * 256; e += gridDim.x * NTHREADS) {
        const int n = e >> 8, k = e & 255; float v = 0.f;
        if (n < 512) { if (k < 64) v = w2[k * 512 + n]; }
        else if (n < 1024) { if (k >= 64 && k < 128) v = a2[(k - 64) * 512 + n - 512]; }
        else { if (k >= 128) v = g2[(k - 128) * 512 + n - 1024]; }
        wl[e] = (h16)v;
    }
}
template <int NV>
DI void gemv_item(const Ctx& c, const float* aL, int K, const float* __restrict__ Wsrc, int N, int n0, const float* bias, float* out, int out_stride, float* red) {
    const int nl = c.tid & 31, kc = c.tid >> 5, kper = K / 16;
    float acc[NV]; for (int v = 0; v < NV; ++v) acc[v] = 0.f;
    for (int k0 = kc * kper; k0 < (kc + 1) * kper; k0 += 16) {
        float wv[16]; _Pragma("unroll") for (int u = 0; u < 16; ++u) wv[u] = Wsrc[(size_t)(k0 + u) * N + n0 + nl];
        _Pragma("unroll") for (int u = 0; u < 16; ++u) for (int v = 0; v < NV; ++v) acc[v] += aL[v * K + k0 + u] * wv[u]; }
    for (int v = 0; v < NV; ++v) red[(kc * NV + v) * 32 + nl] = acc[v];
    __syncthreads();
    if (c.tid < 32 * NV) { const int v = c.tid >> 5; float s = bias ? bias[n0 + nl] : 0.f; _Pragma("unroll") for (int q = 0; q < 16; ++q) s += red[(q * NV + v) * 32 + nl]; out[(size_t)v * out_stride + n0 + nl] = s; }
    __syncthreads();
}
DI void phase_mod(const Ctx& c) {
    float* sil = (float*)(c.lds + 70000); float* red = (float*)(c.lds + 70000 + 32768);
    for (int e = c.tid; e < 8 * 1024; e += NTHREADS) { const float x = c.inp(I_C)[e]; sil[e] = x * sigmoidf_(x); }
    __syncthreads();
    for (int it = blockIdx.x; it < 2 * 192; it += gridDim.x) { const int l = it / 192, n0 = (it % 192) * 32;
        gemv_item<8>(c, sil, 1024, c.inl(I_ADAW, l, (size_t)1024 * 6144), 6144, n0, c.inl(I_ADAB, l, 6144), c.W<float>(WS_MOD) + (size_t)l * 8 * 6144, 6144, red); }
}
DI void phase_cbias(const Ctx& c, int l) {
    float* pe = (float*)(c.lds + 70000); float* red = (float*)(c.lds + 70000 + 32768);
    __syncthreads();
    for (int e = c.tid; e < 2 * 2048; e += NTHREADS) pe[e] = c.inl(I_PE, l, 2 * 2048)[e];
    __syncthreads();
    for (int it = (int)gridDim.x - 1 - (int)blockIdx.x; it < 16; it += gridDim.x) { const int j = it >> 3, n0 = (it & 7) * 32;
        gemv_item<1>(c, pe + j * 2048, 2048, c.inl(I_NW1, l, (size_t)2 * 2048 * 256) + (size_t)j * 2048 * 256, 256, n0, nullptr, c.W<float>(WS_CBIAS) + j * 256, 256, red); }
}
DI void phase_norm(const Ctx& c, const float* x, const float* g, const float* mod_l, int sh_off, int sc_off) {
    h16* act = c.W<h16>(WS_ACT);
    f32x4 gg[4]; _Pragma("unroll") for (int j = 0; j < 4; ++j) gg[j] = *(const f32x4*)(g + 4 * c.lane + 256 * j);
    for (int m0 = c.gw; m0 < M; m0 += 4 * c.ngw) {
        f32x4 v[4][4];
        _Pragma("unroll") for (int u = 0; u < 4; ++u) { const int m = m0 + u * c.ngw; const f32x4* xr = (const f32x4*)(x + (size_t)(m < M ? m : m0) * D) + c.lane;
            _Pragma("unroll") for (int j = 0; j < 4; ++j) v[u][j] = xr[64 * j]; }
        _Pragma("unroll") for (int u = 0; u < 4; ++u) { const int m = m0 + u * c.ngw; if (m >= M) break;
            float s = 0.f; _Pragma("unroll") for (int j = 0; j < 4; ++j) s += v[u][j].x * v[u][j].x + v[u][j].y * v[u][j].y + v[u][j].z * v[u][j].z + v[u][j].w * v[u][j].w;
            const float rstd = rsqf_(wave_sum(s) * (1.f / D) + 1e-6f);
            const float* mb = mod_l + (size_t)(m >> 11) * 6144;
            _Pragma("unroll") for (int j = 0; j < 4; ++j) { const int col = 4 * c.lane + 256 * j; const f32x4 sc = *(const f32x4*)(mb + sc_off + col), sh = *(const f32x4*)(mb + sh_off + col);
                half4 o; _Pragma("unroll") for (int q = 0; q < 4; ++q) o[q] = (h16)(v[u][j][q] * rstd * gg[j][q] * (1.f + sc[q]) + sh[q]);
                *(half4*)(act + (size_t)m * D + col) = o; } }
    }
}
template <class Epi>
DI void phase_gemm(const Ctx& c, const h16* A, int lda, const h16* Bt, int ldb, int K, int nM, int nN, const Epi& epi) {
    const int G = (int)gridDim.x, bid = (int)blockIdx.x, nwg = nM * nN, rounds = nwg / G, rem = nwg - rounds * G;
    const bool tail_half = rem > 0 && 2 * rem <= G;
    const int nfull = tail_half ? rounds : (nwg + G - 1) / G;
    bool pre = false;
    for (int i = 0; i < nfull; ++i) { int pm, pn, pm2 = 0, pn2 = 0; if (!unit_order(i * G + bid, nM, nN, pm, pn)) break;
        const bool have2 = (i + 1 < nfull) && unit_order((i + 1) * G + bid, nM, nN, pm2, pn2);
        gemm_unit(c.tid, A, lda, Bt, ldb, K, pm * 256, pn * 256, (h16*)c.lds, epi, pre, have2, pm2 * 256, pn2 * 256);
        pre = have2; }
    if (tail_half && bid < 2 * rem) { int pm, pn; unit_order(rounds * G + (bid >> 1), nM, nN, pm, pn);
        gemm_unit(c.tid, A, lda, Bt, ldb, K, pm * 256 + 128 * (bid & 1), pn * 256, (h16*)c.lds, epi, false, false, 0, 0, true); }
}

DI void phase_prep(const Ctx& c, int l) {
    h16* Z = c.W<h16>(WS_Z);
    const float* dqg = c.inl(I_DQG, l, 64); const float* dkg = c.inl(I_DKG, l, 64); const float* nqg = c.inl(I_NQG, l, 64); const float* nkg = c.inl(I_NKG, l, 64);
    const float* mu = c.inl(I_MU, l, 1792);
    const int lane = c.lane; const bool hi = lane >= 32;
    const float inv = powf(10000.f, -(float)(lane & 31) * (1.f / 32.f));
    const float g_dq = dqg[lane], g_dk = dkg[lane], g_nq = nqg[lane], g_nk = nkg[lane];
    h16* VL = (h16*)(c.lds + 65536);
    for (int tb = blockIdx.x; tb < M / 64; tb += gridDim.x) {
      __syncthreads();
      for (int ti = 0; ti < 8; ++ti) {
        const int m = tb * 64 + c.wave * 8 + ti; const int tl = c.wave * 8 + ti;
        const int b = m >> 11, t = m & 2047; h16* zr = Z + (size_t)m * ZC;
        float xqa[4], xiq[4], xqc[4];
        _Pragma("unroll") for (int h = 0; h < 4; ++h) { xqa[h] = (float)zr[C_QA + h * 64 + lane]; xiq[h] = (float)zr[C_IQ + h * 64 + lane]; xqc[h] = (float)zr[C_QC + h * 64 + lane]; }
        const float xka = (float)zr[C_KA + lane], xik = (float)zr[C_IK + lane], xks = (float)zr[C_KS + lane], xkw = (float)zr[C_KW + lane];
        const h16 xva = zr[C_VA + lane], xkc = zr[C_KC + lane], xvc = zr[C_VC + lane], xvs = zr[C_VS + lane], xvw = zr[C_VW + lane];
        const int c4 = lane * 4; const half4 zc = *(const half4*)(zr + C_WD + c4); half4 zp = {0, 0, 0, 0}; if (t > 0) zp = *(const half4*)(zr - ZC + C_WD + c4);
        const f32x4 mu4 = *(const f32x4*)(mu + 1536 + c4);
        asm volatile("" ::: "memory");
        const float ang = (float)t * inv; float sn, cs;
        {
            const float kf = rintf(ang * 0.15915494309189535f); float rr = fmaf(-kf, 6.28125f, ang); rr = fmaf(-kf, 0.0019353071795864769f, rr); sn = __sinf(rr); cs = __cosf(rr); }
        auto rope = [&](float x) { const float o = shx(x, 32); return hi ? x * cs + o * sn : x * cs - o * sn; };
        auto normrope = [&](float x, float g) { const float ss = wave_sum_dpp(x * x); return rope(x * rsqf_(ss * (1.f / 64.f) + 1e-6f) * g); };
        _Pragma("unroll") for (int h = 0; h < 4; ++h) { zr[C_QA + h * 64 + lane] = (h16)(normrope(xqa[h], g_dq) * 0.18033688f); zr[C_IQ + h * 64 + lane] = (h16)rope(xiq[h]); zr[C_QC + h * 64 + lane] = (h16)(normrope(xqc[h], g_nq) * 0.18033688f); }
        c.W<h16>(WS_KA)[(size_t)m * 64 + lane] = (h16)normrope(xka, g_dk);
        c.W<h16>(WS_IK)[(size_t)m * 64 + lane] = (h16)rope(xik);
        c.W<h16>(WS_KS)[(size_t)m * 64 + lane] = (h16)normrope(xks, g_nk);
        c.W<h16>(WS_KW)[(size_t)m * 64 + lane] = (h16)normrope(xkw, g_nk);
        c.W<h16>(WS_KC)[(size_t)m * 64 + lane] = xkc;
        c.W<h16>(WS_VC)[(size_t)m * 64 + lane] = xvc;
        VL[(0 * 64 + lane) * 72 + tl] = xva; VL[(1 * 64 + lane) * 72 + tl] = xvs; VL[(2 * 64 + lane) * 72 + tl] = xvw; (void)b; (void)t;
        { half4 o; _Pragma("unroll") for (int q = 0; q < 4; ++q) { const float a = (float)zc[q], v = a + ((float)zp[q] - a) * mu4[q];
              o[q] = (h16)(c4 < 64 ? tanhf(v) : (c4 < 128 ? v : sigmoidf_(v))); }
          *(half4*)(c.W<h16>(WS_L16) + (size_t)m * 256 + c4) = o; }
      }
      __syncthreads();
      {
          const int bb = (tb * 64) >> 11, t0 = (tb * 64) & 2047;
          for (int e = c.tid; e < 3 * 64 * 8; e += NTHREADS) { const int arr = e >> 9, dim = (e >> 3) & 63, pc = e & 7;
              h16* dst = c.W<h16>(arr == 0 ? WS_VAT : (arr == 1 ? WS_VST : WS_VWT)) + ((size_t)bb * 64 + dim) * T + t0 + 8 * pc;
              *(half8*)dst = *(const half8*)(VL + (arr * 64 + dim) * 72 + 8 * pc); }
      }
    }
}

constexpr int SCS = 2056;
DI unsigned sortable(float v) { if (v == 0.f) v = 0.f; const unsigned u = __builtin_bit_cast(unsigned, v); return (u & 0x80000000u) ? ~u : (u | 0x80000000u); }
DI void dsa_select_item(const Ctx& c, int item) {
    const int b = item >> 7, t0 = (item & 127) * 16; const int lane = c.lane, w = c.wave;
    unsigned* dmask = c.W<unsigned>(WS_DMASK);
    if (t0 < 256) {
        for (int e = c.tid; e < 16 * 64; e += NTHREADS) { const int qi = e >> 6, wd = e & 63, t = t0 + qi; const int nb = t + 1 - 32 * wd;
            dmask[(size_t)(b * T + t) * 64 + wd] = nb <= 0 ? 0u : (nb >= 32 ? 0xFFFFFFFFu : ((1u << nb) - 1u)); }
        return;
    }
    float* sc = (float*)c.lds;
    const h16* Z = c.W<h16>(WS_Z); const h16* IK = c.W<h16>(WS_IK) + (size_t)b * T * 64;
    const int r = lane & 31, hf = lane >> 5, hd = r & 3;
    half8 qf[2][4]; float iw[2][4][4];
    _Pragma("unroll") for (int cb = 0; cb < 2; ++cb) { const int mq = b * T + t0 + 8 * cb + (r >> 2); const h16* zq = Z + (size_t)mq * ZC;
        _Pragma("unroll") for (int ks = 0; ks < 4; ++ks) qf[cb][ks] = *(const half8*)(zq + C_IQ + hd * 64 + 16 * ks + 8 * hf);
        _Pragma("unroll") for (int g = 0; g < 4; ++g) { const half4 w4 = *(const half4*)(Z + (size_t)(b * T + t0 + 8 * cb + 2 * g + hf) * ZC + C_IW);
            _Pragma("unroll") for (int q = 0; q < 4; ++q) iw[cb][g][q] = (float)w4[q]; } }
    const int ntile = (t0 + 15) / 32 + 1;
    for (int kt = w; kt < ntile; kt += 16) {
        const bool two = kt + 8 < ntile;
        const h16* kr = IK + (size_t)(32 * kt + r) * 64 + 8 * hf;
        half8 ka[4], kb[4];
        _Pragma("unroll") for (int ks = 0; ks < 4; ++ks) ka[ks] = *(const half8*)(kr + 16 * ks);
        if (two) { _Pragma("unroll") for (int ks = 0; ks < 4; ++ks) kb[ks] = *(const half8*)(kr + 8 * 32 * 64 + 16 * ks); }
        _Pragma("unroll") for (int hh = 0; hh < 2; ++hh) {
            if (hh == 1 && !two) break;
            const int key = 32 * (kt + 8 * hh) + r;
            f32x16 s0 = {}, s1 = {};
            _Pragma("unroll") for (int ks = 0; ks < 4; ++ks) { const half8 kf = hh ? kb[ks] : ka[ks]; s0 = MFMA32(qf[0][ks], kf, s0); s1 = MFMA32(qf[1][ks], kf, s1); }
            _Pragma("unroll") for (int g = 0; g < 4; ++g) { float v0 = 0.f, v1 = 0.f;
                _Pragma("unroll") for (int q = 0; q < 4; ++q) { v0 += iw[0][g][q] * fmaxf(s0[4 * g + q], 0.f); v1 += iw[1][g][q] * fmaxf(s1[4 * g + q], 0.f); }
                sc[(2 * g + hf) * SCS + key] = v0; sc[(8 + 2 * g + hf) * SCS + key] = v1; }
        }
    }
    __syncthreads();
    _Pragma("unroll") for (int qq = 0; qq < 2; ++qq) {
        const int qi = 2 * w + qq, t = t0 + qi; unsigned u[32]; const int nI = (t >> 6) + 1;
        _Pragma("unroll") for (int i = 0; i < 32; ++i) { const int key = 64 * i + lane; u[i] = (i < nI && key <= t) ? sortable(sc[qi * SCS + key]) : 0u; }
        unsigned thr = 0u; bool exact = false;
        for (int bit = 31; bit >= 0; --bit) { const unsigned cand = thr | (1u << bit); int cnt = 0;
            _Pragma("unroll") for (int g = 0; g < 4; ++g) if (8 * g < nI) { _Pragma("unroll") for (int i = 8 * g; i < 8 * g + 8; ++i) cnt += __popcll(__ballot(u[i] >= cand)); }
            if (cnt >= 256) { thr = cand; if (cnt == 256) { exact = true; break; } } }
        int need = 0;
        if (!exact) { int cg_ = 0; _Pragma("unroll") for (int i = 0; i < 32; ++i) cg_ += __popcll(__ballot(u[i] > thr)); need = 256 - cg_; }
        unsigned long long mine = 0ull; int run = 0;
        _Pragma("unroll") for (int i = 0; i < 32; ++i) { bool sel;
            if (exact) sel = u[i] >= thr;
            else { const bool eq = (u[i] == thr); const unsigned long long be = __ballot(eq); const int pre = run + __popcll(be & ((1ull << lane) - 1ull)); sel = (u[i] > thr) || (eq && pre < need); run += __popcll(be); }
            const unsigned long long bs = __ballot(sel); if (lane == i) mine = bs; }
        if (lane < 32) *(unsigned long long*)(dmask + (size_t)(b * T + t) * 64 + 2 * lane) = mine;
    }
}

struct Flash { f32x16 o0, o1; float mx, l; DI void init() { _Pragma("unroll") for (int i = 0; i < 16; ++i) { o0[i] = 0.f; o1[i] = 0.f; } mx = -1e30f; l = 0.f; } };
DI half8 ld2x4(const char* p) { const half4 a = *(const half4*)p, b = *(const half4*)(p + 16); return __builtin_shufflevector(a, b, 0, 1, 2, 3, 4, 5, 6, 7); }
struct KV { half8 k[4]; half8 v[2][2]; unsigned word; };
template <bool HASMASK>
DI void load_kv(KV& t, const h16* Kb, const h16* Vt, int ldv, const unsigned* mrow, int kt, int r, int hf) {
    const h16* kr = Kb + (size_t)(32 * kt + r) * 64 + 8 * hf;
    _Pragma("unroll") for (int ks = 0; ks < 4; ++ks) t.k[ks] = *(const half8*)(kr + 16 * ks);
    _Pragma("unroll") for (int st = 0; st < 2; ++st) { const h16* vp0 = Vt + (size_t)r * ldv + 32 * kt + 16 * st + 4 * hf; const h16* vp1 = vp0 + (size_t)32 * ldv;
        const half4 a0 = *(const half4*)vp0, b0 = *(const half4*)(vp0 + 8), a1 = *(const half4*)vp1, b1 = *(const half4*)(vp1 + 8);
        t.v[st][0] = __builtin_shufflevector(a0, b0, 0, 1, 2, 3, 4, 5, 6, 7); t.v[st][1] = __builtin_shufflevector(a1, b1, 0, 1, 2, 3, 4, 5, 6, 7); }
    if (HASMASK) t.word = mrow[kt]; else t.word = 0u;
}
typedef __fp16 fp16x2_t __attribute__((ext_vector_type(2)));
typedef __fp16 fp16x4_t __attribute__((ext_vector_type(4)));
typedef __fp16 fp16x8_t __attribute__((ext_vector_type(8)));
DI half8 pack8(const f32x16& s, int st) {
    const fp16x2_t p0 = __builtin_amdgcn_cvt_pkrtz(s[8 * st + 0], s[8 * st + 1]), p1 = __builtin_amdgcn_cvt_pkrtz(s[8 * st + 2], s[8 * st + 3]);
    const fp16x2_t p2 = __builtin_amdgcn_cvt_pkrtz(s[8 * st + 4], s[8 * st + 5]), p3 = __builtin_amdgcn_cvt_pkrtz(s[8 * st + 6], s[8 * st + 7]);
    const fp16x4_t a = __builtin_shufflevector(p0, p1, 0, 1, 2, 3), b = __builtin_shufflevector(p2, p3, 0, 1, 2, 3);
    const fp16x8_t c = __builtin_shufflevector(a, b, 0, 1, 2, 3, 4, 5, 6, 7);
    return __builtin_bit_cast(half8, c);
}
template <class VF>
DI void flash_compute(Flash& f, const half8 (&qf)[4], const KV& t, bool full, VF valid) {
    f32x16 s = {};
    _Pragma("unroll") for (int ks = 0; ks < 4; ++ks) s = MFMA32(t.k[ks], qf[ks], s);
    float tmax = -1e30f;
    if (!full) { _Pragma("unroll") for (int i = 0; i < 16; ++i) s[i] = valid(i) ? s[i] : -3.0e38f; }
    _Pragma("unroll") for (int i = 0; i < 16; ++i) tmax = fmaxf(tmax, s[i]);
    tmax = fmaxf(tmax, shx(tmax, 32));
    const float mnew = fmaxf(f.mx, tmax), alpha = __builtin_amdgcn_exp2f(f.mx - mnew);
    float psum = 0.f;
    _Pragma("unroll") for (int i = 0; i < 16; ++i) { const float p = __builtin_amdgcn_exp2f(s[i] - mnew); s[i] = p; psum += p; }
    f.l = f.l * alpha + psum; f.mx = mnew;
    if (__ballot(alpha != 1.f) != 0ull) { _Pragma("unroll") for (int i = 0; i < 16; ++i) { f.o0[i] *= alpha; f.o1[i] *= alpha; } }
    _Pragma("unroll") for (int st = 0; st < 2; ++st) { const half8 pf = pack8(s, st);
        f.o0 = MFMA32(t.v[st][0], pf, f.o0); f.o1 = MFMA32(t.v[st][1], pf, f.o1); }
}
template <bool HASMASK, class VF, class FF>
DI void flash_pass(Flash& f, const half8 (&qf)[4], const h16* Kb, const h16* Vt, int ldv, const unsigned* mrow, int kt0, int kt1, unsigned um, int lane, VF valid  , FF full  ) {
    const int r = lane & 31, hf = lane >> 5;
    int kt = kt0; while (kt < kt1 && !((um >> (kt >> 1)) & 1u)) ++kt;
    if (kt >= kt1) return;
    auto nextv = [&](int k) { ++k; while (k < kt1 && !((um >> (k >> 1)) & 1u)) ++k; return k; };
    KV ta, tb; load_kv<HASMASK>(ta, Kb, Vt, ldv, mrow, kt, r, hf);
    for (;;) {
        int kn = nextv(kt);
        if (kn < kt1) load_kv<HASMASK>(tb, Kb, Vt, ldv, mrow, kn, r, hf);
        { const int key0 = 32 * kt; const unsigned word = ta.word; flash_compute(f, qf, ta, full(key0, word), [&](int i) { return valid(i, key0 + crow(i, hf), word); }); }
        if (kn >= kt1) break;
        kt = kn; kn = nextv(kt);
        if (kn < kt1) load_kv<HASMASK>(ta, Kb, Vt, ldv, mrow, kn, r, hf);
        { const int key0 = 32 * kt; const unsigned word = tb.word; flash_compute(f, qf, tb, full(key0, word), [&](int i) { return valid(i, key0 + crow(i, hf), word); }); }
        if (kn >= kt1) break;
        kt = kn;
    }
}
constexpr int AT_LDS = 32768, AT_ROW = 144, AT_STAGE = 2 * 64 * AT_ROW;
template <bool HASMASK, class VF, class FF>
DI void flash_pass_wg(Flash& f, const half8 (&qf)[4], const h16* Kb, const h16* Vt, int ldv, const unsigned* mrow, int jb0, int jb1, unsigned um, char* lds, int tid, VF valid  , FF full  ) {
    const int lane = tid & 63, r = lane & 31, hf = lane >> 5;
    auto nextv = [&](int k) { while (k < jb1 && !((um >> k) & 1u)) ++k; return k; };
    const int prow = tid >> 3, ppart = tid & 7;
    const h16* gk = Kb + (size_t)prow * 64 + 8 * ppart; const h16* gv = Vt + (size_t)prow * ldv + 8 * ppart;
    const int loff = prow * AT_ROW + 16 * ppart;
    char* st0 = lds + AT_LDS;
    int jb = nextv(jb0);
    __syncthreads();
    if (jb >= jb1) return;
    half8 pk = *(const half8*)(gk + (size_t)jb * 64 * 64), pv = *(const half8*)(gv + (size_t)jb * 64);
    unsigned w0p = 0u, w1p = 0u; if (HASMASK) { w0p = mrow[2 * jb]; w1p = mrow[2 * jb + 1]; }
    *(half8*)(st0 + loff) = pk; *(half8*)(st0 + 64 * AT_ROW + loff) = pv;
    unsigned w0 = w0p, w1 = w1p; int buf = 0;
    int jn = nextv(jb + 1);
    if (jn < jb1) { pk = *(const half8*)(gk + (size_t)jn * 64 * 64); pv = *(const half8*)(gv + (size_t)jn * 64); if (HASMASK) { w0p = mrow[2 * jn]; w1p = mrow[2 * jn + 1]; } }
    __syncthreads();
    for (;;) {
        const char* sb = st0 + buf * AT_STAGE;
        const int key0 = 64 * jb;
        const bool fa = full(key0, w0), fb = full(key0 + 32, w1);
        f32x16 sa = {}, sc = {};
        _Pragma("unroll") for (int ks = 0; ks < 4; ++ks) { const half8 ka = *(const half8*)(sb + r * AT_ROW + 32 * ks + 16 * hf), kb = *(const half8*)(sb + (32 + r) * AT_ROW + 32 * ks + 16 * hf);
            sa = MFMA32(ka, qf[ks], sa); sc = MFMA32(kb, qf[ks], sc); }
        if (!fa) { _Pragma("unroll") for (int i = 0; i < 16; ++i) sa[i] = valid(i, key0 + crow(i, hf), w0) ? sa[i] : -3.0e38f; }
        if (!fb) { _Pragma("unroll") for (int i = 0; i < 16; ++i) sc[i] = valid(i, key0 + 32 + crow(i, hf), w1) ? sc[i] : -3.0e38f; }
        float tmax = -1e30f;
        _Pragma("unroll") for (int i = 0; i < 16; ++i) tmax = fmaxf(tmax, fmaxf(sa[i], sc[i]));
        tmax = fmaxf(tmax, shx(tmax, 32));
        const float mnew = fmaxf(f.mx, tmax), alpha = __builtin_amdgcn_exp2f(f.mx - mnew);
        float psum = 0.f;
        _Pragma("unroll") for (int i = 0; i < 16; ++i) { sa[i] = __builtin_amdgcn_exp2f(sa[i] - mnew); sc[i] = __builtin_amdgcn_exp2f(sc[i] - mnew); psum += sa[i] + sc[i]; }
        f.l = f.l * alpha + psum; f.mx = mnew;
        if (__ballot(alpha != 1.f) != 0ull) { _Pragma("unroll") for (int i = 0; i < 16; ++i) { f.o0[i] *= alpha; f.o1[i] *= alpha; } }
        const char* vb = sb + 64 * AT_ROW;
        _Pragma("unroll") for (int sub = 0; sub < 2; ++sub) _Pragma("unroll") for (int st = 0; st < 2; ++st) {
            const half8 pf = pack8(sub ? sc : sa, st);
            const char* vp0 = vb + r * AT_ROW + (32 * sub + 16 * st + 4 * hf) * 2; const char* vp1 = vp0 + 32 * AT_ROW;
            f.o0 = MFMA32(ld2x4(vp0), pf, f.o0); f.o1 = MFMA32(ld2x4(vp1), pf, f.o1); }
        if (jn >= jb1) break;
        *(half8*)(st0 + (buf ^ 1) * AT_STAGE + loff) = pk; *(half8*)(st0 + (buf ^ 1) * AT_STAGE + 64 * AT_ROW + loff) = pv; w0 = w0p; w1 = w1p;
        jb = jn; jn = nextv(jb + 1); buf ^= 1;
        if (jn < jb1) { pk = *(const half8*)(gk + (size_t)jn * 64 * 64); pv = *(const half8*)(gv + (size_t)jn * 64); if (HASMASK) { w0p = mrow[2 * jn]; w1p = mrow[2 * jn + 1]; } }
        __syncthreads();
    }
}
DI void store_o(h16* dst  , const f32x16& o0, const f32x16& o1, int hf) {
    _Pragma("unroll") for (int g = 0; g < 4; ++g) { half4 a, b; _Pragma("unroll") for (int j = 0; j < 4; ++j) { a[j] = (h16)o0[4 * g + j]; b[j] = (h16)o1[4 * g + j]; }
        *(half4*)(dst + 8 * g + 4 * hf) = a; *(half4*)(dst + 32 + 8 * g + 4 * hf) = b; }
}
DI void dsa_attn_wave(const Ctx& c, int b, int t0) {
    const int lane = c.lane, r = lane & 31, hf = lane >> 5, hd = r & 3, t = t0 + (r >> 2), m = b * T + t;
    const h16* zq = c.W<h16>(WS_Z) + (size_t)m * ZC + C_QA + hd * 64 + 8 * hf;
    half8 qf[4]; _Pragma("unroll") for (int ks = 0; ks < 4; ++ks) qf[ks] = *(const half8*)(zq + 16 * ks);
    const h16* Kb = c.W<h16>(WS_KA) + (size_t)b * T * 64; const h16* Vt = c.W<h16>(WS_VAT) + (size_t)b * 64 * T;
    const unsigned* mrow = c.W<unsigned>(WS_DMASK) + (size_t)m * 64;
    Flash f; f.init();
    flash_pass_wg<true>(f, qf, Kb, Vt, T, mrow, 0, (t0 >> 6) + 1, 0xFFFFFFFFu, c.lds, c.tid, [&](int i, int key, unsigned word) { return ((word >> (key & 31)) & 1u) != 0u; },
                     [&](int, unsigned word) { return __ballot(word != 0xFFFFFFFFu) == 0ull; });
    const float lt = f.l + shx(f.l, 32), inv = rcpf_(lt);
    _Pragma("unroll") for (int i = 0; i < 16; ++i) { f.o0[i] *= inv; f.o1[i] *= inv; }
    store_o(c.W<h16>(WS_ACT) + (size_t)m * D + hd * 64, f.o0, f.o1, hf);
}
DI void nsa_attn_wave(const Ctx& c, int b, int t0) {
    const int lane = c.lane, w = c.wave, r = lane & 31, hf = lane >> 5, hd = r & 3, qi = r >> 2, t = t0 + qi, m = b * T + t;
    const h16* zrow = c.W<h16>(WS_Z) + (size_t)m * ZC;
    half8 qf[4]; _Pragma("unroll") for (int ks = 0; ks < 4; ++ks) qf[ks] = *(const half8*)(zrow + C_QC + hd * 64 + 8 * hf + 16 * ks);
    const float g0 = sigmoidf_((float)zrow[C_GC + hd * 3 + 0]), g1 = sigmoidf_((float)zrow[C_GC + hd * 3 + 1]), g2 = sigmoidf_((float)zrow[C_GC + hd * 3 + 2]);
    float* GS = (float*)(c.lds + w * 4096); float* LA = GS + 256; float* IMPF = GS + 512; unsigned* SELM = (unsigned*)(GS + 768);
    float* APARK = (float*)(c.lds + 73728 + w * 8192) + lane;
    {
        const h16* Kc = c.W<h16>(WS_KCMP) + (size_t)b * 128 * 64; const h16* Vc = c.W<h16>(WS_VCMPT) + (size_t)b * 64 * 128;
        const int nmax = t >= 31 ? ((t - 31) >> 4) : -1;
        f32x16 s[4]; float mxv = -1e30f;
        _Pragma("unroll") for (int tl = 0; tl < 4; ++tl) { const h16* kr = Kc + (size_t)(32 * tl + r) * 64 + 8 * hf; f32x16 a = {};
            _Pragma("unroll") for (int ks = 0; ks < 4; ++ks) { const half8 kf = *(const half8*)(kr + 16 * ks); a = MFMA32(kf, qf[ks], a); }
            _Pragma("unroll") for (int i = 0; i < 16; ++i) { const int n = 32 * tl + crow(i, hf); a[i] = n <= nmax ? a[i] : -3.0e38f; mxv = fmaxf(mxv, a[i]); }
            s[tl] = a; }
        mxv = fmaxf(mxv, shx(mxv, 32));
        float sum = 0.f;
        _Pragma("unroll") for (int tl = 0; tl < 4; ++tl) _Pragma("unroll") for (int i = 0; i < 16; ++i) { const float p = __builtin_amdgcn_exp2f(s[tl][i] - mxv); s[tl][i] = p; sum += p; }
        sum += shx(sum, 32);
        const float inv = sum > 0.f ? rcpf_(sum) : 0.f;
        f32x16 o0 = {}, o1 = {};
        _Pragma("unroll") for (int tl = 0; tl < 4; ++tl) { _Pragma("unroll") for (int i = 0; i < 16; ++i) s[tl][i] *= inv;
            _Pragma("unroll") for (int st = 0; st < 2; ++st) { half8 pf; _Pragma("unroll") for (int j = 0; j < 8; ++j) pf[j] = (h16)s[tl][8 * st + j];
                const h16* vp0 = Vc + (size_t)r * 128 + 32 * tl + 16 * st + 4 * hf; const h16* vp1 = vp0 + 32 * 128;
                const half4 x0 = *(const half4*)vp0, y0 = *(const half4*)(vp0 + 8), x1 = *(const half4*)vp1, y1 = *(const half4*)(vp1 + 8);
                o0 = MFMA32(__builtin_shufflevector(x0, y0, 0, 1, 2, 3, 4, 5, 6, 7), pf, o0); o1 = MFMA32(__builtin_shufflevector(x1, y1, 0, 1, 2, 3, 4, 5, 6, 7), pf, o1); } }
        _Pragma("unroll") for (int i = 0; i < 16; ++i) { APARK[i * 64] = g0 * o0[i]; APARK[(16 + i) * 64] = g0 * o1[i]; }
        _Pragma("unroll") for (int tl = 0; tl < 4; ++tl) _Pragma("unroll") for (int g = 0; g < 4; ++g) { const int G = 8 * tl + 2 * g + hf;
            const float gs = quad_sum((s[tl][4 * g] + s[tl][4 * g + 1]) + (s[tl][4 * g + 2] + s[tl][4 * g + 3])); const float la = quad_sum(s[tl][4 * g + 3]);
            if (hd == 0) { GS[qi * 32 + G] = gs; LA[qi * 32 + G] = la; } }
        WSYNC();
        _Pragma("unroll") for (int it = 0; it < 4; ++it) { const int q = (lane >> 5) + 2 * it, j = lane & 31, tq = t0 + q, cur = tq >> 6;
            const float imp = GS[q * 32 + j] + (j > 0 ? LA[q * 32 + j - 1] : 0.f);
            const bool adm = (j * 64 <= tq), forced = (j == 0) || (j == cur) || (j == cur - 1);
            IMPF[q * 32 + j] = adm ? (forced ? __builtin_inff() : imp) : -__builtin_inff(); }
        WSYNC();
        _Pragma("unroll") for (int it = 0; it < 4; ++it) { const int q = (lane >> 5) + 2 * it, j = lane & 31; const float mv = IMPF[q * 32 + j]; int rank = 0;
            _Pragma("unroll") for (int jj = 0; jj < 32; ++jj) { const float ov = IMPF[q * 32 + jj]; rank += (ov > mv || (ov == mv && jj < j)) ? 1 : 0; }
            const unsigned long long bs = __ballot(rank < 16);
            if (lane == 0) { SELM[2 * it] = (unsigned)bs; SELM[2 * it + 1] = (unsigned)(bs >> 32); } }
        WSYNC();
    }
    const unsigned selmask = SELM[qi];
    WSYNC();
    {
        const h16* Kb = c.W<h16>(WS_KS) + (size_t)b * T * 64; const h16* Vt = c.W<h16>(WS_VST) + (size_t)b * 64 * T;
        Flash f; f.init();
        unsigned um = 0u; for (int j = 0; j < 32; ++j) if (__ballot(((selmask >> j) & 1u) != 0u) != 0ull) um |= 1u << j;
        unsigned* UM = (unsigned*)(c.lds + AT_LDS - 64);
        if (lane == 0) UM[w] = um;
        __syncthreads();
        um = UM[0] | UM[1] | UM[2] | UM[3] | UM[4] | UM[5] | UM[6] | UM[7];
        flash_pass_wg<false>(f, qf, Kb, Vt, T, nullptr, 0, (t0 >> 6) + 1, um, c.lds, c.tid, [&](int i, int key, unsigned) { return (((selmask >> (key >> 6)) & 1u) != 0u) && key <= t; },
                          [&](int key0, unsigned) { return key0 + 31 <= t0 && __ballot(((selmask >> (key0 >> 6)) & 1u) == 0u) == 0ull; });
        const float lt = f.l + shx(f.l, 32), sc = g1 * rcpf_(lt);
        _Pragma("unroll") for (int i = 0; i < 16; ++i) { APARK[i * 64] += sc * f.o0[i]; APARK[(16 + i) * 64] += sc * f.o1[i]; }
    }
    {
        const h16* Kb = c.W<h16>(WS_KW) + (size_t)b * T * 64; const h16* Vt = c.W<h16>(WS_VWT) + (size_t)b * 64 * T;
        Flash f; f.init();
        const int lo = (t0 - 511 > 0 ? t0 - 511 : 0) >> 5, hiT = (t0 + 7) >> 5;
        flash_pass_wg<false>(f, qf, Kb, Vt, T, nullptr, (((t0 & ~63) - 511 > 0 ? (t0 & ~63) - 511 : 0) >> 6), (t0 >> 6) + 1, 0xFFFFFFFFu, c.lds, c.tid, [&](int i, int key, unsigned) { return key <= t && key > t - 512; },
                          [&](int key0, unsigned) { return key0 + 31 <= t0 && key0 > t0 + 7 - 512; });
        const float lt = f.l + shx(f.l, 32), sc = g2 * rcpf_(lt);
        _Pragma("unroll") for (int i = 0; i < 16; ++i) { f.o0[i] = APARK[i * 64] + sc * f.o0[i]; f.o1[i] = APARK[(16 + i) * 64] + sc * f.o1[i]; }
        store_o(c.W<h16>(WS_ACT) + (size_t)m * D + 768 + hd * 64, f.o0, f.o1, hf);
    }
}

constexpr int RW_KRT = 0, RW_G = 4608, RW_VT = 9728, RW_BBT = 12800, RW_TT = 14336, RW_NAPT = 15872, RW_PL = 17408, RW_SLOT = 17664;
constexpr int RW_PRIV = 6 * RW_SLOT, RW_BK = 0, RW_AF = 4608, RW_PRIVSZ = 5632;
DI float wave_sum_fast(float x) {
    x += dpp_f<0xB1>(x); x += dpp_f<0x4E>(x); x += dpp_f<0x141>(x); x += dpp_f<0x140>(x);
    return (__builtin_amdgcn_readlane(__builtin_bit_cast(int, x), 0) == 0 ? 0.f : 0.f) +
           (__builtin_bit_cast(float, __builtin_amdgcn_readlane(__builtin_bit_cast(int, x), 0)) + __builtin_bit_cast(float, __builtin_amdgcn_readlane(__builtin_bit_cast(int, x), 16))) +
           (__builtin_bit_cast(float, __builtin_amdgcn_readlane(__builtin_bit_cast(int, x), 32)) + __builtin_bit_cast(float, __builtin_amdgcn_readlane(__builtin_bit_cast(int, x), 48)));
}
DI half8 pack8r(const f32x16& s, int st) { half8 o; _Pragma("unroll") for (int j = 0; j < 8; ++j) o[j] = (h16)s[8 * st + j]; return o; }
DI half8 ld2x4_unused(const char* p) { const half4 a = *(const half4*)p, b = *(const half4*)(p + 16); return __builtin_shufflevector(a, b, 0, 1, 2, 3, 4, 5, 6, 7); }
DI void rwkv_item(const Ctx& c, int l, int item) {
    const int b = item >> 3, h = item & 7; const int lane = c.lane, w = c.wave;
    char* L = c.lds;
    const h16* Z = c.W<h16>(WS_Z); const h16* DEC = c.W<h16>(WS_DEC); const h16* AA = c.W<h16>(WS_A); h16* MIX = c.W<h16>(WS_ACT);
    const float* mu = c.inl(I_MU, l, 1792); const float* k_k = c.inl(I_KK, l, 512); const float* k_a = c.inl(I_KA, l, 512);
    const int col = h * 64 + lane;
    const float c_mur = mu[col], c_muk = mu[512 + col], c_muv = mu[1024 + col], c_kk = k_k[col], c_ka = k_a[col];
    const int r = lane & 31, hf = lane >> 5;
    f32x16 ST0 = {}, ST1 = {};
    volatile int* PROD = (volatile int*)(L + RW_PRIV + 6 * RW_PRIVSZ); volatile int* CONS = PROD + 8;
    __syncthreads();
    if (c.tid < 16) PROD[c.tid] = 0;
    __syncthreads();
    for (int R = 0; R < 22; ++R) {
        if (w >= 2) {
            const int hw = w - 2, ch = 6 * R + hw;
            if (ch < 128) {
                while (CONS[hw] != 2 * R) __builtin_amdgcn_s_sleep(1);
                asm volatile("" ::: "memory");
                char* slot = L + hw * RW_SLOT; char* priv = L + RW_PRIV + hw * RW_PRIVSZ;
                const int tt0 = 16 * ch; const size_t m0 = (size_t)b * T + tt0;
                h16 zr[17], zk[17], zv[17], zd[16], za[16];
                _Pragma("unroll") for (int q = 0; q < 17; ++q) { const bool ok = (tt0 + q - 1) >= 0; const h16* zp = Z + (m0 + (ok ? q - 1 : 0)) * ZC;
                    zr[q] = zp[C_R + col]; zk[q] = zp[C_K + col]; zv[q] = zp[C_V + col]; }
                if (tt0 == 0) { zr[0] = (h16)0; zk[0] = (h16)0; zv[0] = (h16)0; }
                _Pragma("unroll") for (int q = 0; q < 16; ++q) { zd[q] = DEC[(m0 + q) * 512 + col]; za[q] = AA[(m0 + q) * 512 + col]; }
                float P = 1.f; float bt[16], kl[16]; half8 vlo, vhi;
                h16* KRT = (h16*)(slot + RW_KRT); h16* BK = (h16*)(priv + RW_BK);
                _Pragma("unroll") for (int q = 0; q < 16; ++q) {
                    const float r0 = (float)zr[q + 1], k0 = (float)zk[q + 1], v0 = (float)zv[q + 1];
                    const float rr = r0 + ((float)zr[q] - r0) * c_mur, kx = k0 + ((float)zk[q] - k0) * c_muk, vv = v0 + ((float)zv[q] - v0) * c_muv;
                    const float kr = kx * c_kk; const float ss = wave_sum_fast(kr * kr);
                    const float kk = kr * rcpf_(fmaxf(__builtin_amdgcn_sqrtf(ss), 1e-12f)); const float a = (float)za[q];
                    const float kp = kx * (1.f + (a - 1.f) * c_ka), bb = kk * a;
                    const float Pprev = P; P *= (float)zd[q]; const float iP = rcpf_(P);
                    bt[q] = fminf(fmaxf(bb * iP, -60000.f), 60000.f); kl[q] = fminf(fmaxf(kp * iP, -60000.f), 60000.f);
                    KRT[q * 72 + lane] = (h16)(Pprev * kk); KRT[(16 + q) * 72 + lane] = (h16)(P * rr);
                    BK[q * 72 + lane] = (h16)bt[q]; BK[(16 + q) * 72 + lane] = (h16)kl[q];
                    if (q < 8) vlo[q] = (h16)vv; else vhi[q - 8] = (h16)vv;
                }
                { h16* VT = (h16*)(slot + RW_VT) + lane * 24; *(half8*)VT = vlo; *(half8*)(VT + 8) = vhi; }
                ((float*)(slot + RW_PL))[lane] = P;
                { h16* G = (h16*)(slot + RW_G) + lane * 40; half8 g0, g1, g2, g3;
                  _Pragma("unroll") for (int q = 0; q < 8; ++q) { g0[q] = (h16)(-bt[q] * P); g1[q] = (h16)(-bt[8 + q] * P); g2[q] = (h16)(kl[q] * P); g3[q] = (h16)(kl[8 + q] * P); }
                  *(half8*)G = g0; *(half8*)(G + 8) = g1; *(half8*)(G + 16) = g2; *(half8*)(G + 24) = g3; }
                WSYNC();
                f32x16 M = {};
                _Pragma("unroll") for (int ks = 0; ks < 4; ++ks) { const half8 af = *(const half8*)(BK + r * 72 + 16 * ks + 8 * hf), bf = *(const half8*)(KRT + r * 72 + 16 * ks + 8 * hf); M = MFMA32(af, bf, M); }
                float* AF = (float*)(priv + RW_AF); h16* BBT = (h16*)(slot + RW_BBT); h16* NAPT = (h16*)(slot + RW_NAPT); h16* TT = (h16*)(slot + RW_TT);
                const int n = r;
                _Pragma("unroll") for (int q = 0; q < 8; ++q) { const int sidx = crow(q, hf);
                    if (n < 16) { AF[sidx * 16 + n] = sidx < n ? M[q] : 0.f; NAPT[n * 24 + sidx] = (h16)0.f; }
                    else NAPT[n * 24 + sidx] = (h16)(sidx <= n - 16 ? -M[q] : 0.f); }
                _Pragma("unroll") for (int q = 8; q < 16; ++q) { const int sidx = crow(q, hf) - 16;
                    BBT[n * 24 + sidx] = (h16)((n < 16 ? sidx < n : sidx <= n - 16) ? M[q] : 0.f); }
                WSYNC();
                if (lane < 32) { float x[16];
                    {
                        f32x4 ar[8][2];
                        _Pragma("unroll") for (int q = 0; q < 8; ++q) { ar[q][0] = *(const f32x4*)(AF + (8 + q) * 16 + 8); ar[q][1] = *(const f32x4*)(AF + (8 + q) * 16 + 12); }
                        _Pragma("unroll") for (int sidx = 15; sidx >= 8; --sidx) { float acc = (sidx == lane) ? 1.f : 0.f;
                            _Pragma("unroll") for (int mm = sidx + 1; mm < 16; ++mm) acc -= ar[sidx - 8][(mm - 8) >> 2][(mm - 8) & 3] * x[mm];
                            x[sidx] = acc; } }
                    {
                        f32x4 ar[8][4];
                        _Pragma("unroll") for (int q = 0; q < 8; ++q) _Pragma("unroll") for (int g = 0; g < 4; ++g) ar[q][g] = *(const f32x4*)(AF + q * 16 + 4 * g);
                        _Pragma("unroll") for (int sidx = 7; sidx >= 0; --sidx) { float acc = (sidx == lane) ? 1.f : 0.f;
                            _Pragma("unroll") for (int mm = sidx + 1; mm < 16; ++mm) acc -= ar[sidx][mm >> 2][mm & 3] * x[mm];
                            x[sidx] = acc; } }
                    half8 t0, t1; _Pragma("unroll") for (int q = 0; q < 8; ++q) { t0[q] = (h16)(lane < 16 ? x[q] : 0.f); t1[q] = (h16)(lane < 16 ? x[8 + q] : 0.f); }
                    *(half8*)(TT + lane * 24) = t0; *(half8*)(TT + lane * 24 + 8) = t1; }
                WSYNC();
                if (lane == 0) PROD[hw] = R + 1;
            }
        }
        if (w < 2) {
            _Pragma("unroll 1") for (int hw = 0; hw < 6; ++hw) { const int ch = 6 * R + hw; if (ch >= 128) break;
                while (PROD[hw] != R + 1) __builtin_amdgcn_s_sleep(1);
                asm volatile("" ::: "memory");
                const char* slot = L + hw * RW_SLOT;
                const char* KRT = slot + RW_KRT; const char* G = slot + RW_G;
                const half8 sf00 = pack8r(ST0, 0), sf01 = pack8r(ST0, 1), sf10 = pack8r(ST1, 0), sf11 = pack8r(ST1, 1);
                f32x16 X = {};
                X = MFMA32(ld2x4(KRT + r * 144 + (0 + 4 * hf) * 2), sf00, X);
                X = MFMA32(ld2x4(KRT + r * 144 + (16 + 4 * hf) * 2), sf01, X);
                X = MFMA32(ld2x4(KRT + r * 144 + (32 + 4 * hf) * 2), sf10, X);
                X = MFMA32(ld2x4(KRT + r * 144 + (48 + 4 * hf) * 2), sf11, X);
                const half8 vtf = *(const half8*)(slot + RW_VT + (32 * w + r) * 48 + 16 * hf);
                X = MFMA32(*(const half8*)(slot + RW_BBT + r * 48 + 16 * hf), vtf, X);
                f32x16 U = {};
                U = MFMA32(ld2x4(slot + RW_TT + r * 48 + 8 * hf), pack8r(X, 0), U);
                const half8 uu = pack8r(U, 0);
                X = MFMA32(ld2x4(slot + RW_NAPT + r * 48 + 8 * hf), uu, X);
                { h16* yo = MIX + ((size_t)b * T + 16 * ch) * D + 256 + h * 64 + 32 * w + r;
                  _Pragma("unroll") for (int q = 8; q < 16; ++q) yo[(size_t)(crow(q, hf) - 16) * D] = (h16)X[q]; }
                const float* PLp = (const float*)(slot + RW_PL);
                _Pragma("unroll") for (int g = 0; g < 4; ++g) { const f32x4 p0 = *(const f32x4*)(PLp + 8 * g + 4 * hf), p1 = *(const f32x4*)(PLp + 32 + 8 * g + 4 * hf);
                    _Pragma("unroll") for (int q = 0; q < 4; ++q) { ST0[4 * g + q] *= p0[q]; ST1[4 * g + q] *= p1[q]; } }
                ST0 = MFMA32(ld2x4(G + r * 80 + 8 * hf), uu, ST0);
                ST0 = MFMA32(*(const half8*)(G + r * 80 + 32 + 16 * hf), vtf, ST0);
                ST1 = MFMA32(ld2x4(G + (32 + r) * 80 + 8 * hf), uu, ST1);
                ST1 = MFMA32(*(const half8*)(G + (32 + r) * 80 + 32 + 16 * hf), vtf, ST1);
                WSYNC();
                if (lane == 0) __hip_atomic_fetch_add((int*)&CONS[hw], 1, __ATOMIC_RELAXED, __HIP_MEMORY_SCOPE_WORKGROUP);
            }
        }
    }
    __syncthreads();
}

DI void phase_rwkv_post(const Ctx& c, int l) {
    const h16* Z = c.W<h16>(WS_Z); const h16* AA = c.W<h16>(WS_A); const h16* GG = c.W<h16>(WS_G); h16* MIX = c.W<h16>(WS_ACT);
    const float* mu = c.inl(I_MU, l, 1792); const float* k_a = c.inl(I_KA, l, 512); const float* r_k = c.inl(I_RK, l, 512); const float* ln_w = c.inl(I_LNW, l, 512); const float* ln_b = c.inl(I_LNB, l, 512);
    const int col = c.lane * 8;
    float c_mur[8], c_muk[8], c_muv[8], c_ka[8], c_rk[8], c_lw[8], c_lb[8];
    _Pragma("unroll") for (int q = 0; q < 8; ++q) { c_mur[q] = mu[col + q]; c_muk[q] = mu[512 + col + q]; c_muv[q] = mu[1024 + col + q]; c_ka[q] = k_a[col + q]; c_rk[q] = r_k[col + q]; c_lw[q] = ln_w[col + q]; c_lb[q] = ln_b[col + q]; }
    for (int m = c.gw; m < M; m += c.ngw) {
        const int t = m & 2047; const h16* zr = Z + (size_t)m * ZC;
        const half8 y8 = *(const half8*)(MIX + (size_t)m * D + 256 + col);
        const half8 r8 = *(const half8*)(zr + C_R + col), k8 = *(const half8*)(zr + C_K + col), v8 = *(const half8*)(zr + C_V + col);
        half8 rp = {0, 0, 0, 0, 0, 0, 0, 0}, kp_ = rp, vp = rp;
        if (t > 0) { rp = *(const half8*)(zr - ZC + C_R + col); kp_ = *(const half8*)(zr - ZC + C_K + col); vp = *(const half8*)(zr - ZC + C_V + col); }
        const half8 a8 = *(const half8*)(AA + (size_t)m * 512 + col), g8 = *(const half8*)(GG + (size_t)m * 512 + col);
        float y[8], vv[8]; float sum = 0.f, bs = 0.f;
        _Pragma("unroll") for (int q = 0; q < 8; ++q) { const float r0 = (float)r8[q], k0 = (float)k8[q], v0 = (float)v8[q], a = (float)a8[q];
            const float rr = r0 + ((float)rp[q] - r0) * c_mur[q], kx = k0 + ((float)kp_[q] - k0) * c_muk[q]; vv[q] = v0 + ((float)vp[q] - v0) * c_muv[q];
            const float kp = kx * (1.f + (a - 1.f) * c_ka[q]); y[q] = (float)y8[q]; sum += y[q]; bs += rr * kp * c_rk[q]; }
        const float mean = red8(sum) * (1.f / 64.f); bs = red8(bs);
        float vs = 0.f; _Pragma("unroll") for (int q = 0; q < 8; ++q) { const float d = y[q] - mean; vs += d * d; }
        const float rstd = rsqf_(red8(vs) * (1.f / 64.f) + 64e-5f);
        half8 o;
        _Pragma("unroll") for (int q = 0; q < 8; ++q) o[q] = (h16)((((y[q] - mean) * rstd * c_lw[q] + c_lb[q]) + bs * vv[q]) * (float)g8[q]);
        *(half8*)(MIX + (size_t)m * D + 256 + col) = o;
    }
}

DI void phase_cmp2(const Ctx& c, int l) {
    const h16* HID = c.W<h16>(WS_HID); const float* w2 = c.inl(I_NW2, l, 2 * 256 * 64); const float* nkg = c.inl(I_NKG, l, 64);
    const int lane = c.lane; const bool hi = lane >= 32; const float inv = powf(10000.f, -(float)(lane & 31) * (1.f / 32.f));
    for (int it = c.gw; it < 2 * 1024; it += c.ngw) { const int j = it >> 10, rrow = it & 1023, b = rrow >> 7, n = rrow & 127;
        float acc = 0.f;
        if (n < 127) { const h16* hr = HID + ((size_t)j * 1024 + rrow) * 256; const float* wj = w2 + (size_t)j * 256 * 64;
            float a4[4] = {0.f, 0.f, 0.f, 0.f};
            _Pragma("unroll 2") for (int k = 0; k < 256; k += 32) {
                _Pragma("unroll") for (int u = 0; u < 4; ++u) { const half8 hv = *(const half8*)(hr + k + 8 * u); _Pragma("unroll") for (int q = 0; q < 8; ++q) a4[u] += (float)hv[q] * wj[(k + 8 * u + q) * 64 + lane]; } }
            acc = (a4[0] + a4[1]) + (a4[2] + a4[3]); }
        if (j == 0) { const float ss = wave_sum(acc * acc); float y = acc * rsqf_(ss * (1.f / 64.f) + 1e-6f) * nkg[lane];
            const float ang = (float)(16 * n + 31) * inv; const float cs = cosf(ang), sn = sinf(ang); const float o = shx(y, 32); y = hi ? y * cs + o * sn : y * cs - o * sn;
            c.W<h16>(WS_KCMP)[((size_t)b * 128 + n) * 64 + lane] = (h16)(n < 127 ? y : 0.f); }
        else c.W<h16>(WS_VCMPT)[((size_t)b * 64 + lane) * 128 + n] = (h16)acc; }
}

__global__ void __launch_bounds__(NTHREADS) fwd_kernel(Params p) {
    extern __shared__ __attribute__((aligned(16))) char lds[];
    cg::grid_group grid = cg::this_grid();
    Ctx c; c.out = p.out; c.ws = p.ws; c.lds = lds; c.ctl = (unsigned*)(p.ws + WS_CTL);
    c.wave = __builtin_amdgcn_readfirstlane(threadIdx.x >> 6); c.lane = lane_id(); c.tid = c.wave * 64 + c.lane; c.gw = blockIdx.x * 8 + c.wave; c.ngw = gridDim.x * 8;
    if (c.tid < 28) ((const float**)(p.ws + WS_PTRS))[c.tid] = p.in[c.tid];
    unsigned* xbar = c.ctl + 4096;
    if (c.tid == 0) { s_xb[0] = 0u; s_xb[1] = 0u; (void)xb_add(&xbar[XB_XCNT(xb_xcc_id())], 1u); }
    __threadfence(); __syncthreads();
#define GSYNC() do { xcd_barrier(c.ctl + 4096, c.tid); PH(); } while (0)
    h16* ACT = c.W<h16>(WS_ACT); h16* Z = c.W<h16>(WS_Z);

#define PH() do { c.ws = launder_ptr(c.ws); c.out = launder_ptr(c.out); c.lane = lane_id(); asm volatile("" : "+v"(c.lane)); c.tid = c.wave * 64 + c.lane; c.gw = blockIdx.x * 8 + c.wave; } while (0)
    phase_mod(c);
#pragma unroll 1
    for (int l = 0; l < DEPTH; ++l) {
        const float* mod_l = c.W<float>(WS_MOD) + (size_t)l * 8 * 6144;
        PH(); convert_weights(c, l);
        PH(); phase_cbias(c, l);
        if (l == 0) grid.sync();
        PH();
        phase_norm(c, l == 0 ? c.inp(I_X) : c.out, c.inl(I_N1G, l, D), mod_l, 0, 1024);
        GSYNC();
        phase_gemm(c, ACT, D, c.W<h16>(WS_WIN), D, D, 64, 13, EpiZ{Z, ZC});
        GSYNC();
        phase_prep(c, l);
        GSYNC();
        {
            const int nq = gridDim.x >= 8 ? 8 : 1, qid = (int)blockIdx.x % nq;
            unsigned* ctr = c.ctl + 512 + 512 * (2 * l) + 64 * qid;
            for (;;) { const int it = next_item(ctr, c.tid) * nq + qid; if (it >= 8 + 384 + 1024) break; PH();
                if (it < 8) { const int j = it >> 2, pm = it & 3;
                    gemm_unit(c.tid, c.W<h16>(j ? WS_VC : WS_KC), 1024, c.W<h16>(WS_W1) + (size_t)j * 256 * 2048, 2048, 2048, pm * 256, 0, (h16*)lds, EpiCmp{c.W<h16>(WS_HID) + (size_t)j * 1024 * 256, c.W<float>(WS_CBIAS) + j * 256}); }
                else if (it < 392) { const int u = it - 8, pm = u / 6, pn = u % 6;
                    gemm_unit(c.tid, c.W<h16>(WS_L16), 256, c.W<h16>(WS_WL), 256, 256, pm * 256, pn * 256, (h16*)lds, EpiLora{c.W<h16>(WS_DEC), c.W<h16>(WS_A), c.W<h16>(WS_G), c.inl(I_W0, l, 512), c.inl(I_A0, l, 512)}); }
                else dsa_select_item(c, 1023 - (it - 392)); }
        }
        GSYNC();
        phase_cmp2(c, l);
        GSYNC();
        {
            const int nq = gridDim.x >= 8 ? 8 : 1, qid = (int)blockIdx.x % nq;
            unsigned* ctr = c.ctl + 512 + 512 * (2 * l + 1) + 64 * qid;
            for (;;) { const int it = next_item(ctr, c.tid) * nq + qid; if (it >= 64 + 512) break; PH();
                if (it < 64) rwkv_item(c, l, it);
                else { const int a = it - 64; const int kind = a >> 8, idx = 255 - (a & 255); const int b = idx & 7, qb = idx >> 3; const int t0 = qb * 64 + c.wave * 8;
                    if (kind == 0) nsa_attn_wave(c, b, t0); else dsa_attn_wave(c, b, t0); } }
        }
        GSYNC();
        phase_rwkv_post(c, l);
        GSYNC();
        phase_gemm(c, ACT, D, c.W<h16>(WS_WOUT), D, D, 64, 4, EpiRes{l == 0 ? c.inp(I_X) : c.out, c.out, mod_l + 2048});
        GSYNC();
        phase_norm(c, c.out, c.inl(I_N2G, l, D), mod_l, 3072, 4096);
        GSYNC();
        phase_gemm(c, ACT, D, c.W<h16>(WS_WI), D, D, 64, 22, EpiSwiglu{Z});
        GSYNC();
        phase_gemm(c, Z, FF, c.W<h16>(WS_WO), FF, FF, 64, 4, EpiRes{c.out, c.out, mod_l + 5120});
        if (l + 1 < DEPTH) GSYNC();
    }
}

extern "C" void kernel_launch(void* const* d_in, const int* in_sizes, int n_in, void* d_out, int out_size, void* d_ws, size_t ws_size, hipStream_t stream) {
    static int grid_blocks = 0;
    if (grid_blocks == 0) {
        if (n_in != 28 || ws_size < WS_END) { fprintf(stderr, "kernel_launch: unexpected n_in %d / ws %zu\n", n_in, ws_size); grid_blocks = -1; return; }
        int dev = 0, cus = 0, per_cu = 0;
        hipGetDevice(&dev); hipDeviceGetAttribute(&cus, hipDeviceAttributeMultiprocessorCount, dev);
        hipFuncSetAttribute((const void*)fwd_kernel, hipFuncAttributeMaxDynamicSharedMemorySize, LDS_BYTES);
        hipOccupancyMaxActiveBlocksPerMultiprocessor(&per_cu, (const void*)fwd_kernel, NTHREADS, LDS_BYTES);
        if (per_cu < 1) { fprintf(stderr, "kernel_launch: occupancy query says %d blocks/CU\n", per_cu); per_cu = 1; }
        grid_blocks = cus * 1;
    }
    if (grid_blocks < 0) return;
    hipMemsetAsync((char*)d_ws + WS_CTL, 0, 64 * 1024, stream);
    Params p{};
    for (int i = 0; i < 28; ++i) p.in[i] = (const float*)d_in[i];
    p.out = (float*)d_out; p.ws = (unsigned char*)d_ws;
    void* args[] = {&p};
    hipError_t e = hipLaunchCooperativeKernel((const void*)fwd_kernel, dim3(grid_blocks), dim3(NTHREADS), args, LDS_BYTES, stream);
    if (e != hipSuccess) fprintf(stderr, "cooperative launch failed: %s (grid %d)\n", hipGetErrorString(e), grid_blocks);
}
```

```cpp
#include <hip/hip_runtime.h>
#include <hip/hip_cooperative_groups.h>
#include <cstdio>
#include <cstdint>
namespace cg = cooperative_groups;

typedef _Float16 h16;
typedef _Float16 half8 __attribute__((ext_vector_type(8)));
typedef _Float16 half4 __attribute__((ext_vector_type(4)));
typedef float f32x4 __attribute__((ext_vector_type(4)));
typedef float f32x16 __attribute__((ext_vector_type(16)));
#define LAS __attribute__((address_space(3)))
#define DI __device__ __forceinline__

constexpr int D = 1024, NB = 8, T = 2048, M = NB * T, FF = 2816, DEPTH = 2;
constexpr int ZC = 3328;
constexpr int C_QA = 0, C_KA = 256, C_VA = 320, C_IQ = 384, C_IK = 640, C_IW = 704;
constexpr int C_R = 768, C_K = 1280, C_V = 1792, C_WD = 2304;
constexpr int C_QC = 2560, C_KC = 2816, C_VC = 2880, C_KS = 2944, C_VS = 3008, C_KW = 3072, C_VW = 3136, C_GC = 3200;
constexpr int NTHREADS = 512;
constexpr int LDS_BYTES = 143360;

constexpr size_t MiB = 1u << 20;
constexpr size_t WS_CTL = 0;
constexpr size_t WS_PTRS = 60 * 1024;
constexpr size_t WS_MOD = 64 * 1024;
constexpr size_t WS_CBIAS = 512 * 1024;
constexpr size_t WS_KCMP = 1 * MiB;
constexpr size_t WS_VCMPT = 1 * MiB + 128 * 1024;
constexpr size_t WS_HID = 2 * MiB;
constexpr size_t WS_KA = 4 * MiB, WS_IK = 6 * MiB, WS_KS = 8 * MiB, WS_KW = 10 * MiB;
constexpr size_t WS_VAT = 12 * MiB, WS_VST = 14 * MiB, WS_VWT = 16 * MiB;
constexpr size_t WS_DMASK = 18 * MiB;
constexpr size_t WS_WIN = 22 * MiB;
constexpr size_t WS_WOUT = WS_WIN + 6656 * 1024;
constexpr size_t WS_WI = WS_WOUT + 2 * MiB;
constexpr size_t WS_WO = WS_WI + 11 * MiB;
constexpr size_t WS_W1 = WS_WO + 5632 * 1024;
constexpr size_t WS_WL = WS_W1 + 2 * MiB;
constexpr size_t WS_ACT = 50 * MiB;
constexpr size_t WS_L16 = WS_ACT, WS_KC = WS_ACT + 8 * MiB, WS_VC = WS_ACT + 12 * MiB;
constexpr size_t WS_DEC = 82 * MiB, WS_A = 98 * MiB, WS_G = 114 * MiB;
constexpr size_t WS_Z = 130 * MiB;
constexpr size_t WS_END = 234 * MiB;
static_assert(WS_WL + 768 * 1024 <= WS_ACT, "weights fit");

struct Params { const float* in[28]; float* out; unsigned char* ws; };
enum { I_X = 0, I_C, I_ADAW, I_ADAB, I_N1G, I_WIN, I_DQG, I_DKG, I_MU, I_W0, I_W2, I_A0, I_A2, I_G2, I_KK, I_KA, I_RK, I_LNW, I_LNB,
       I_NQG, I_NKG, I_PE, I_NW1, I_NW2, I_WOUT, I_N2G, I_FWI, I_FWO };

DI int lane_id_fresh() { int l = (int)__builtin_amdgcn_mbcnt_hi(~0u, __builtin_amdgcn_mbcnt_lo(~0u, 0u)); asm volatile("" : "+v"(l)); return l; }
DI float shx(float x, int m) { return __builtin_bit_cast(float, __builtin_amdgcn_ds_bpermute((lane_id_fresh() ^ m) << 2, __builtin_bit_cast(int, x))); }
DI int shx(int x, int m) { return __builtin_amdgcn_ds_bpermute((lane_id_fresh() ^ m) << 2, x); }
template <int CTRL> DI float dpp_f(float x) { return __builtin_bit_cast(float, __builtin_amdgcn_update_dpp(0, __builtin_bit_cast(int, x), CTRL, 0xF, 0xF, true)); }
DI float quad_sum(float x) { x += dpp_f<0xB1>(x); x += dpp_f<0x4E>(x); return x; }
DI float red8(float x) { x += dpp_f<0xB1>(x); x += dpp_f<0x4E>(x); x += dpp_f<0x141>(x); return x; }
DI float red16(float x) { x += shx(x, 1); x += shx(x, 2); x += shx(x, 4); x += shx(x, 8); return x; }
DI float wave_sum(float x) { for (int o = 1; o < 64; o <<= 1) x += shx(x, o); return x; }
DI float rcpf_(float x) { return __builtin_amdgcn_rcpf(x); }
DI float rsqf_(float x) { return __builtin_amdgcn_rsqf(x); }
DI float wave_sum_dpp(float x) {
    x += dpp_f<0xB1>(x); x += dpp_f<0x4E>(x); x += dpp_f<0x141>(x); x += dpp_f<0x140>(x);
    return (__builtin_bit_cast(float, __builtin_amdgcn_readlane(__builtin_bit_cast(int, x), 0)) + __builtin_bit_cast(float, __builtin_amdgcn_readlane(__builtin_bit_cast(int, x), 16))) +
           (__builtin_bit_cast(float, __builtin_amdgcn_readlane(__builtin_bit_cast(int, x), 32)) + __builtin_bit_cast(float, __builtin_amdgcn_readlane(__builtin_bit_cast(int, x), 48)));
}
DI float sigmoidf_(float x) { return rcpf_(1.f + __expf(-x)); }
DI int crow(int i, int h) { return (i & 3) + 8 * (i >> 2) + 4 * h; }
#define WSYNC() asm volatile("s_waitcnt lgkmcnt(0)" ::: "memory")
#define MFMA32(a, b, c) __builtin_amdgcn_mfma_f32_32x32x16_f16((a), (b), (c), 0, 0, 0)

template <class Tp> DI Tp* launder_ptr(Tp* p) {
    unsigned lo = (unsigned)(uintptr_t)p, hi = (unsigned)((uintptr_t)p >> 32); asm volatile("" : "+v"(lo), "+v"(hi));
    lo = __builtin_amdgcn_readfirstlane(lo); hi = __builtin_amdgcn_readfirstlane(hi); return (Tp*)(__attribute__((address_space(1))) Tp*)(((uintptr_t)hi << 32) | lo); }
DI int lane_id() { return (int)__builtin_amdgcn_mbcnt_hi(~0u, __builtin_amdgcn_mbcnt_lo(~0u, 0u)); }
__shared__ int s_item;
DI int next_item(unsigned* ctr, int tid) {
    __syncthreads();
    if (tid == 0) s_item = (int)atomicAdd(ctr, 1u);
    __syncthreads();
    return s_item;
}


#define XB_TMO      128
#define XB_XCNT(j)  (256  + 64 * (j))
#define XB_XSUB(j)  (1280 + 64 * (j))
#define XB_XGEN(j)  (2304 + 64 * (j))
#define XB_TOP      3328
#define XB_TOPGEN   3392
#define XB_SPIN_CAP (1u << 22)
DI unsigned xb_ld(unsigned* p) { return __hip_atomic_load(p, __ATOMIC_RELAXED, __HIP_MEMORY_SCOPE_AGENT); }
DI unsigned xb_add(unsigned* p, unsigned v) { return __hip_atomic_fetch_add(p, v, __ATOMIC_RELAXED, __HIP_MEMORY_SCOPE_AGENT); }
DI unsigned xb_xcc_id() { return (unsigned)__builtin_amdgcn_s_getreg((3 << 11) | 20) & 0xFu; }
#define XB_SPIN(cond, bar) do { unsigned _sp = 0; while (cond) { __builtin_amdgcn_s_sleep(1); \
    if ((++_sp & 255u) == 0u) { if (xb_ld(&(bar)[XB_TMO])) break; if (_sp > XB_SPIN_CAP) { atomicAdd(&(bar)[XB_TMO], 1u); break; } } } } while (0)
__shared__ unsigned s_xb[2];
DI void xcd_barrier_complete(unsigned* bar, unsigned x, unsigned& nloc, unsigned& nx) {
    const unsigned G = gridDim.x; unsigned sum, cnt, mine, sp = 0u;
    for (;;) { sum = 0u; cnt = 0u; mine = 0u;
        _Pragma("unroll") for (unsigned j = 0; j < 16; ++j) { const unsigned c = xb_ld(&bar[XB_XCNT(j)]); sum += c; cnt += (c > 0u) ? 1u : 0u; mine = (j == x) ? c : mine; }
        if (sum == G) break;
        __builtin_amdgcn_s_sleep(1);
        if ((++sp & 255u) == 0u) { if (xb_ld(&bar[XB_TMO])) break; if (sp > XB_SPIN_CAP) { atomicAdd(&bar[XB_TMO], 1u); break; } } }
    nloc = mine > 0u ? mine : 1u; nx = cnt > 0u ? cnt : 1u;
}
DI void xcd_barrier(unsigned* bar, int tid) {
    asm volatile("s_waitcnt vmcnt(0)" ::: "memory");
    __syncthreads();
    if (tid == 0) {
        __builtin_amdgcn_s_waitcnt(0);
        const unsigned x = xb_xcc_id();
        unsigned nloc = s_xb[0], nx = s_xb[1];
        if (nloc == 0u) { xcd_barrier_complete(bar, x, nloc, nx); s_xb[0] = nloc; s_xb[1] = nx; }
        const unsigned old = xb_add(&bar[XB_XSUB(x)], 1u);
        const unsigned gen = old / nloc;
        if (old + 1u == (gen + 1u) * nloc) {
            __builtin_amdgcn_fence(__ATOMIC_RELEASE, "agent");
            asm volatile("s_waitcnt vmcnt(0)" ::: "memory");
            const unsigned og = xb_add(&bar[XB_TOP], 1u);
            const unsigned tg = og / nx;
            if (og + 1u == (tg + 1u) * nx) xb_add(&bar[XB_TOPGEN], 1u);
            else XB_SPIN(xb_ld(&bar[XB_TOPGEN]) == tg, bar);
            __builtin_amdgcn_fence(__ATOMIC_ACQUIRE, "agent");
            xb_add(&bar[XB_XGEN(x)], 1u);
            asm volatile("s_waitcnt vmcnt(0)" ::: "memory");
        } else {
            XB_SPIN(xb_ld(&bar[XB_XGEN(x)]) == gen, bar);
            __builtin_amdgcn_fence(__ATOMIC_ACQUIRE, "agent");
            asm volatile("s_waitcnt vmcnt(0)" ::: "memory");
        }
    }
    __syncthreads();
}

constexpr int BK = 64, HALF = 128, HT = HALF * BK;
DI void stage_rc(int b, int& R, int& C) { int st = b / 1024, sb = b % 1024, swz = sb ^ (((sb >> 9) & 1) << 5); R = (st >> 1) * 16 + swz / 64; C = (st & 1) * 32 + (swz % 64) / 2; }

template <class Epi>
DI void gemm_unit(int tid_in, const h16* __restrict__ A, int lda, const h16* __restrict__ Bt, int ldb, int K, int brow, int bcol, h16* shm, const Epi& epi, bool pre_issued = false, bool has_next = false, int nbrow = 0, int nbcol = 0, bool half_m = false) {
#define SA(b, h) (shm + ((b) * 2 + (h)) * HT)
#define SB(b, h) (shm + (4 + (b) * 2 + (h)) * HT)
#define STAGE_A(P, br, kt) do { const char* _g = (const char*)(A + ((long)(br) * lda + (long)(kt) * BK)); \
    __builtin_amdgcn_global_load_lds((const unsigned*)(_g + oa0), (LAS unsigned*)((char*)(P) + tidx * 16), 16, 0, 0); \
    __builtin_amdgcn_global_load_lds((const unsigned*)(_g + (size_t)lda * 128 + oa0), (LAS unsigned*)((char*)(P) + tidx * 16 + 8192), 16, 0, 0); } while (0)
#define STAGE_B(P, br, kt) do { const char* _g = (const char*)(Bt + ((long)(br) * ldb + (long)(kt) * BK)); \
    __builtin_amdgcn_global_load_lds((const unsigned*)(_g + ob0), (LAS unsigned*)((char*)(P) + tidx * 16), 16, 0, 0); \
    __builtin_amdgcn_global_load_lds((const unsigned*)(_g + (size_t)ldb * 128 + ob0), (LAS unsigned*)((char*)(P) + tidx * 16 + 8192), 16, 0, 0); } while (0)
#define LDA(dst, b, h) _Pragma("unroll") for (int m = 0; m < 4; ++m) _Pragma("unroll") for (int k = 0; k < 2; ++k) dst[m][k] = *reinterpret_cast<const half8*>((char*)SA(b, h) + la + (m * 2 + k) * 1024)
#define LDB(dst, b, h) _Pragma("unroll") for (int n = 0; n < 2; ++n) _Pragma("unroll") for (int k = 0; k < 2; ++k) dst[n][k] = *reinterpret_cast<const half8*>((char*)SB(b, h) + lb + (n * 2 + k) * 1024)
#define MMA(ai, bj, At_, Bt_) do { __builtin_amdgcn_s_setprio(1); \
    _Pragma("unroll") for (int m = 0; m < 4; ++m) _Pragma("unroll") for (int n = 0; n < 2; ++n) _Pragma("unroll") for (int k = 0; k < 2; ++k) \
        acc[ai][bj][m][n] = __builtin_amdgcn_mfma_f32_16x16x32_f16(Bt_[n][k], At_[m][k], acc[ai][bj][m][n], 0, 0, 0); \
    __builtin_amdgcn_s_setprio(0); } while (0)
#define MMAH(ai, bj, At_, Bt_) do { if (!half_m) MMA(ai, bj, At_, Bt_); } while (0)
#define WAIT_V(n) asm volatile("s_waitcnt vmcnt(" #n ")" ::: "memory")
#define WAIT_L(n) asm volatile("s_waitcnt lgkmcnt(" #n ")" ::: "memory")
#define BAR __builtin_amdgcn_s_barrier()
#define SCHED __builtin_amdgcn_sched_barrier(0)
    int tidx = tid_in; asm volatile("" : "+v"(tidx));
    const int wid = tidx >> 6, lane = tidx & 63, wr = wid >> 2, wc = wid & 3, fr = lane & 15, fq = lane >> 4;
    const int lpart = ((fr * 64 + fq * 16) ^ ((fr >> 3) << 5));
    const int la = wr * 8192 + lpart, lb = wc * 4096 + lpart;
    unsigned oa0, ob0;
    { int _r, _c; stage_rc(tidx * 16, _r, _c); oa0 = (unsigned)(_r * lda + _c) * 2u; ob0 = (unsigned)(_r * ldb + _c) * 2u; }
    f32x4 acc[2][2][4][2] = {};
    half8 At[4][2], B0[2][2], B1[2][2];
    const int nt = K / BK;
    if (!pre_issued) {
        STAGE_B(SB(0, 0), bcol, 0); STAGE_A(SA(0, 0), brow, 0);
        STAGE_B(SB(0, 1), bcol + HALF, 0); STAGE_A(SA(0, 1), brow + HALF, 0); }
    if (wr == 1) BAR;
    WAIT_V(4); BAR;
    STAGE_B(SB(1, 0), bcol, 1); STAGE_A(SA(1, 0), brow, 1); STAGE_B(SB(1, 1), bcol + HALF, 1);
    WAIT_V(6); BAR;
    for (int t = 0; t < nt - 2; t += 2) {
        LDB(B0, 0, 0); SCHED; LDA(At, 0, 0); STAGE_A(SA(1, 1), brow + HALF, t + 1);
        WAIT_L(8); BAR; WAIT_L(0); MMA(0, 0, At, B0); BAR; SCHED;
        LDB(B1, 0, 1); STAGE_B(SB(0, 0), bcol, t + 2);
        BAR; WAIT_L(0); MMA(0, 1, At, B1); BAR;
        LDA(At, 0, 1); STAGE_A(SA(0, 0), brow, t + 2);
        BAR; WAIT_L(0); MMAH(1, 0, At, B0); BAR; SCHED;
        STAGE_B(SB(0, 1), bcol + HALF, t + 2);
        WAIT_V(6); BAR; MMAH(1, 1, At, B1); BAR;
        LDB(B0, 1, 0); SCHED; LDA(At, 1, 0); STAGE_A(SA(0, 1), brow + HALF, t + 2);
        WAIT_L(8); BAR; WAIT_L(0); MMA(0, 0, At, B0); BAR; SCHED;
        LDB(B1, 1, 1); STAGE_B(SB(1, 0), bcol, t + 3);
        BAR; WAIT_L(0); MMA(0, 1, At, B1); BAR;
        LDA(At, 1, 1); STAGE_A(SA(1, 0), brow, t + 3);
        BAR; WAIT_L(0); MMAH(1, 0, At, B0); BAR; SCHED;
        STAGE_B(SB(1, 1), bcol + HALF, t + 3);
        WAIT_V(6); BAR; MMAH(1, 1, At, B1); BAR;
    }
    { LDB(B0, 0, 0); LDA(At, 0, 0); STAGE_A(SA(1, 1), brow + HALF, nt - 1);
      BAR; WAIT_L(0); MMA(0, 0, At, B0); BAR;
      LDB(B1, 0, 1); BAR; WAIT_L(0); MMA(0, 1, At, B1); BAR;
      LDA(At, 0, 1); WAIT_V(4); BAR; WAIT_L(0); MMAH(1, 0, At, B0); MMAH(1, 1, At, B1); BAR; }
    { LDB(B0, 1, 0); LDA(At, 1, 0); WAIT_V(2); BAR; WAIT_L(0); MMA(0, 0, At, B0); BAR;
      LDB(B1, 1, 1); WAIT_V(0); BAR; WAIT_L(0); MMA(0, 1, At, B1); BAR;
      LDA(At, 1, 1); BAR; WAIT_L(0); MMAH(1, 0, At, B0); MMAH(1, 1, At, B1); BAR; }
    if (wr == 0) BAR;
    if (has_next) { STAGE_B(SB(0, 0), nbcol, 0); STAGE_A(SA(0, 0), nbrow, 0); STAGE_B(SB(0, 1), nbcol + HALF, 0); STAGE_A(SA(0, 1), nbrow + HALF, 0); }
    epi(acc, brow + wr * 64 + fr, bcol + wc * 32 + fq * 4, half_m ? 1 : 2);
    __syncthreads();
}
DI bool unit_order(int L, int nM, int nN, int& pm, int& pn) {
    const int nwg = nM * nN; if (L >= nwg) return false;
    int wgid = L; { const int q = nwg / 8, r = nwg % 8, xcd = wgid % 8, off = wgid / 8; wgid = (xcd < r ? xcd * (q + 1) : r * (q + 1) + (xcd - r) * q) + off; }
    const int nig = 8 * nN, gid = wgid / nig, fm = gid * 8, gsz = (nM - fm) < 8 ? (nM - fm) : 8;
    pm = fm + ((wgid % nig) % gsz); pn = (wgid % nig) / gsz; return true;
}
typedef f32x4 Acc[2][2][4][2];
#define EPI_LOOP _Pragma("unroll") for (int ai = 0; ai < 2; ++ai) if (ai < nai) _Pragma("unroll") for (int bj = 0; bj < 2; ++bj) _Pragma("unroll") for (int m = 0; m < 4; ++m) _Pragma("unroll") for (int n = 0; n < 2; ++n)
struct EpiZ { h16* z; int ld;
    DI void operator()(Acc& acc, int r0, int c0, int nai) const { EPI_LOOP { const int row = r0 + ai * 128 + m * 16, col = c0 + bj * 128 + n * 16;
        half4 v; _Pragma("unroll") for (int j = 0; j < 4; ++j) v[j] = (h16)acc[ai][bj][m][n][j]; *(half4*)(z + (size_t)row * ld + col) = v; } } };
struct EpiLora { h16 *dec, *a, *g; const float *w0, *a0;
    DI void operator()(Acc& acc, int r0, int c0, int nai) const { EPI_LOOP { const int row = r0 + ai * 128 + m * 16, col = c0 + bj * 128 + n * 16; half4 v;
        if (col < 512) { _Pragma("unroll") for (int j = 0; j < 4; ++j) { const float lw = w0[col + j] + acc[ai][bj][m][n][j]; v[j] = (h16)__expf(-0.60653066f * sigmoidf_(lw)); } *(half4*)(dec + (size_t)row * 512 + col) = v; }
        else if (col < 1024) { _Pragma("unroll") for (int j = 0; j < 4; ++j) v[j] = (h16)sigmoidf_(a0[col - 512 + j] + acc[ai][bj][m][n][j]); *(half4*)(a + (size_t)row * 512 + col - 512) = v; }
        else { _Pragma("unroll") for (int j = 0; j < 4; ++j) v[j] = (h16)acc[ai][bj][m][n][j]; *(half4*)(g + (size_t)row * 512 + col - 1024) = v; } } } };
struct EpiCmp { h16* hid; const float* bias;
    DI void operator()(Acc& acc, int r0, int c0, int nai) const { EPI_LOOP { const int row = r0 + ai * 128 + m * 16, col = c0 + bj * 128 + n * 16; half4 v;
        _Pragma("unroll") for (int j = 0; j < 4; ++j) { const float x = acc[ai][bj][m][n][j] + bias[col + j]; const float u = 0.7978845608f * (x + 0.044715f * x * x * x);
            const float th = 1.f - 2.f * rcpf_(1.f + __expf(2.f * u)); v[j] = (h16)(0.5f * x * (1.f + th)); }
        *(half4*)(hid + (size_t)row * 256 + col) = v; } } };
struct EpiRes { const float* xin; float* xout; const float* gate;
    DI void operator()(Acc& acc, int r0, int c0, int nai) const { EPI_LOOP { const int row = r0 + ai * 128 + m * 16, col = c0 + bj * 128 + n * 16;
        const f32x4 xi = *(const f32x4*)(xin + (size_t)row * D + col); const f32x4 gg = *(const f32x4*)(gate + (size_t)(row >> 11) * 6144 + col);
        f32x4 o; _Pragma("unroll") for (int j = 0; j < 4; ++j) o[j] = xi[j] + gg[j] * acc[ai][bj][m][n][j]; *(f32x4*)(xout + (size_t)row * D + col) = o; } } };
struct EpiSwiglu { h16* hid;
    DI void operator()(Acc& acc, int r0, int c0, int nai) const { _Pragma("unroll") for (int ai = 0; ai < 2; ++ai) if (ai < nai) _Pragma("unroll") for (int m = 0; m < 4; ++m) _Pragma("unroll") for (int n = 0; n < 2; ++n) {
        const int row = r0 + ai * 128 + m * 16; const int tcol = c0 & 255, pn = c0 >> 8; const int col = pn * 128 + tcol + n * 16; half4 v;
        _Pragma("unroll") for (int j = 0; j < 4; ++j) { const float gt = acc[ai][0][m][n][j], up = acc[ai][1][m][n][j]; v[j] = (h16)(gt * sigmoidf_(gt) * up); }
        *(half4*)(hid + (size_t)row * FF + col) = v; } } };

struct Ctx {
    float* out; unsigned char* ws; char* lds; unsigned* ctl;
    int tid, lane, wave, gw, ngw;
    template <class Tp> DI Tp* W(size_t off) const { return (Tp*)(ws + off); }
    DI const float* inp(int i) const { const unsigned* t = (const unsigned*)(ws + WS_PTRS) + 2 * i;
        const unsigned lo = __builtin_amdgcn_readfirstlane(t[0]), hi = __builtin_amdgcn_readfirstlane(t[1]); return (const float*)(const __attribute__((address_space(1))) float*)(((uintptr_t)hi << 32) | lo); }
    DI const float* inl(int i, int l, size_t per_layer) const { return inp(i) + (size_t)l * per_layer; }
};

template <class CM>
DI void tr_item(const float* __restrict__ Wsrc, int K, int Nsrc, h16* WT, int k0, int n0, float* scr, int lane, CM cm) {
    const int kk = lane >> 3, n4 = (lane & 7) * 4; const int sc = cm(n0 + n4);
    f32x4 v[8];
#pragma unroll
    for (int i = 0; i < 8; ++i) { v[i] = (f32x4){0.f, 0.f, 0.f, 0.f}; if (sc >= 0) v[i] = *(const f32x4*)(Wsrc + (size_t)(k0 + kk + 8 * i) * Nsrc + sc); }
#pragma unroll
    for (int i = 0; i < 8; ++i) { float* d = scr + (kk + 8 * i) * 33 + n4; d[0] = v[i].x; d[1] = v[i].y; d[2] = v[i].z; d[3] = v[i].w; }
    WSYNC();
    const int c = lane & 7;
#pragma unroll
    for (int j = 0; j < 4; ++j) { const int n = (lane >> 3) + 8 * j; const float* s = scr + (8 * c) * 33 + n; half8 o;
        _Pragma("unroll") for (int q = 0; q < 8; ++q) o[q] = (h16)s[q * 33];
        *(half8*)(WT + (size_t)(n0 + n) * K + k0 + 8 * c) = o; }
    WSYNC();
}
DI void convert_weights(const Ctx& c, int l) {
    float* scr = (float*)(c.lds + c.wave * 8448);
    constexpr int I_IN = 16 * 104, I_OUT = 16 * 32, I_FI = 16 * 176, I_FO = 44 * 32, I_W1 = 32 * 8;
    constexpr int NIT = I_IN + I_OUT + I_FI + I_FO + 2 * I_W1;
    for (int it = c.gw; it < NIT; it += c.ngw) {
        int r = it;
        if (r < I_IN) { tr_item(c.inl(I_WIN, l, (size_t)D * 3152), D, 3152, c.W<h16>(WS_WIN), (r / 104) * 64, (r % 104) * 32, scr, c.lane,
                                [](int n) { return n < 708 ? n : (n < 768 ? -1 : (n < 3212 ? n - 60 : -1)); }); continue; } r -= I_IN;
        if (r < I_OUT) { tr_item(c.inl(I_WOUT, l, (size_t)D * D), D, D, c.W<h16>(WS_WOUT), (r / 32) * 64, (r % 32) * 32, scr, c.lane, [](int n) { return n; }); continue; } r -= I_OUT;
        if (r < I_FI) { tr_item(c.inl(I_FWI, l, (size_t)D * 2 * FF), D, 2 * FF, c.W<h16>(WS_WI), (r / 176) * 64, (r % 176) * 32, scr, c.lane,
                                [](int n) { const int pn = n >> 8, q = n & 255; return q < 128 ? pn * 128 + q : FF + pn * 128 + (q - 128); }); continue; } r -= I_FI;
        if (r < I_FO) { tr_item(c.inl(I_FWO, l, (size_t)FF * D), FF, D, c.W<h16>(WS_WO), (r / 32) * 64, (r % 32) * 32, scr, c.lane, [](int n) { return n; }); continue; } r -= I_FO;
        const int j = r / I_W1; r %= I_W1;
        tr_item(c.inl(I_NW1, l, (size_t)2 * 2048 * 256) + (size_t)j * 2048 * 256, 2048, 256, c.W<h16>(WS_W1) + (size_t)j * 256 * 2048, (r / 8) * 64, (r % 8) * 32, scr, c.lane, [](int n) { return n; });
    }
    const float* w2 = c.inl(I_W2, l, 64 * 512); const float* a2 = c.inl(I_A2, l, 64 * 512); const float* g2 = c.inl(I_G2, l, 128 * 512);
    h16* wl = c.W<h16>(WS_WL);
    for (int e = blockIdx.x * NTHREADS + c.tid; e < 1536 * 256; e += gridDim.x * NTHREADS) {
        const int n = e >> 8, k = e & 255; float v = 0.f;
        if (n < 512) { if (k < 64) v = w2[k * 512 + n]; }
        else if (n < 1024) { if (k >= 64 && k < 128) v = a2[(k - 64) * 512 + n - 512]; }
        else { if (k >= 128) v = g2[(k - 128) * 512 + n - 1024]; }
        wl[e] = (h16)v;
    }
}
template <int NV>
DI void gemv_item(const Ctx& c, const float* aL, int K, const float* __restrict__ Wsrc, int N, int n0, const float* bias, float* out, int out_stride, float* red) {
    const int nl = c.tid & 31, kc = c.tid >> 5, kper = K / 16;
    float acc[NV]; for (int v = 0; v < NV; ++v) acc[v] = 0.f;
    for (int k0 = kc * kper; k0 < (kc + 1) * kper; k0 += 16) {
        float wv[16]; _Pragma("unroll") for (int u = 0; u < 16; ++u) wv[u] = Wsrc[(size_t)(k0 + u) * N + n0 + nl];
        _Pragma("unroll") for (int u = 0; u < 16; ++u) for (int v = 0; v < NV; ++v) acc[v] += aL[v * K + k0 + u] * wv[u]; }
    for (int v = 0; v < NV; ++v) red[(kc * NV + v) * 32 + nl] = acc[v];
    __syncthreads();
    if (c.tid < 32 * NV) { const int v = c.tid >> 5; float s = bias ? bias[n0 + nl] : 0.f; _Pragma("unroll") for (int q = 0; q < 16; ++q) s += red[(q * NV + v) * 32 + nl]; out[(size_t)v * out_stride + n0 + nl] = s; }
    __syncthreads();
}
DI void phase_mod(const Ctx& c) {
    float* sil = (float*)(c.lds + 70000); float* red = (float*)(c.lds + 70000 + 32768);
    for (int e = c.tid; e < 8 * 1024; e += NTHREADS) { const float x = c.inp(I_C)[e]; sil[e] = x * sigmoidf_(x); }
    __syncthreads();
    for (int it = blockIdx.x; it < 2 * 192; it += gridDim.x) { const int l = it / 192, n0 = (it % 192) * 32;
        gemv_item<8>(c, sil, 1024, c.inl(I_ADAW, l, (size_t)1024 * 6144), 6144, n0, c.inl(I_ADAB, l, 6144), c.W<float>(WS_MOD) + (size_t)l * 8 * 6144, 6144, red); }
}
DI void phase_cbias(const Ctx& c, int l) {
    float* pe = (float*)(c.lds + 70000); float* red = (float*)(c.lds + 70000 + 32768);
    __syncthreads();
    for (int e = c.tid; e < 2 * 2048; e += NTHREADS) pe[e] = c.inl(I_PE, l, 2 * 2048)[e];
    __syncthreads();
    for (int it = (int)gridDim.x - 1 - (int)blockIdx.x; it < 16; it += gridDim.x) { const int j = it >> 3, n0 = (it & 7) * 32;
        gemv_item<1>(c, pe + j * 2048, 2048, c.inl(I_NW1, l, (size_t)2 * 2048 * 256) + (size_t)j * 2048 * 256, 256, n0, nullptr, c.W<float>(WS_CBIAS) + j * 256, 256, red); }
}
DI void phase_norm(const Ctx& c, const float* x, const float* g, const float* mod_l, int sh_off, int sc_off) {
    h16* act = c.W<h16>(WS_ACT);
    f32x4 gg[4]; _Pragma("unroll") for (int j = 0; j < 4; ++j) gg[j] = *(const f32x4*)(g + 4 * c.lane + 256 * j);
    for (int m0 = c.gw; m0 < M; m0 += 4 * c.ngw) {
        f32x4 v[4][4];
        _Pragma("unroll") for (int u = 0; u < 4; ++u) { const int m = m0 + u * c.ngw; const f32x4* xr = (const f32x4*)(x + (size_t)(m < M ? m : m0) * D) + c.lane;
            _Pragma("unroll") for (int j = 0; j < 4; ++j) v[u][j] = xr[64 * j]; }
        _Pragma("unroll") for (int u = 0; u < 4; ++u) { const int m = m0 + u * c.ngw; if (m >= M) break;
            float s = 0.f; _Pragma("unroll") for (int j = 0; j < 4; ++j) s += v[u][j].x * v[u][j].x + v[u][j].y * v[u][j].y + v[u][j].z * v[u][j].z + v[u][j].w * v[u][j].w;
            const float rstd = rsqf_(wave_sum(s) * (1.f / D) + 1e-6f);
            const float* mb = mod_l + (size_t)(m >> 11) * 6144;
            _Pragma("unroll") for (int j = 0; j < 4; ++j) { const int col = 4 * c.lane + 256 * j; const f32x4 sc = *(const f32x4*)(mb + sc_off + col), sh = *(const f32x4*)(mb + sh_off + col);
                half4 o; _Pragma("unroll") for (int q = 0; q < 4; ++q) o[q] = (h16)(v[u][j][q] * rstd * gg[j][q] * (1.f + sc[q]) + sh[q]);
                *(half4*)(act + (size_t)m * D + col) = o; } }
    }
}
template <class Epi>
DI void phase_gemm(const Ctx& c, const h16* A, int lda, const h16* Bt, int ldb, int K, int nM, int nN, const Epi& epi) {
    const int G = (int)gridDim.x, bid = (int)blockIdx.x, nwg = nM * nN, rounds = nwg / G, rem = nwg - rounds * G;
    const bool tail_half = rem > 0 && 2 * rem <= G;
    const int nfull = tail_half ? rounds : (nwg + G - 1) / G;
    bool pre = false;
    for (int i = 0; i < nfull; ++i) { int pm, pn, pm2 = 0, pn2 = 0; if (!unit_order(i * G + bid, nM, nN, pm, pn)) break;
        const bool have2 = (i + 1 < nfull) && unit_order((i + 1) * G + bid, nM, nN, pm2, pn2);
        gemm_unit(c.tid, A, lda, Bt, ldb, K, pm * 256, pn * 256, (h16*)c.lds, epi, pre, have2, pm2 * 256, pn2 * 256);
        pre = have2; }
    if (tail_half && bid < 2 * rem) { int pm, pn; unit_order(rounds * G + (bid >> 1), nM, nN, pm, pn);
        gemm_unit(c.tid, A, lda, Bt, ldb, K, pm * 256 + 128 * (bid & 1), pn * 256, (h16*)c.lds, epi, false, false, 0, 0, true); }
}

DI void phase_prep(const Ctx& c, int l) {
    h16* Z = c.W<h16>(WS_Z);
    const float* dqg = c.inl(I_DQG, l, 64); const float* dkg = c.inl(I_DKG, l, 64); const float* nqg = c.inl(I_NQG, l, 64); const float* nkg = c.inl(I_NKG, l, 64);
    const float* mu = c.inl(I_MU, l, 1792);
    const int lane = c.lane; const bool hi = lane >= 32;
    const float inv = powf(10000.f, -(float)(lane & 31) * (1.f / 32.f));
    const float g_dq = dqg[lane], g_dk = dkg[lane], g_nq = nqg[lane], g_nk = nkg[lane];
    h16* VL = (h16*)(c.lds + 65536);
    for (int tb = blockIdx.x; tb < M / 64; tb += gridDim.x) {
      __syncthreads();
      const int c4 = lane * 4; const f32x4 mu4 = *(const f32x4*)(mu + 1536 + c4);
      for (int ti0 = 0; ti0 < 8; ti0 += 4) {
        struct TokIn { float xqa[4], xiq[4], xqc[4], xka, xik, xks, xkw; h16 xva, xkc, xvc, xvs, xvw; half4 zc, zp; } in[4];
        _Pragma("unroll") for (int u = 0; u < 4; ++u) { const int m = tb * 64 + c.wave * 8 + ti0 + u; const int t = m & 2047; const h16* zr = Z + (size_t)m * ZC; TokIn& x = in[u];
            _Pragma("unroll") for (int h = 0; h < 4; ++h) { x.xqa[h] = (float)zr[C_QA + h * 64 + lane]; x.xiq[h] = (float)zr[C_IQ + h * 64 + lane]; x.xqc[h] = (float)zr[C_QC + h * 64 + lane]; }
            x.xka = (float)zr[C_KA + lane]; x.xik = (float)zr[C_IK + lane]; x.xks = (float)zr[C_KS + lane]; x.xkw = (float)zr[C_KW + lane];
            x.xva = zr[C_VA + lane]; x.xkc = zr[C_KC + lane]; x.xvc = zr[C_VC + lane]; x.xvs = zr[C_VS + lane]; x.xvw = zr[C_VW + lane];
            x.zc = *(const half4*)(zr + C_WD + c4); x.zp = *(const half4*)((t > 0 ? zr - ZC : zr) + C_WD + c4); }
        asm volatile("" ::: "memory");
        _Pragma("unroll") for (int u = 0; u < 4; ++u) { const int m = tb * 64 + c.wave * 8 + ti0 + u; const int tl = c.wave * 8 + ti0 + u; const int t = m & 2047; h16* zr = Z + (size_t)m * ZC; const TokIn& x = in[u];
            const float ang = (float)t * inv; float sn, cs;
            { const float kf = rintf(ang * 0.15915494309189535f); float rr = fmaf(-kf, 6.28125f, ang); rr = fmaf(-kf, 0.0019353071795864769f, rr); sn = __sinf(rr); cs = __cosf(rr); }
            auto rope = [&](float v) { const float o = shx(v, 32); return hi ? v * cs + o * sn : v * cs - o * sn; };
            auto normrope = [&](float v, float g) { const float ss = wave_sum_dpp(v * v); return rope(v * rsqf_(ss * (1.f / 64.f) + 1e-6f) * g); };
            _Pragma("unroll") for (int h = 0; h < 4; ++h) { zr[C_QA + h * 64 + lane] = (h16)(normrope(x.xqa[h], g_dq) * 0.18033688f); zr[C_IQ + h * 64 + lane] = (h16)rope(x.xiq[h]); zr[C_QC + h * 64 + lane] = (h16)(normrope(x.xqc[h], g_nq) * 0.18033688f); }
            c.W<h16>(WS_KA)[(size_t)m * 64 + lane] = (h16)normrope(x.xka, g_dk);
            c.W<h16>(WS_IK)[(size_t)m * 64 + lane] = (h16)rope(x.xik);
            c.W<h16>(WS_KS)[(size_t)m * 64 + lane] = (h16)normrope(x.xks, g_nk);
            c.W<h16>(WS_KW)[(size_t)m * 64 + lane] = (h16)normrope(x.xkw, g_nk);
            c.W<h16>(WS_KC)[(size_t)m * 64 + lane] = x.xkc;
            c.W<h16>(WS_VC)[(size_t)m * 64 + lane] = x.xvc;
            VL[(0 * 64 + lane) * 72 + tl] = x.xva; VL[(1 * 64 + lane) * 72 + tl] = x.xvs; VL[(2 * 64 + lane) * 72 + tl] = x.xvw;
            { half4 o; _Pragma("unroll") for (int q = 0; q < 4; ++q) { const float a = (float)x.zc[q], pz = t > 0 ? (float)x.zp[q] : 0.f, v = a + (pz - a) * mu4[q];
                  o[q] = (h16)(c4 < 64 ? (1.f - 2.f * rcpf_(1.f + __expf(2.f * v))) : (c4 < 128 ? v : sigmoidf_(v))); }
              *(half4*)(c.W<h16>(WS_L16) + (size_t)m * 256 + c4) = o; } }
      }
      __syncthreads();
      {
          const int bb = (tb * 64) >> 11, t0 = (tb * 64) & 2047;
          for (int e = c.tid; e < 3 * 64 * 8; e += NTHREADS) { const int arr = e >> 9, dim = (e >> 3) & 63, pc = e & 7;
              h16* dst = c.W<h16>(arr == 0 ? WS_VAT : (arr == 1 ? WS_VST : WS_VWT)) + ((size_t)bb * 64 + dim) * T + t0 + 8 * pc;
              *(half8*)dst = *(const half8*)(VL + (arr * 64 + dim) * 72 + 8 * pc); }
      }
    }
}

constexpr int SCS = 2056;
DI unsigned sortable(float v) { if (v == 0.f) v = 0.f; const unsigned u = __builtin_bit_cast(unsigned, v); return (u & 0x80000000u) ? ~u : (u | 0x80000000u); }
DI void dsa_select_item(const Ctx& c, int item) {
    const int b = item >> 7, t0 = (item & 127) * 16; const int lane = c.lane, w = c.wave;
    unsigned* dmask = c.W<unsigned>(WS_DMASK);
    if (t0 < 256) {
        for (int e = c.tid; e < 16 * 64; e += NTHREADS) { const int qi = e >> 6, wd = e & 63, t = t0 + qi; const int nb = t + 1 - 32 * wd;
            dmask[(size_t)(b * T + t) * 64 + wd] = nb <= 0 ? 0u : (nb >= 32 ? 0xFFFFFFFFu : ((1u << nb) - 1u)); }
        return;
    }
    float* sc = (float*)c.lds;
    const h16* Z = c.W<h16>(WS_Z); const h16* IK = c.W<h16>(WS_IK) + (size_t)b * T * 64;
    const int r = lane & 31, hf = lane >> 5, hd = r & 3;
    half8 qf[2][4]; float iw[2][4][4];
    _Pragma("unroll") for (int cb = 0; cb < 2; ++cb) { const int mq = b * T + t0 + 8 * cb + (r >> 2); const h16* zq = Z + (size_t)mq * ZC;
        _Pragma("unroll") for (int ks = 0; ks < 4; ++ks) qf[cb][ks] = *(const half8*)(zq + C_IQ + hd * 64 + 16 * ks + 8 * hf);
        _Pragma("unroll") for (int g = 0; g < 4; ++g) { const half4 w4 = *(const half4*)(Z + (size_t)(b * T + t0 + 8 * cb + 2 * g + hf) * ZC + C_IW);
            _Pragma("unroll") for (int q = 0; q < 4; ++q) iw[cb][g][q] = (float)w4[q]; } }
    const int ntile = (t0 + 15) / 32 + 1;
    for (int kt = w; kt < ntile; kt += 16) {
        const bool two = kt + 8 < ntile;
        const h16* kr = IK + (size_t)(32 * kt + r) * 64 + 8 * hf;
        half8 ka[4], kb[4];
        _Pragma("unroll") for (int ks = 0; ks < 4; ++ks) ka[ks] = *(const half8*)(kr + 16 * ks);
        if (two) { _Pragma("unroll") for (int ks = 0; ks < 4; ++ks) kb[ks] = *(const half8*)(kr + 8 * 32 * 64 + 16 * ks); }
        _Pragma("unroll") for (int hh = 0; hh < 2; ++hh) {
            if (hh == 1 && !two) break;
            const int key = 32 * (kt + 8 * hh) + r;
            f32x16 s0 = {}, s1 = {};
            _Pragma("unroll") for (int ks = 0; ks < 4; ++ks) { const half8 kf = hh ? kb[ks] : ka[ks]; s0 = MFMA32(qf[0][ks], kf, s0); s1 = MFMA32(qf[1][ks], kf, s1); }
            _Pragma("unroll") for (int g = 0; g < 4; ++g) { float v0 = 0.f, v1 = 0.f;
                _Pragma("unroll") for (int q = 0; q < 4; ++q) { v0 += iw[0][g][q] * fmaxf(s0[4 * g + q], 0.f); v1 += iw[1][g][q] * fmaxf(s1[4 * g + q], 0.f); }
                sc[(2 * g + hf) * SCS + key] = v0; sc[(8 + 2 * g + hf) * SCS + key] = v1; }
        }
    }
    __syncthreads();
    _Pragma("unroll") for (int qq = 0; qq < 2; ++qq) {
        const int qi = 2 * w + qq, t = t0 + qi; unsigned u[32]; const int nI = (t >> 6) + 1;
        _Pragma("unroll") for (int i = 0; i < 32; ++i) { const int key = 64 * i + lane; u[i] = (i < nI && key <= t) ? sortable(sc[qi * SCS + key]) : 0u; }
        unsigned thr = 0u; bool exact = false;
        for (int bit = 31; bit >= 0; --bit) { const unsigned cand = thr | (1u << bit); int cnt = 0;
            _Pragma("unroll") for (int g = 0; g < 4; ++g) if (8 * g < nI) { _Pragma("unroll") for (int i = 8 * g; i < 8 * g + 8; ++i) cnt += __popcll(__ballot(u[i] >= cand)); }
            if (cnt >= 256) { thr = cand; if (cnt == 256) { exact = true; break; } } }
        int need = 0;
        if (!exact) { int cg_ = 0; _Pragma("unroll") for (int i = 0; i < 32; ++i) cg_ += __popcll(__ballot(u[i] > thr)); need = 256 - cg_; }
        unsigned long long mine = 0ull; int run = 0;
        _Pragma("unroll") for (int i = 0; i < 32; ++i) { bool sel;
            if (exact) sel = u[i] >= thr;
            else { const bool eq = (u[i] == thr); const unsigned long long be = __ballot(eq); const int pre = run + __popcll(be & ((1ull << lane) - 1ull)); sel = (u[i] > thr) || (eq && pre < need); run += __popcll(be); }
            const unsigned long long bs = __ballot(sel); if (lane == i) mine = bs; }
        if (lane < 32) *(unsigned long long*)(dmask + (size_t)(b * T + t) * 64 + 2 * lane) = mine;
    }
}

struct Flash { f32x16 o0, o1; float mx, l; DI void init() { _Pragma("unroll") for (int i = 0; i < 16; ++i) { o0[i] = 0.f; o1[i] = 0.f; } mx = -1e30f; l = 0.f; } };
DI half8 ld2x4(const char* p) { const half4 a = *(const half4*)p, b = *(const half4*)(p + 16); return __builtin_shufflevector(a, b, 0, 1, 2, 3, 4, 5, 6, 7); }
struct KV { half8 k[4]; half8 v[2][2]; unsigned word; };
template <bool HASMASK>
DI void load_kv(KV& t, const h16* Kb, const h16* Vt, int ldv, const unsigned* mrow, int kt, int r, int hf) {
    const h16* kr = Kb + (size_t)(32 * kt + r) * 64 + 8 * hf;
    _Pragma("unroll") for (int ks = 0; ks < 4; ++ks) t.k[ks] = *(const half8*)(kr + 16 * ks);
    _Pragma("unroll") for (int st = 0; st < 2; ++st) { const h16* vp0 = Vt + (size_t)r * ldv + 32 * kt + 16 * st + 4 * hf; const h16* vp1 = vp0 + (size_t)32 * ldv;
        const half4 a0 = *(const half4*)vp0, b0 = *(const half4*)(vp0 + 8), a1 = *(const half4*)vp1, b1 = *(const half4*)(vp1 + 8);
        t.v[st][0] = __builtin_shufflevector(a0, b0, 0, 1, 2, 3, 4, 5, 6, 7); t.v[st][1] = __builtin_shufflevector(a1, b1, 0, 1, 2, 3, 4, 5, 6, 7); }
    if (HASMASK) t.word = mrow[kt]; else t.word = 0u;
}
typedef __fp16 fp16x2_t __attribute__((ext_vector_type(2)));
typedef __fp16 fp16x4_t __attribute__((ext_vector_type(4)));
typedef __fp16 fp16x8_t __attribute__((ext_vector_type(8)));
DI half8 pack8(const f32x16& s, int st) {
    const fp16x2_t p0 = __builtin_amdgcn_cvt_pkrtz(s[8 * st + 0], s[8 * st + 1]), p1 = __builtin_amdgcn_cvt_pkrtz(s[8 * st + 2], s[8 * st + 3]);
    const fp16x2_t p2 = __builtin_amdgcn_cvt_pkrtz(s[8 * st + 4], s[8 * st + 5]), p3 = __builtin_amdgcn_cvt_pkrtz(s[8 * st + 6], s[8 * st + 7]);
    const fp16x4_t a = __builtin_shufflevector(p0, p1, 0, 1, 2, 3), b = __builtin_shufflevector(p2, p3, 0, 1, 2, 3);
    const fp16x8_t c = __builtin_shufflevector(a, b, 0, 1, 2, 3, 4, 5, 6, 7);
    return __builtin_bit_cast(half8, c);
}
template <class VF>
DI void flash_compute(Flash& f, const half8 (&qf)[4], const KV& t, bool full, VF valid) {
    f32x16 s = {};
    _Pragma("unroll") for (int ks = 0; ks < 4; ++ks) s = MFMA32(t.k[ks], qf[ks], s);
    float tmax = -1e30f;
    if (!full) { _Pragma("unroll") for (int i = 0; i < 16; ++i) s[i] = valid(i) ? s[i] : -3.0e38f; }
    _Pragma("unroll") for (int i = 0; i < 16; ++i) tmax = fmaxf(tmax, s[i]);
    tmax = fmaxf(tmax, shx(tmax, 32));
    const float mnew = fmaxf(f.mx, tmax), alpha = __builtin_amdgcn_exp2f(f.mx - mnew);
    float psum = 0.f;
    _Pragma("unroll") for (int i = 0; i < 16; ++i) { const float p = __builtin_amdgcn_exp2f(s[i] - mnew); s[i] = p; psum += p; }
    f.l = f.l * alpha + psum; f.mx = mnew;
    if (__ballot(alpha != 1.f) != 0ull) { _Pragma("unroll") for (int i = 0; i < 16; ++i) { f.o0[i] *= alpha; f.o1[i] *= alpha; } }
    _Pragma("unroll") for (int st = 0; st < 2; ++st) { const half8 pf = pack8(s, st);
        f.o0 = MFMA32(t.v[st][0], pf, f.o0); f.o1 = MFMA32(t.v[st][1], pf, f.o1); }
}
template <bool HASMASK, class VF, class FF>
DI void flash_pass(Flash& f, const half8 (&qf)[4], const h16* Kb, const h16* Vt, int ldv, const unsigned* mrow, int kt0, int kt1, unsigned um, int lane, VF valid  , FF full  ) {
    const int r = lane & 31, hf = lane >> 5;
    int kt = kt0; while (kt < kt1 && !((um >> (kt >> 1)) & 1u)) ++kt;
    if (kt >= kt1) return;
    auto nextv = [&](int k) { ++k; while (k < kt1 && !((um >> (k >> 1)) & 1u)) ++k; return k; };
    KV ta, tb; load_kv<HASMASK>(ta, Kb, Vt, ldv, mrow, kt, r, hf);
    for (;;) {
        int kn = nextv(kt);
        if (kn < kt1) load_kv<HASMASK>(tb, Kb, Vt, ldv, mrow, kn, r, hf);
        { const int key0 = 32 * kt; const unsigned word = ta.word; flash_compute(f, qf, ta, full(key0, word), [&](int i) { return valid(i, key0 + crow(i, hf), word); }); }
        if (kn >= kt1) break;
        kt = kn; kn = nextv(kt);
        if (kn < kt1) load_kv<HASMASK>(ta, Kb, Vt, ldv, mrow, kn, r, hf);
        { const int key0 = 32 * kt; const unsigned word = tb.word; flash_compute(f, qf, tb, full(key0, word), [&](int i) { return valid(i, key0 + crow(i, hf), word); }); }
        if (kn >= kt1) break;
        kt = kn;
    }
}
constexpr int AT_LDS = 32768, AT_ROW = 144, AT_STAGE = 2 * 64 * AT_ROW;
template <bool HASMASK, class VF, class FF>
DI void flash_pass_wg(Flash& f, const half8 (&qf)[4], const h16* Kb, const h16* Vt, int ldv, const unsigned* mrow, int jb0, int jb1, unsigned um, char* lds, int tid, VF valid  , FF full  ) {
    const int lane = tid & 63, r = lane & 31, hf = lane >> 5;
    auto nextv = [&](int k) { while (k < jb1 && !((um >> k) & 1u)) ++k; return k; };
    const int prow = tid >> 3, ppart = tid & 7;
    const h16* gk = Kb + (size_t)prow * 64 + 8 * ppart; const h16* gv = Vt + (size_t)prow * ldv + 8 * ppart;
    const int loff = prow * AT_ROW + 16 * ppart;
    char* st0 = lds + AT_LDS;
    int jb = nextv(jb0);
    __syncthreads();
    if (jb >= jb1) return;
    half8 pk = *(const half8*)(gk + (size_t)jb * 64 * 64), pv = *(const half8*)(gv + (size_t)jb * 64);
    unsigned w0p = 0u, w1p = 0u; if (HASMASK) { w0p = mrow[2 * jb]; w1p = mrow[2 * jb + 1]; }
    *(half8*)(st0 + loff) = pk; *(half8*)(st0 + 64 * AT_ROW + loff) = pv;
    unsigned w0 = w0p, w1 = w1p; int buf = 0;
    int jn = nextv(jb + 1);
    if (jn < jb1) { pk = *(const half8*)(gk + (size_t)jn * 64 * 64); pv = *(const half8*)(gv + (size_t)jn * 64); if (HASMASK) { w0p = mrow[2 * jn]; w1p = mrow[2 * jn + 1]; } }
    __syncthreads();
    for (;;) {
        const char* sb = st0 + buf * AT_STAGE;
        const int key0 = 64 * jb;
        const bool fa = full(key0, w0), fb = full(key0 + 32, w1);
        f32x16 sa = {}, sc = {};
        _Pragma("unroll") for (int ks = 0; ks < 4; ++ks) { const half8 ka = *(const half8*)(sb + r * AT_ROW + 32 * ks + 16 * hf), kb = *(const half8*)(sb + (32 + r) * AT_ROW + 32 * ks + 16 * hf);
            sa = MFMA32(ka, qf[ks], sa); sc = MFMA32(kb, qf[ks], sc); }
        if (!fa) { _Pragma("unroll") for (int i = 0; i < 16; ++i) sa[i] = valid(i, key0 + crow(i, hf), w0) ? sa[i] : -3.0e38f; }
        if (!fb) { _Pragma("unroll") for (int i = 0; i < 16; ++i) sc[i] = valid(i, key0 + 32 + crow(i, hf), w1) ? sc[i] : -3.0e38f; }
        float tmax = -1e30f;
        _Pragma("unroll") for (int i = 0; i < 16; ++i) tmax = fmaxf(tmax, fmaxf(sa[i], sc[i]));
        tmax = fmaxf(tmax, shx(tmax, 32));
        const float mnew = fmaxf(f.mx, tmax), alpha = __builtin_amdgcn_exp2f(f.mx - mnew);
        float psum = 0.f;
        _Pragma("unroll") for (int i = 0; i < 16; ++i) { sa[i] = __builtin_amdgcn_exp2f(sa[i] - mnew); sc[i] = __builtin_amdgcn_exp2f(sc[i] - mnew); psum += sa[i] + sc[i]; }
        f.l = f.l * alpha + psum; f.mx = mnew;
        if (__ballot(alpha != 1.f) != 0ull) { _Pragma("unroll") for (int i = 0; i < 16; ++i) { f.o0[i] *= alpha; f.o1[i] *= alpha; } }
        const char* vb = sb + 64 * AT_ROW;
        _Pragma("unroll") for (int sub = 0; sub < 2; ++sub) _Pragma("unroll") for (int st = 0; st < 2; ++st) {
            const half8 pf = pack8(sub ? sc : sa, st);
            const char* vp0 = vb + r * AT_ROW + (32 * sub + 16 * st + 4 * hf) * 2; const char* vp1 = vp0 + 32 * AT_ROW;
            f.o0 = MFMA32(ld2x4(vp0), pf, f.o0); f.o1 = MFMA32(ld2x4(vp1), pf, f.o1); }
        if (jn >= jb1) break;
        *(half8*)(st0 + (buf ^ 1) * AT_STAGE + loff) = pk; *(half8*)(st0 + (buf ^ 1) * AT_STAGE + 64 * AT_ROW + loff) = pv; w0 = w0p; w1 = w1p;
        jb = jn; jn = nextv(jb + 1); buf ^= 1;
        if (jn < jb1) { pk = *(const half8*)(gk + (size_t)jn * 64 * 64); pv = *(const half8*)(gv + (size_t)jn * 64); if (HASMASK) { w0p = mrow[2 * jn]; w1p = mrow[2 * jn + 1]; } }
        __syncthreads();
    }
}
DI void store_o(h16* dst  , const f32x16& o0, const f32x16& o1, int hf) {
    _Pragma("unroll") for (int g = 0; g < 4; ++g) { half4 a, b; _Pragma("unroll") for (int j = 0; j < 4; ++j) { a[j] = (h16)o0[4 * g + j]; b[j] = (h16)o1[4 * g + j]; }
        *(half4*)(dst + 8 * g + 4 * hf) = a; *(half4*)(dst + 32 + 8 * g + 4 * hf) = b; }
}
DI void dsa_attn_wave(const Ctx& c, int b, int t0) {
    const int lane = c.lane, r = lane & 31, hf = lane >> 5, hd = r & 3, t = t0 + (r >> 2), m = b * T + t;
    const h16* zq = c.W<h16>(WS_Z) + (size_t)m * ZC + C_QA + hd * 64 + 8 * hf;
    half8 qf[4]; _Pragma("unroll") for (int ks = 0; ks < 4; ++ks) qf[ks] = *(const half8*)(zq + 16 * ks);
    const h16* Kb = c.W<h16>(WS_KA) + (size_t)b * T * 64; const h16* Vt = c.W<h16>(WS_VAT) + (size_t)b * 64 * T;
    const unsigned* mrow = c.W<unsigned>(WS_DMASK) + (size_t)m * 64;
    Flash f; f.init();
    flash_pass_wg<true>(f, qf, Kb, Vt, T, mrow, 0, (t0 >> 6) + 1, 0xFFFFFFFFu, c.lds, c.tid, [&](int i, int key, unsigned word) { return ((word >> (key & 31)) & 1u) != 0u; },
                     [&](int, unsigned word) { return __ballot(word != 0xFFFFFFFFu) == 0ull; });
    const float lt = f.l + shx(f.l, 32), inv = rcpf_(lt);
    _Pragma("unroll") for (int i = 0; i < 16; ++i) { f.o0[i] *= inv; f.o1[i] *= inv; }
    store_o(c.W<h16>(WS_ACT) + (size_t)m * D + hd * 64, f.o0, f.o1, hf);
}
DI void nsa_attn_wave(const Ctx& c, int b, int t0) {
    const int lane = c.lane, w = c.wave, r = lane & 31, hf = lane >> 5, hd = r & 3, qi = r >> 2, t = t0 + qi, m = b * T + t;
    const h16* zrow = c.W<h16>(WS_Z) + (size_t)m * ZC;
    half8 qf[4]; _Pragma("unroll") for (int ks = 0; ks < 4; ++ks) qf[ks] = *(const half8*)(zrow + C_QC + hd * 64 + 8 * hf + 16 * ks);
    const float g0 = sigmoidf_((float)zrow[C_GC + hd * 3 + 0]), g1 = sigmoidf_((float)zrow[C_GC + hd * 3 + 1]), g2 = sigmoidf_((float)zrow[C_GC + hd * 3 + 2]);
    float* GS = (float*)(c.lds + w * 4096); float* LA = GS + 256; float* IMPF = GS + 512; unsigned* SELM = (unsigned*)(GS + 768);
    float* APARK = (float*)(c.lds + 73728 + w * 8192) + lane;
    {
        const h16* Kc = c.W<h16>(WS_KCMP) + (size_t)b * 128 * 64; const h16* Vc = c.W<h16>(WS_VCMPT) + (size_t)b * 64 * 128;
        const int nmax = t >= 31 ? ((t - 31) >> 4) : -1;
        f32x16 s[4]; float mxv = -1e30f;
        _Pragma("unroll") for (int tl = 0; tl < 4; ++tl) { const h16* kr = Kc + (size_t)(32 * tl + r) * 64 + 8 * hf; f32x16 a = {};
            _Pragma("unroll") for (int ks = 0; ks < 4; ++ks) { const half8 kf = *(const half8*)(kr + 16 * ks); a = MFMA32(kf, qf[ks], a); }
            _Pragma("unroll") for (int i = 0; i < 16; ++i) { const int n = 32 * tl + crow(i, hf); a[i] = n <= nmax ? a[i] : -3.0e38f; mxv = fmaxf(mxv, a[i]); }
            s[tl] = a; }
        mxv = fmaxf(mxv, shx(mxv, 32));
        float sum = 0.f;
        _Pragma("unroll") for (int tl = 0; tl < 4; ++tl) _Pragma("unroll") for (int i = 0; i < 16; ++i) { const float p = __builtin_amdgcn_exp2f(s[tl][i] - mxv); s[tl][i] = p; sum += p; }
        sum += shx(sum, 32);
        const float inv = sum > 0.f ? rcpf_(sum) : 0.f;
        f32x16 o0 = {}, o1 = {};
        _Pragma("unroll") for (int tl = 0; tl < 4; ++tl) { _Pragma("unroll") for (int i = 0; i < 16; ++i) s[tl][i] *= inv;
            _Pragma("unroll") for (int st = 0; st < 2; ++st) { half8 pf; _Pragma("unroll") for (int j = 0; j < 8; ++j) pf[j] = (h16)s[tl][8 * st + j];
                const h16* vp0 = Vc + (size_t)r * 128 + 32 * tl + 16 * st + 4 * hf; const h16* vp1 = vp0 + 32 * 128;
                const half4 x0 = *(const half4*)vp0, y0 = *(const half4*)(vp0 + 8), x1 = *(const half4*)vp1, y1 = *(const half4*)(vp1 + 8);
                o0 = MFMA32(__builtin_shufflevector(x0, y0, 0, 1, 2, 3, 4, 5, 6, 7), pf, o0); o1 = MFMA32(__builtin_shufflevector(x1, y1, 0, 1, 2, 3, 4, 5, 6, 7), pf, o1); } }
        _Pragma("unroll") for (int i = 0; i < 16; ++i) { APARK[i * 64] = g0 * o0[i]; APARK[(16 + i) * 64] = g0 * o1[i]; }
        _Pragma("unroll") for (int tl = 0; tl < 4; ++tl) _Pragma("unroll") for (int g = 0; g < 4; ++g) { const int G = 8 * tl + 2 * g + hf;
            const float gs = quad_sum((s[tl][4 * g] + s[tl][4 * g + 1]) + (s[tl][4 * g + 2] + s[tl][4 * g + 3])); const float la = quad_sum(s[tl][4 * g + 3]);
            if (hd == 0) { GS[qi * 32 + G] = gs; LA[qi * 32 + G] = la; } }
        WSYNC();
        _Pragma("unroll") for (int it = 0; it < 4; ++it) { const int q = (lane >> 5) + 2 * it, j = lane & 31, tq = t0 + q, cur = tq >> 6;
            const float imp = GS[q * 32 + j] + (j > 0 ? LA[q * 32 + j - 1] : 0.f);
            const bool adm = (j * 64 <= tq), forced = (j == 0) || (j == cur) || (j == cur - 1);
            IMPF[q * 32 + j] = adm ? (forced ? __builtin_inff() : imp) : -__builtin_inff(); }
        WSYNC();
        _Pragma("unroll") for (int it = 0; it < 4; ++it) { const int q = (lane >> 5) + 2 * it, j = lane & 31; const float mv = IMPF[q * 32 + j]; int rank = 0;
            _Pragma("unroll") for (int jj = 0; jj < 32; ++jj) { const float ov = IMPF[q * 32 + jj]; rank += (ov > mv || (ov == mv && jj < j)) ? 1 : 0; }
            const unsigned long long bs = __ballot(rank < 16);
            if (lane == 0) { SELM[2 * it] = (unsigned)bs; SELM[2 * it + 1] = (unsigned)(bs >> 32); } }
        WSYNC();
    }
    const unsigned selmask = SELM[qi];
    WSYNC();
    {
        const h16* Kb = c.W<h16>(WS_KS) + (size_t)b * T * 64; const h16* Vt = c.W<h16>(WS_VST) + (size_t)b * 64 * T;
        Flash f; f.init();
        unsigned um = 0u; for (int j = 0; j < 32; ++j) if (__ballot(((selmask >> j) & 1u) != 0u) != 0ull) um |= 1u << j;
        unsigned* UM = (unsigned*)(c.lds + AT_LDS - 64);
        if (lane == 0) UM[w] = um;
        __syncthreads();
        um = UM[0] | UM[1] | UM[2] | UM[3] | UM[4] | UM[5] | UM[6] | UM[7];
        flash_pass_wg<false>(f, qf, Kb, Vt, T, nullptr, 0, (t0 >> 6) + 1, um, c.lds, c.tid, [&](int i, int key, unsigned) { return (((selmask >> (key >> 6)) & 1u) != 0u) && key <= t; },
                          [&](int key0, unsigned) { return key0 + 31 <= t0 && __ballot(((selmask >> (key0 >> 6)) & 1u) == 0u) == 0ull; });
        const float lt = f.l + shx(f.l, 32), sc = g1 * rcpf_(lt);
        _Pragma("unroll") for (int i = 0; i < 16; ++i) { APARK[i * 64] += sc * f.o0[i]; APARK[(16 + i) * 64] += sc * f.o1[i]; }
    }
    {
        const h16* Kb = c.W<h16>(WS_KW) + (size_t)b * T * 64; const h16* Vt = c.W<h16>(WS_VWT) + (size_t)b * 64 * T;
        Flash f; f.init();
        const int lo = (t0 - 511 > 0 ? t0 - 511 : 0) >> 5, hiT = (t0 + 7) >> 5;
        flash_pass_wg<false>(f, qf, Kb, Vt, T, nullptr, (((t0 & ~63) - 511 > 0 ? (t0 & ~63) - 511 : 0) >> 6), (t0 >> 6) + 1, 0xFFFFFFFFu, c.lds, c.tid, [&](int i, int key, unsigned) { return key <= t && key > t - 512; },
                          [&](int key0, unsigned) { return key0 + 31 <= t0 && key0 > t0 + 7 - 512; });
        const float lt = f.l + shx(f.l, 32), sc = g2 * rcpf_(lt);
        _Pragma("unroll") for (int i = 0; i < 16; ++i) { f.o0[i] = APARK[i * 64] + sc * f.o0[i]; f.o1[i] = APARK[(16 + i) * 64] + sc * f.o1[i]; }
        store_o(c.W<h16>(WS_ACT) + (size_t)m * D + 768 + hd * 64, f.o0, f.o1, hf);
    }
}

constexpr int RW_KRT = 0, RW_G = 4608, RW_VT = 9728, RW_BBT = 12800, RW_TT = 14336, RW_NAPT = 15872, RW_PL = 17408, RW_SLOT = 17664;
constexpr int RW_PRIV = 6 * RW_SLOT, RW_BK = 0, RW_AF = 4608, RW_PRIVSZ = 5632;
DI float wave_sum_fast(float x) {
    x += dpp_f<0xB1>(x); x += dpp_f<0x4E>(x); x += dpp_f<0x141>(x); x += dpp_f<0x140>(x);
    return (__builtin_amdgcn_readlane(__builtin_bit_cast(int, x), 0) == 0 ? 0.f : 0.f) +
           (__builtin_bit_cast(float, __builtin_amdgcn_readlane(__builtin_bit_cast(int, x), 0)) + __builtin_bit_cast(float, __builtin_amdgcn_readlane(__builtin_bit_cast(int, x), 16))) +
           (__builtin_bit_cast(float, __builtin_amdgcn_readlane(__builtin_bit_cast(int, x), 32)) + __builtin_bit_cast(float, __builtin_amdgcn_readlane(__builtin_bit_cast(int, x), 48)));
}
DI half8 pack8r(const f32x16& s, int st) { half8 o; _Pragma("unroll") for (int j = 0; j < 8; ++j) o[j] = (h16)s[8 * st + j]; return o; }
DI half8 ld2x4_unused(const char* p) { const half4 a = *(const half4*)p, b = *(const half4*)(p + 16); return __builtin_shufflevector(a, b, 0, 1, 2, 3, 4, 5, 6, 7); }
DI void rwkv_item(const Ctx& c, int l, int item) {
    const int b = item >> 3, h = item & 7; const int lane = c.lane, w = c.wave;
    char* L = c.lds;
    const h16* Z = c.W<h16>(WS_Z); const h16* DEC = c.W<h16>(WS_DEC); const h16* AA = c.W<h16>(WS_A); h16* MIX = c.W<h16>(WS_ACT);
    const float* mu = c.inl(I_MU, l, 1792); const float* k_k = c.inl(I_KK, l, 512); const float* k_a = c.inl(I_KA, l, 512);
    const int col = h * 64 + lane;
    const float c_mur = mu[col], c_muk = mu[512 + col], c_muv = mu[1024 + col], c_kk = k_k[col], c_ka = k_a[col];
    const int r = lane & 31, hf = lane >> 5;
    f32x16 ST0 = {}, ST1 = {};
    volatile int* PROD = (volatile int*)(L + RW_PRIV + 6 * RW_PRIVSZ); volatile int* CONS = PROD + 8;
    __syncthreads();
    if (c.tid < 16) PROD[c.tid] = 0;
    __syncthreads();
    for (int R = 0; R < 22; ++R) {
        if (w >= 2) {
            const int hw = w - 2, ch = 6 * R + hw;
            if (ch < 128) {
                while (CONS[hw] != 2 * R) __builtin_amdgcn_s_sleep(1);
                asm volatile("" ::: "memory");
                char* slot = L + hw * RW_SLOT; char* priv = L + RW_PRIV + hw * RW_PRIVSZ;
                const int tt0 = 16 * ch; const size_t m0 = (size_t)b * T + tt0;
                h16 zr[17], zk[17], zv[17], zd[16], za[16];
                _Pragma("unroll") for (int q = 0; q < 17; ++q) { const bool ok = (tt0 + q - 1) >= 0; const h16* zp = Z + (m0 + (ok ? q - 1 : 0)) * ZC;
                    zr[q] = zp[C_R + col]; zk[q] = zp[C_K + col]; zv[q] = zp[C_V + col]; }
                if (tt0 == 0) { zr[0] = (h16)0; zk[0] = (h16)0; zv[0] = (h16)0; }
                _Pragma("unroll") for (int q = 0; q < 16; ++q) { zd[q] = DEC[(m0 + q) * 512 + col]; za[q] = AA[(m0 + q) * 512 + col]; }
                float P = 1.f; float bt[16], kl[16]; half8 vlo, vhi;
                h16* KRT = (h16*)(slot + RW_KRT); h16* BK = (h16*)(priv + RW_BK);
                _Pragma("unroll") for (int q = 0; q < 16; ++q) {
                    const float r0 = (float)zr[q + 1], k0 = (float)zk[q + 1], v0 = (float)zv[q + 1];
                    const float rr = r0 + ((float)zr[q] - r0) * c_mur, kx = k0 + ((float)zk[q] - k0) * c_muk, vv = v0 + ((float)zv[q] - v0) * c_muv;
                    const float kr = kx * c_kk; const float ss = wave_sum_fast(kr * kr);
                    const float kk = kr * rcpf_(fmaxf(__builtin_amdgcn_sqrtf(ss), 1e-12f)); const float a = (float)za[q];
                    const float kp = kx * (1.f + (a - 1.f) * c_ka), bb = kk * a;
                    const float Pprev = P; P *= (float)zd[q]; const float iP = rcpf_(P);
                    bt[q] = fminf(fmaxf(bb * iP, -60000.f), 60000.f); kl[q] = fminf(fmaxf(kp * iP, -60000.f), 60000.f);
                    KRT[q * 72 + lane] = (h16)(Pprev * kk); KRT[(16 + q) * 72 + lane] = (h16)(P * rr);
                    BK[q * 72 + lane] = (h16)bt[q]; BK[(16 + q) * 72 + lane] = (h16)kl[q];
                    if (q < 8) vlo[q] = (h16)vv; else vhi[q - 8] = (h16)vv;
                }
                { h16* VT = (h16*)(slot + RW_VT) + lane * 24; *(half8*)VT = vlo; *(half8*)(VT + 8) = vhi; }
                ((float*)(slot + RW_PL))[lane] = P;
                { h16* G = (h16*)(slot + RW_G) + lane * 40; half8 g0, g1, g2, g3;
                  _Pragma("unroll") for (int q = 0; q < 8; ++q) { g0[q] = (h16)(-bt[q] * P); g1[q] = (h16)(-bt[8 + q] * P); g2[q] = (h16)(kl[q] * P); g3[q] = (h16)(kl[8 + q] * P); }
                  *(half8*)G = g0; *(half8*)(G + 8) = g1; *(half8*)(G + 16) = g2; *(half8*)(G + 24) = g3; }
                WSYNC();
                f32x16 M = {};
                _Pragma("unroll") for (int ks = 0; ks < 4; ++ks) { const half8 af = *(const half8*)(BK + r * 72 + 16 * ks + 8 * hf), bf = *(const half8*)(KRT + r * 72 + 16 * ks + 8 * hf); M = MFMA32(af, bf, M); }
                float* AF = (float*)(priv + RW_AF); h16* BBT = (h16*)(slot + RW_BBT); h16* NAPT = (h16*)(slot + RW_NAPT); h16* TT = (h16*)(slot + RW_TT);
                const int n = r;
                _Pragma("unroll") for (int q = 0; q < 8; ++q) { const int sidx = crow(q, hf);
                    if (n < 16) { AF[sidx * 16 + n] = sidx < n ? M[q] : 0.f; NAPT[n * 24 + sidx] = (h16)0.f; }
                    else NAPT[n * 24 + sidx] = (h16)(sidx <= n - 16 ? -M[q] : 0.f); }
                _Pragma("unroll") for (int q = 8; q < 16; ++q) { const int sidx = crow(q, hf) - 16;
                    BBT[n * 24 + sidx] = (h16)((n < 16 ? sidx < n : sidx <= n - 16) ? M[q] : 0.f); }
                WSYNC();
                if (lane < 32) { float x[16];
                    {
                        f32x4 ar[8][2];
                        _Pragma("unroll") for (int q = 0; q < 8; ++q) { ar[q][0] = *(const f32x4*)(AF + (8 + q) * 16 + 8); ar[q][1] = *(const f32x4*)(AF + (8 + q) * 16 + 12); }
                        _Pragma("unroll") for (int sidx = 15; sidx >= 8; --sidx) { float acc = (sidx == lane) ? 1.f : 0.f;
                            _Pragma("unroll") for (int mm = sidx + 1; mm < 16; ++mm) acc -= ar[sidx - 8][(mm - 8) >> 2][(mm - 8) & 3] * x[mm];
                            x[sidx] = acc; } }
                    {
                        f32x4 ar[8][4];
                        _Pragma("unroll") for (int q = 0; q < 8; ++q) _Pragma("unroll") for (int g = 0; g < 4; ++g) ar[q][g] = *(const f32x4*)(AF + q * 16 + 4 * g);
                        _Pragma("unroll") for (int sidx = 7; sidx >= 0; --sidx) { float acc = (sidx == lane) ? 1.f : 0.f;
                            _Pragma("unroll") for (int mm = sidx + 1; mm < 16; ++mm) acc -= ar[sidx][mm >> 2][mm & 3] * x[mm];
                            x[sidx] = acc; } }
                    half8 t0, t1; _Pragma("unroll") for (int q = 0; q < 8; ++q) { t0[q] = (h16)(lane < 16 ? x[q] : 0.f); t1[q] = (h16)(lane < 16 ? x[8 + q] : 0.f); }
                    *(half8*)(TT + lane * 24) = t0; *(half8*)(TT + lane * 24 + 8) = t1; }
                WSYNC();
                if (lane == 0) PROD[hw] = R + 1;
            }
        }
        if (w < 2) {
            _Pragma("unroll 1") for (int hw = 0; hw < 6; ++hw) { const int ch = 6 * R + hw; if (ch >= 128) break;
                while (PROD[hw] != R + 1) __builtin_amdgcn_s_sleep(1);
                asm volatile("" ::: "memory");
                const char* slot = L + hw * RW_SLOT;
                const char* KRT = slot + RW_KRT; const char* G = slot + RW_G;
                const half8 sf00 = pack8r(ST0, 0), sf01 = pack8r(ST0, 1), sf10 = pack8r(ST1, 0), sf11 = pack8r(ST1, 1);
                f32x16 X = {};
                X = MFMA32(ld2x4(KRT + r * 144 + (0 + 4 * hf) * 2), sf00, X);
                X = MFMA32(ld2x4(KRT + r * 144 + (16 + 4 * hf) * 2), sf01, X);
                X = MFMA32(ld2x4(KRT + r * 144 + (32 + 4 * hf) * 2), sf10, X);
                X = MFMA32(ld2x4(KRT + r * 144 + (48 + 4 * hf) * 2), sf11, X);
                const half8 vtf = *(const half8*)(slot + RW_VT + (32 * w + r) * 48 + 16 * hf);
                X = MFMA32(*(const half8*)(slot + RW_BBT + r * 48 + 16 * hf), vtf, X);
                f32x16 U = {};
                U = MFMA32(ld2x4(slot + RW_TT + r * 48 + 8 * hf), pack8r(X, 0), U);
                const half8 uu = pack8r(U, 0);
                X = MFMA32(ld2x4(slot + RW_NAPT + r * 48 + 8 * hf), uu, X);
                { h16* yo = MIX + ((size_t)b * T + 16 * ch) * D + 256 + h * 64 + 32 * w + r;
                  _Pragma("unroll") for (int q = 8; q < 16; ++q) yo[(size_t)(crow(q, hf) - 16) * D] = (h16)X[q]; }
                const float* PLp = (const float*)(slot + RW_PL);
                _Pragma("unroll") for (int g = 0; g < 4; ++g) { const f32x4 p0 = *(const f32x4*)(PLp + 8 * g + 4 * hf), p1 = *(const f32x4*)(PLp + 32 + 8 * g + 4 * hf);
                    _Pragma("unroll") for (int q = 0; q < 4; ++q) { ST0[4 * g + q] *= p0[q]; ST1[4 * g + q] *= p1[q]; } }
                ST0 = MFMA32(ld2x4(G + r * 80 + 8 * hf), uu, ST0);
                ST0 = MFMA32(*(const half8*)(G + r * 80 + 32 + 16 * hf), vtf, ST0);
                ST1 = MFMA32(ld2x4(G + (32 + r) * 80 + 8 * hf), uu, ST1);
                ST1 = MFMA32(*(const half8*)(G + (32 + r) * 80 + 32 + 16 * hf), vtf, ST1);
                WSYNC();
                if (lane == 0) __hip_atomic_fetch_add((int*)&CONS[hw], 1, __ATOMIC_RELAXED, __HIP_MEMORY_SCOPE_WORKGROUP);
            }
        }
    }
    __syncthreads();
}

DI void phase_rwkv_post(const Ctx& c, int l) {
    const h16* Z = c.W<h16>(WS_Z); const h16* AA = c.W<h16>(WS_A); const h16* GG = c.W<h16>(WS_G); h16* MIX = c.W<h16>(WS_ACT);
    const float* mu = c.inl(I_MU, l, 1792); const float* k_a = c.inl(I_KA, l, 512); const float* r_k = c.inl(I_RK, l, 512); const float* ln_w = c.inl(I_LNW, l, 512); const float* ln_b = c.inl(I_LNB, l, 512);
    const int col = c.lane * 8;
    float c_mur[8], c_muk[8], c_muv[8], c_ka[8], c_rk[8], c_lw[8], c_lb[8];
    _Pragma("unroll") for (int q = 0; q < 8; ++q) { c_mur[q] = mu[col + q]; c_muk[q] = mu[512 + col + q]; c_muv[q] = mu[1024 + col + q]; c_ka[q] = k_a[col + q]; c_rk[q] = r_k[col + q]; c_lw[q] = ln_w[col + q]; c_lb[q] = ln_b[col + q]; }
    for (int m = c.gw; m < M; m += c.ngw) {
        const int t = m & 2047; const h16* zr = Z + (size_t)m * ZC;
        const half8 y8 = *(const half8*)(MIX + (size_t)m * D + 256 + col);
        const half8 r8 = *(const half8*)(zr + C_R + col), k8 = *(const half8*)(zr + C_K + col), v8 = *(const half8*)(zr + C_V + col);
        half8 rp = {0, 0, 0, 0, 0, 0, 0, 0}, kp_ = rp, vp = rp;
        if (t > 0) { rp = *(const half8*)(zr - ZC + C_R + col); kp_ = *(const half8*)(zr - ZC + C_K + col); vp = *(const half8*)(zr - ZC + C_V + col); }
        const half8 a8 = *(const half8*)(AA + (size_t)m * 512 + col), g8 = *(const half8*)(GG + (size_t)m * 512 + col);
        float y[8], vv[8]; float sum = 0.f, bs = 0.f;
        _Pragma("unroll") for (int q = 0; q < 8; ++q) { const float r0 = (float)r8[q], k0 = (float)k8[q], v0 = (float)v8[q], a = (float)a8[q];
            const float rr = r0 + ((float)rp[q] - r0) * c_mur[q], kx = k0 + ((float)kp_[q] - k0) * c_muk[q]; vv[q] = v0 + ((float)vp[q] - v0) * c_muv[q];
            const float kp = kx * (1.f + (a - 1.f) * c_ka[q]); y[q] = (float)y8[q]; sum += y[q]; bs += rr * kp * c_rk[q]; }
        const float mean = red8(sum) * (1.f / 64.f); bs = red8(bs);
        float vs = 0.f; _Pragma("unroll") for (int q = 0; q < 8; ++q) { const float d = y[q] - mean; vs += d * d; }
        const float rstd = rsqf_(red8(vs) * (1.f / 64.f) + 64e-5f);
        half8 o;
        _Pragma("unroll") for (int q = 0; q < 8; ++q) o[q] = (h16)((((y[q] - mean) * rstd * c_lw[q] + c_lb[q]) + bs * vv[q]) * (float)g8[q]);
        *(half8*)(MIX + (size_t)m * D + 256 + col) = o;
    }
}

DI void phase_cmp2(const Ctx& c, int l) {
    const h16* HID = c.W<h16>(WS_HID); const float* w2 = c.inl(I_NW2, l, 2 * 256 * 64); const float* nkg = c.inl(I_NKG, l, 64);
    const int lane = c.lane; const bool hi = lane >= 32; const float inv = powf(10000.f, -(float)(lane & 31) * (1.f / 32.f));
    for (int it = c.gw; it < 2 * 1024; it += c.ngw) { const int j = it >> 10, rrow = it & 1023, b = rrow >> 7, n = rrow & 127;
        float acc = 0.f;
        if (n < 127) { const h16* hr = HID + ((size_t)j * 1024 + rrow) * 256; const float* wj = w2 + (size_t)j * 256 * 64;
            float a4[4] = {0.f, 0.f, 0.f, 0.f};
            _Pragma("unroll 2") for (int k = 0; k < 256; k += 32) {
                _Pragma("unroll") for (int u = 0; u < 4; ++u) { const half8 hv = *(const half8*)(hr + k + 8 * u); _Pragma("unroll") for (int q = 0; q < 8; ++q) a4[u] += (float)hv[q] * wj[(k + 8 * u + q) * 64 + lane]; } }
            acc = (a4[0] + a4[1]) + (a4[2] + a4[3]); }
        if (j == 0) { const float ss = wave_sum(acc * acc); float y = acc * rsqf_(ss * (1.f / 64.f) + 1e-6f) * nkg[lane];
            const float ang = (float)(16 * n + 31) * inv; const float cs = cosf(ang), sn = sinf(ang); const float o = shx(y, 32); y = hi ? y * cs + o * sn : y * cs - o * sn;
            c.W<h16>(WS_KCMP)[((size_t)b * 128 + n) * 64 + lane] = (h16)(n < 127 ? y : 0.f); }
        else c.W<h16>(WS_VCMPT)[((size_t)b * 64 + lane) * 128 + n] = (h16)acc; }
}

__global__ void __launch_bounds__(NTHREADS) fwd_kernel(Params p) {
    extern __shared__ __attribute__((aligned(16))) char lds[];
    cg::grid_group grid = cg::this_grid();
    Ctx c; c.out = p.out; c.ws = p.ws; c.lds = lds; c.ctl = (unsigned*)(p.ws + WS_CTL);
    c.wave = __builtin_amdgcn_readfirstlane(threadIdx.x >> 6); c.lane = lane_id(); c.tid = c.wave * 64 + c.lane; c.gw = blockIdx.x * 8 + c.wave; c.ngw = gridDim.x * 8;
    if (c.tid < 28) ((const float**)(p.ws + WS_PTRS))[c.tid] = p.in[c.tid];
    unsigned* xbar = c.ctl + 4096;
    if (c.tid == 0) { s_xb[0] = 0u; s_xb[1] = 0u; (void)xb_add(&xbar[XB_XCNT(xb_xcc_id())], 1u); }
    __threadfence(); __syncthreads();
#define GSYNC() do { xcd_barrier(c.ctl + 4096, c.tid); PH(); } while (0)
    h16* ACT = c.W<h16>(WS_ACT); h16* Z = c.W<h16>(WS_Z);

#define PH() do { c.ws = launder_ptr(c.ws); c.out = launder_ptr(c.out); c.lane = lane_id(); asm volatile("" : "+v"(c.lane)); c.tid = c.wave * 64 + c.lane; c.gw = blockIdx.x * 8 + c.wave; } while (0)
    phase_mod(c);
#pragma unroll 1
    for (int l = 0; l < DEPTH; ++l) {
        const float* mod_l = c.W<float>(WS_MOD) + (size_t)l * 8 * 6144;
        PH(); convert_weights(c, l);
        PH(); phase_cbias(c, l);
        if (l == 0) grid.sync();
        PH();
        phase_norm(c, l == 0 ? c.inp(I_X) : c.out, c.inl(I_N1G, l, D), mod_l, 0, 1024);
        GSYNC();
        phase_gemm(c, ACT, D, c.W<h16>(WS_WIN), D, D, 64, 13, EpiZ{Z, ZC});
        GSYNC();
        phase_prep(c, l);
        GSYNC();
        {
            unsigned* ctr = c.ctl + 16 * (2 * l);
            for (;;) { const int it = next_item(ctr, c.tid); if (it >= 8 + 384 + 1024) break; PH();
                if (it < 8) { const int j = it >> 2, pm = it & 3;
                    gemm_unit(c.tid, c.W<h16>(j ? WS_VC : WS_KC), 1024, c.W<h16>(WS_W1) + (size_t)j * 256 * 2048, 2048, 2048, pm * 256, 0, (h16*)lds, EpiCmp{c.W<h16>(WS_HID) + (size_t)j * 1024 * 256, c.W<float>(WS_CBIAS) + j * 256}); }
                else if (it < 392) { const int u = it - 8, pm = u / 6, pn = u % 6;
                    gemm_unit(c.tid, c.W<h16>(WS_L16), 256, c.W<h16>(WS_WL), 256, 256, pm * 256, pn * 256, (h16*)lds, EpiLora{c.W<h16>(WS_DEC), c.W<h16>(WS_A), c.W<h16>(WS_G), c.inl(I_W0, l, 512), c.inl(I_A0, l, 512)}); }
                else dsa_select_item(c, 1023 - (it - 392)); }
        }
        GSYNC();
        phase_cmp2(c, l);
        GSYNC();
        {
            unsigned* ctr = c.ctl + 16 * (2 * l + 1);
            for (;;) { const int it = next_item(ctr, c.tid); if (it >= 64 + 512) break; PH();
                if (it < 64) rwkv_item(c, l, it);
                else { const int a = it - 64; const int kind = a >> 8, idx = 255 - (a & 255); const int b = idx & 7, qb = idx >> 3; const int t0 = qb * 64 + c.wave * 8;
                    if (kind == 0) nsa_attn_wave(c, b, t0); else dsa_attn_wave(c, b, t0); } }
        }
        GSYNC();
        phase_rwkv_post(c, l);
        GSYNC();
        phase_gemm(c, ACT, D, c.W<h16>(WS_WOUT), D, D, 64, 4, EpiRes{l == 0 ? c.inp(I_X) : c.out, c.out, mod_l + 2048});
        GSYNC();
        phase_norm(c, c.out, c.inl(I_N2G, l, D), mod_l, 3072, 4096);
        GSYNC();
        phase_gemm(c, ACT, D, c.W<h16>(WS_WI), D, D, 64, 22, EpiSwiglu{Z});
        GSYNC();
        phase_gemm(c, Z, FF, c.W<h16>(WS_WO), FF, FF, 64, 4, EpiRes{c.out, c.out, mod_l + 5120});
        if (l + 1 < DEPTH) GSYNC();
    }
}

extern "C" void kernel_launch(void* const* d_in, const int* in_sizes, int n_in, void* d_out, int out_size, void* d_ws, size_t ws_size, hipStream_t stream) {
    static int grid_blocks = 0;
    if (grid_blocks == 0) {
        if (n_in != 28 || ws_size < WS_END) { fprintf(stderr, "kernel_launch: unexpected n_in %d / ws %zu\n", n_in, ws_size); grid_blocks = -1; return; }
        int dev = 0, cus = 0, per_cu = 0;
        hipGetDevice(&dev); hipDeviceGetAttribute(&cus, hipDeviceAttributeMultiprocessorCount, dev);
        hipFuncSetAttribute((const void*)fwd_kernel, hipFuncAttributeMaxDynamicSharedMemorySize, LDS_BYTES);
        hipOccupancyMaxActiveBlocksPerMultiprocessor(&per_cu, (const void*)fwd_kernel, NTHREADS, LDS_BYTES);
        if (per_cu < 1) { fprintf(stderr, "kernel_launch: occupancy query says %d blocks/CU\n", per_cu); per_cu = 1; }
        grid_blocks = cus * 1;
    }
    if (grid_blocks < 0) return;
    hipMemsetAsync((char*)d_ws + WS_CTL, 0, 64 * 1024, stream);
    Params p{};
    for (int i = 0; i < 28; ++i) p.in[i] = (const float*)d_in[i];
    p.out = (float*)d_out; p.ws = (unsigned char*)d_ws;
    void* args[] = {&p};
    hipError_t e = hipLaunchCooperativeKernel((const void*)fwd_kernel, dim3(grid_blocks), dim3(NTHREADS), args, LDS_BYTES, stream);
    if (e != hipSuccess) fprintf(stderr, "cooperative launch failed: %s (grid %d)\n", hipGetErrorString(e), grid_blocks);
}
```
